# Optimizing an MI355X kernel written in HIP

```python
import math
import jax
import jax.numpy as jnp
from jax import lax
import numpy as np

D_MODEL = 1024
BATCH = 2
SEQ = 16384
DEPTH = 2

HEAD_DIM = 64
FOX_HEADS = 8
DIFF_HEADS = 4
DIFF_V_DIM = 2 * HEAD_DIM
FOX_WIDTH = FOX_HEADS * HEAD_DIM
DIFF_QK_WIDTH = DIFF_HEADS * 2 * HEAD_DIM
DIFF_WIDTH = DIFF_HEADS * DIFF_V_DIM
ATTN_WIDTH = FOX_WIDTH + DIFF_WIDTH
ATTN_SPLITS = (FOX_WIDTH, FOX_WIDTH, FOX_WIDTH, FOX_HEADS, DIFF_QK_WIDTH, DIFF_QK_WIDTH, DIFF_WIDTH, ATTN_WIDTH)
ATTN_IN = 3 * FOX_WIDTH + FOX_HEADS + 2 * DIFF_QK_WIDTH + DIFF_WIDTH + ATTN_WIDTH

ML_HEADS = 8
ML_QK_DIM = 64
ML_V_DIM = 128
ML_QK_WIDTH = ML_HEADS * ML_QK_DIM
ML_WIDTH = ML_HEADS * ML_V_DIM
ML_SPLITS = (ML_QK_WIDTH, ML_QK_WIDTH, ML_WIDTH, ML_HEADS, ML_HEADS, ML_WIDTH, ML_WIDTH)
ML_IN = 2 * ML_QK_WIDTH + 3 * ML_WIDTH + 2 * ML_HEADS

Q_BLOCK = 128
ML_CHUNK = 128
ROPE_THETA = 10000.0
EPS = 1e-6
POS_OFFSET_MAX = 4096
N_ATTN_LAYERS = (DEPTH + 1) // 2
N_MLSTM_LAYERS = DEPTH // 2

kernel_name = 'hybrid_fox_diff_mlstm'

F32 = jnp.float32


def rms_norm(x, g):
    xf = x.astype(F32)
    y = xf * lax.rsqrt(jnp.mean(xf * xf, axis=-1, keepdims=True) + EPS)
    return (y * g.astype(F32)).astype(x.dtype)


def split_cols(t, sizes):
    idx = np.cumsum(sizes)[:-1].tolist()
    return jnp.split(t, idx, axis=-1)


def rope(x, pos):
    half = x.shape[-1] // 2
    inv = ROPE_THETA ** (-jnp.arange(half, dtype=F32) / half)
    ang = pos.astype(F32)[..., None] * inv
    ang = ang.reshape((x.shape[0],) + (1,) * (x.ndim - 3) + ang.shape[1:])
    cos, sin = jnp.cos(ang), jnp.sin(ang)
    x1 = x[..., :half].astype(F32)
    x2 = x[..., half:].astype(F32)
    return jnp.concatenate([x1 * cos - x2 * sin, x1 * sin + x2 * cos], axis=-1).astype(x.dtype)


def seq_blocks(t, axis, size):
    n = t.shape[axis] // size
    t = t.reshape(t.shape[:axis] + (n, size) + t.shape[axis + 1:])
    return jnp.moveaxis(t, axis, 0)


def seq_unblocks(t, axis):
    t = jnp.moveaxis(t, 0, axis)
    return t.reshape(t.shape[:axis] + (-1,) + t.shape[axis + 2:])


def fox_attention(q, k, v, log_f):
    S = q.shape[2]
    scale = HEAD_DIM ** -0.5
    F = jnp.cumsum(log_f, axis=-1)
    key_pos = jnp.arange(S)
    nb = S // Q_BLOCK

    def block(args):
        i, qi, Fi = args
        q_pos = i * Q_BLOCK + jnp.arange(Q_BLOCK)
        s = jnp.einsum('bhqd,bhkd->bhqk', qi, k, preferred_element_type=F32) * scale
        s = s + Fi[..., :, None] - F[..., None, :]
        s = jnp.where(key_pos[None, :] <= q_pos[:, None], s, -jnp.inf)
        p = jax.nn.softmax(s, axis=-1)
        return jnp.einsum('bhqk,bhkd->bhqd', p.astype(v.dtype), v)

    out = lax.map(block, (jnp.arange(nb), seq_blocks(q, 2, Q_BLOCK), seq_blocks(F, 2, Q_BLOCK)))
    return seq_unblocks(out, 2)


def diff_attention(q, k, v, lam):
    S = q.shape[3]
    scale = HEAD_DIM ** -0.5
    key_pos = jnp.arange(S)
    nb = S // Q_BLOCK

    def block(args):
        i, qi = args
        q_pos = i * Q_BLOCK + jnp.arange(Q_BLOCK)
        s = jnp.einsum('bhcqd,bhckd->bhcqk', qi, k, preferred_element_type=F32) * scale
        s = jnp.where(key_pos[None, :] <= q_pos[:, None], s, -jnp.inf)
        p = jax.nn.softmax(s, axis=-1)
        pd = p[:, :, 0] - lam * p[:, :, 1]
        return jnp.einsum('bhqk,bhke->bhqe', pd.astype(v.dtype), v)

    out = lax.map(block, (jnp.arange(nb), seq_blocks(q, 3, Q_BLOCK)))
    return seq_unblocks(out, 2)


def mlstm_chunkwise(q, k, v, log_i, log_f):
    B, H, S, dk = q.shape
    dv = v.shape[-1]
    L = ML_CHUNK
    causal = jnp.tril(jnp.ones((L, L), dtype=bool))

    def step(carry, xs):
        C, n, m = carry
        qi, ki, vi, li, lf = xs
        qf, kf, vf = qi.astype(F32), ki.astype(F32), vi.astype(F32)
        b = jnp.cumsum(lf, axis=-1)
        a = b[..., -1]
        log_d = b[..., :, None] - b[..., None, :] + li[..., None, :]
        log_d = jnp.where(causal, log_d, -jnp.inf)
        log_inter = b + m[..., None]
        m_t = jnp.maximum(log_inter, jnp.max(log_d, axis=-1))
        d = jnp.exp(log_d - m_t[..., None])
        w_inter = jnp.exp(log_inter - m_t)
        s = jnp.einsum('bhtd,bhsd->bhts', qf, kf) * d
        num = w_inter[..., None] * jnp.einsum('bhtd,bhde->bhte', qf, C) + jnp.einsum('bhts,bhse->bhte', s, vf)
        den = w_inter * jnp.einsum('bhtd,bhd->bht', qf, n) + jnp.sum(s, axis=-1)
        h = num / jnp.maximum(jnp.abs(den), jnp.exp(-m_t))[..., None]
        g = a[..., None] - b + li
        m_new = jnp.maximum(a + m, jnp.max(g, axis=-1))
        w_old = jnp.exp(a + m - m_new)
        w_s = jnp.exp(g - m_new[..., None])
        C_new = w_old[..., None, None] * C + jnp.einsum('bhs,bhsd,bhse->bhde', w_s, kf, vf)
        n_new = w_old[..., None] * n + jnp.einsum('bhs,bhsd->bhd', w_s, kf)
        return (C_new, n_new, m_new), h.astype(v.dtype)

    init = (jnp.zeros((B, H, dk, dv), F32), jnp.zeros((B, H, dk), F32), jnp.zeros((B, H), F32))
    xs = (seq_blocks(q, 2, L), seq_blocks(k, 2, L), seq_blocks(v, 2, L),
          seq_blocks(log_i, 2, L), seq_blocks(log_f, 2, L))
    _, hs = lax.scan(step, init, xs)
    return seq_unblocks(hs, 2)


def attention_layer(x, pos, norm_g, w_in, b_f, lam_q1, lam_k1, lam_q2, lam_k2, subln_g, w_out, layer_idx):
    B, S, _ = x.shape
    h = rms_norm(x, norm_g)
    proj = jnp.einsum('bsd,de->bse', h, w_in)
    fq, fk, fv, ff, dq, dk, dv, z = split_cols(proj, ATTN_SPLITS)

    def heads(t, nh):
        return t.reshape(B, S, nh, -1).transpose(0, 2, 1, 3)

    log_f = jax.nn.log_sigmoid((ff + b_f).astype(F32)).transpose(0, 2, 1)
    o_fox = fox_attention(heads(fq, FOX_HEADS), heads(fk, FOX_HEADS), heads(fv, FOX_HEADS), log_f)

    dq = rope(dq.reshape(B, S, DIFF_HEADS, 2, HEAD_DIM).transpose(0, 2, 3, 1, 4), pos)
    dk = rope(dk.reshape(B, S, DIFF_HEADS, 2, HEAD_DIM).transpose(0, 2, 3, 1, 4), pos)
    lam_init = 0.8 - 0.6 * math.exp(-0.3 * layer_idx)
    lam = (jnp.exp(jnp.sum(lam_q1.astype(F32) * lam_k1.astype(F32)))
           - jnp.exp(jnp.sum(lam_q2.astype(F32) * lam_k2.astype(F32))) + lam_init)
    o_diff = diff_attention(dq, dk, heads(dv, DIFF_HEADS), lam)
    o_diff = rms_norm(o_diff, subln_g) * (1.0 - lam_init)

    y = jnp.concatenate([o_fox.transpose(0, 2, 1, 3).reshape(B, S, FOX_WIDTH),
                         o_diff.transpose(0, 2, 1, 3).reshape(B, S, DIFF_WIDTH)], axis=-1)
    y = y * jax.nn.silu(z)
    return x + jnp.einsum('bse,ed->bsd', y, w_out)


def mlstm_layer(x, norm_g, w_in, b_i, b_f, w_out):
    B, S, _ = x.shape
    h = rms_norm(x, norm_g)
    proj = jnp.einsum('bsd,de->bse', h, w_in)
    q, k, v, ig, fg, og, z = split_cols(proj, ML_SPLITS)

    def heads(t, nh):
        return t.reshape(B, S, nh, -1).transpose(0, 2, 1, 3)

    q = heads(q, ML_HEADS)
    k = heads(k, ML_HEADS) * (ML_QK_DIM ** -0.5)
    v = heads(v, ML_HEADS)
    log_i = (ig + b_i).astype(F32).transpose(0, 2, 1)
    log_f = jax.nn.log_sigmoid((fg + b_f).astype(F32)).transpose(0, 2, 1)
    hm = mlstm_chunkwise(q, k, v, log_i, log_f)
    hm = hm.transpose(0, 2, 1, 3).reshape(B, S, ML_WIDTH)
    y = jax.nn.sigmoid(og) * hm * jax.nn.silu(z)
    return x + jnp.einsum('bse,ed->bsd', y, w_out)


def setup_inputs(seed: int = 0) -> dict:
    key = jax.random.key(seed)
    ks = jax.random.split(key, 18)
    ne, no = N_ATTN_LAYERS, N_MLSTM_LAYERS
    nrm = jax.random.normal
    x = nrm(ks[0], (BATCH, SEQ, D_MODEL), F32)
    positions = (jnp.arange(SEQ, dtype=jnp.int32)[None, :]
                 + jax.random.randint(ks[1], (BATCH, 1), 0, POS_OFFSET_MAX, dtype=jnp.int32))
    attn_norm_g = 1.0 + 0.02 * nrm(ks[2], (ne, D_MODEL), F32)
    attn_w_in = nrm(ks[3], (ne, D_MODEL, ATTN_IN), F32) * D_MODEL ** -0.5
    fox_b_f = jax.random.uniform(ks[4], (ne, FOX_HEADS), F32, 1.0, 4.0)
    diff_lam_q1 = 0.1 * nrm(ks[5], (ne, HEAD_DIM), F32)
    diff_lam_k1 = 0.1 * nrm(ks[6], (ne, HEAD_DIM), F32)
    diff_lam_q2 = 0.1 * nrm(ks[7], (ne, HEAD_DIM), F32)
    diff_lam_k2 = 0.1 * nrm(ks[8], (ne, HEAD_DIM), F32)
    diff_subln_g = 1.0 + 0.02 * nrm(ks[9], (ne, DIFF_V_DIM), F32)
    attn_w_out = nrm(ks[10], (ne, ATTN_WIDTH, D_MODEL), F32) * ATTN_WIDTH ** -0.5
    ml_norm_g = 1.0 + 0.02 * nrm(ks[11], (no, D_MODEL), F32)
    ml_w_in = nrm(ks[12], (no, D_MODEL, ML_IN), F32) * D_MODEL ** -0.5
    ml_b_i = 0.1 * nrm(ks[13], (no, ML_HEADS), F32)
    ml_b_f = jax.random.uniform(ks[14], (no, ML_HEADS), F32, 3.0, 6.0)
    ml_w_out = nrm(ks[15], (no, ML_WIDTH, D_MODEL), F32) * ML_WIDTH ** -0.5
    final_norm_g = 1.0 + 0.02 * nrm(ks[16], (D_MODEL,), F32)
    return {'x': x, 'positions': positions, 'attn_norm_g': attn_norm_g, 'attn_w_in': attn_w_in,
            'fox_b_f': fox_b_f, 'diff_lam_q1': diff_lam_q1, 'diff_lam_k1': diff_lam_k1,
            'diff_lam_q2': diff_lam_q2, 'diff_lam_k2': diff_lam_k2, 'diff_subln_g': diff_subln_g,
            'attn_w_out': attn_w_out, 'ml_norm_g': ml_norm_g, 'ml_w_in': ml_w_in, 'ml_b_i': ml_b_i,
            'ml_b_f': ml_b_f, 'ml_w_out': ml_w_out, 'final_norm_g': final_norm_g}


def reference(x, positions, attn_norm_g, attn_w_in, fox_b_f, diff_lam_q1, diff_lam_k1, diff_lam_q2,
              diff_lam_k2, diff_subln_g, attn_w_out, ml_norm_g, ml_w_in, ml_b_i, ml_b_f, ml_w_out,
              final_norm_g):
    for layer in range(DEPTH):
        j = layer // 2
        if layer % 2 == 0:
            x = attention_layer(x, positions, attn_norm_g[j], attn_w_in[j], fox_b_f[j],
                                diff_lam_q1[j], diff_lam_k1[j], diff_lam_q2[j], diff_lam_k2[j],
                                diff_subln_g[j], attn_w_out[j], layer)
        else:
            x = mlstm_layer(x, ml_norm_g[j], ml_w_in[j], ml_b_i[j], ml_b_f[j], ml_w_out[j])
    return rms_norm(x, final_norm_g)
```

```cpp
#include <hip/hip_runtime.h>
#include <cstdio>
#include <cstdint>
namespace pg8 {
#define PG8_LAS __attribute__((address_space(3)))
typedef unsigned short bf16_t;
typedef short bf16x8 __attribute__((ext_vector_type(8)));
typedef float f32x4 __attribute__((ext_vector_type(4)));
typedef unsigned u32x4 __attribute__((ext_vector_type(4)));
constexpr int BM = 256, BK = 64, HALF = 128, HTB = HALF * BK * 2  , STAGE_BYTES = 8 * HTB, NXCD = 8, WGM = 8;

__host__ __device__ __forceinline__ int lds_byte(int r, int c) { const int st = (r >> 4) * 2 + (c >> 5), rr = r & 15, cc = c & 31, ob = rr * 64 + cc * 2; return st * 1024 + (ob ^ (((ob >> 9) & 1) << 5)); }
__host__ __device__ __forceinline__ void stage_rc(int b, int& R, int& C) { const int st = b / 1024, sb = b % 1024, swz = sb ^ (((sb >> 9) & 1) << 5); R = (st >> 1) * 16 + swz / 64; C = (st & 1) * 32 + (swz % 64) / 2; }
__host__ __device__ __forceinline__ int perm32(int rho) { const int n = rho >> 4, i = rho & 15; return 8 * (i >> 2) + 4 * n + (i & 3); }

struct Unit { int pm, pn; };
struct Gemm { const bf16_t* A; const bf16_t* Bt; int M, N, K; };

struct StaticOrder {
    int nM, nN, nwg, G, c;
    __host__ __device__ void init(int M, int N, int G_, int c_) { nM = M / BM; nN = N / BM; nwg = nM * nN; G = G_; c = c_; }
    __host__ __device__ bool next(int i, Unit& u) const {
        const long L = (long)i * G + c; if (L >= nwg) return false;
        int wgid = (int)L; { const int q = nwg / NXCD, r = nwg % NXCD, xcd = wgid % NXCD, off = wgid / NXCD; wgid = (xcd < r ? xcd * (q + 1) : r * (q + 1) + (xcd - r) * q) + off; }
        const int nig = WGM * nN, gid = wgid / nig, fm = gid * WGM, gsz = (nM - fm) < WGM ? (nM - fm) : WGM;
        u.pm = fm + ((wgid % nig) % gsz); u.pn = (wgid % nig) / gsz; return true;
    }
    __device__ __forceinline__ void a_ready(const Unit&) const {}
    __device__ __forceinline__ void done(const Unit&) const {}
};

__device__ __forceinline__ unsigned cvt_pk_bf16(float lo, float hi) { unsigned r; asm volatile("v_cvt_pk_bf16_f32 %0, %1, %2" : "=v"(r) : "v"(lo), "v"(hi)); return r; }
typedef float f32x2 __attribute__((ext_vector_type(2)));
__device__ __forceinline__ f32x2 gelu_pk(f32x2 v) {
    const f32x2 av = __builtin_elementwise_abs(v), d = av * 0.2316418882f + 1.0f;
    f32x2 t; t.x = __builtin_amdgcn_rcpf(d.x); t.y = __builtin_amdgcn_rcpf(d.y);
    f32x2 q = t * 0.5307027145f + (-0.7265760135f); q = q * t + 0.7107068705f; q = q * t + (-0.142248368f); q = q * t + 0.127414796f; q = q * t;
    const f32x2 s = (v * v) * (-0.72134752044f);
    f32x2 e; e.x = __builtin_amdgcn_exp2f(s.x); e.y = __builtin_amdgcn_exp2f(s.y);
    const f32x2 m = v * (q * e), r = v - m;
    f32x2 o; o.x = v.x < 0.f ? m.x : r.x; o.y = v.y < 0.f ? m.y : r.y; return o;
}

struct EpiProj0 {
    static constexpr bool PERM = true, AFTER_DRAIN = false;
    bf16_t* O; const float* rope; float c2;
    __device__ __forceinline__ void operator()(const f32x4 (&acc)[2][2][4][2], const Unit& u, int wr, int wc, int fr, int fq) const {
        const int row0 = u.pm * BM + wr * 64 + fr, col0 = u.pn * BM + wc * 32 + 8 * fq, pn = u.pn;
        const bool do_rope = (pn >= 6 && pn <= 9);
        const float sc = (pn <= 1 || pn == 6 || pn == 7) ? c2 : 1.f;
        const int i0 = 16 * (wc & 1) + 4 * fq;
#pragma unroll
        for (int ai = 0; ai < 2; ++ai)
#pragma unroll
            for (int m = 0; m < 4; ++m) { const int row = row0 + ai * HALF + m * 16;
                f32x4 cs0 = {1.f, 0.f, 1.f, 0.f}, cs1 = {1.f, 0.f, 1.f, 0.f};
                if (do_rope) { const f32x4* rp = (const f32x4*)(rope + (size_t)row * 64 + 2 * i0); cs0 = rp[0]; cs1 = rp[1]; }
                const f32x4 c = {cs0[0], cs0[2], cs1[0], cs1[2]}, s = {cs0[1], cs0[3], cs1[1], cs1[3]};
#pragma unroll
                for (int bj = 0; bj < 2; ++bj) { f32x4 v0 = acc[ai][bj][m][0], v1 = acc[ai][bj][m][1];
                    if (do_rope) { const f32x4 o0 = v0 * c - v1 * s, o1 = v0 * s + v1 * c; v0 = o0; v1 = o1; }
                    v0 = v0 * sc; v1 = v1 * sc; u32x4 w; w.x = cvt_pk_bf16(v0[0], v0[1]); w.y = cvt_pk_bf16(v0[2], v0[3]); w.z = cvt_pk_bf16(v1[0], v1[1]); w.w = cvt_pk_bf16(v1[2], v1[3]);
                    *(u32x4*)(O + (size_t)row * 4096 + col0 + bj * HALF) = w; } }
    }
};
struct EpiProj1 {
    static constexpr bool PERM = true, AFTER_DRAIN = false;
    bf16_t* O;
    __device__ __forceinline__ void operator()(const f32x4 (&acc)[2][2][4][2], const Unit& u, int wr, int wc, int fr, int fq) const {
        const int row0 = u.pm * BM + wr * 64 + fr, col0 = u.pn * BM + wc * 32 + 8 * fq, pn = u.pn;
        const float sc = (pn == 2 || pn == 3) ? 0.125f : 1.f;
#pragma unroll
        for (int ai = 0; ai < 2; ++ai)
#pragma unroll
            for (int m = 0; m < 4; ++m) { const int row = row0 + ai * HALF + m * 16;
#pragma unroll
                for (int bj = 0; bj < 2; ++bj) { const f32x4 v0 = acc[ai][bj][m][0] * sc, v1 = acc[ai][bj][m][1] * sc;
                    u32x4 w; w.x = cvt_pk_bf16(v0[0], v0[1]); w.y = cvt_pk_bf16(v0[2], v0[3]); w.z = cvt_pk_bf16(v1[0], v1[1]); w.w = cvt_pk_bf16(v1[2], v1[3]);
                    *(u32x4*)(O + (size_t)row * 4096 + col0 + bj * HALF) = w; } }
    }
};
struct EpiResid {
    static constexpr bool PERM = true, AFTER_DRAIN = false;
    const float* base; float* out;
    __device__ __forceinline__ void operator()(const f32x4 (&acc)[2][2][4][2], const Unit& u, int wr, int wc, int fr, int fq) const {
        const int row0 = u.pm * BM + wr * 64 + fr, col0 = u.pn * BM + wc * 32 + 8 * fq;
#pragma unroll
        for (int ai = 0; ai < 2; ++ai)
#pragma unroll
            for (int m = 0; m < 4; ++m) { const size_t p = (size_t)(row0 + ai * HALF + m * 16) * 1024 + col0;
#pragma unroll
                for (int bj = 0; bj < 2; ++bj) { const f32x4 b0 = *(const f32x4*)(base + p + bj * HALF), b1 = *(const f32x4*)(base + p + bj * HALF + 4);
                    *(f32x4*)(out + p + bj * HALF) = b0 + acc[ai][bj][m][0]; *(f32x4*)(out + p + bj * HALF + 4) = b1 + acc[ai][bj][m][1]; } }
    }
};

template <class Epi, class Sched, bool ALIGN_EPI = false, bool SP2 = false>
__device__ __forceinline__ void gemm_phase(PG8_LAS unsigned char* lds, const Gemm g, const Sched& S, const Epi& E) {
    const int tid = threadIdx.x, wid = __builtin_amdgcn_readfirstlane(tid >> 6), lane = tid & 63, wr = wid >> 2, wc = wid & 3, fr = lane & 15, fq = lane >> 4;
    const int K = g.K, nt = K / BK;
    unsigned voffA[2], voffB[2];
#pragma unroll
    for (int i = 0; i < 2; ++i) { int R, C; stage_rc(tid * 16 + i * 8192, R, C); const int Rb = Epi::PERM ? ((R & ~31) + perm32(R & 31)) : R;
        voffA[i] = (unsigned)(R * K + C) * 2u; voffB[i] = (unsigned)(Rb * K + C) * 2u; }
    const size_t kstep = (size_t)(BK * 2);
    const size_t hstep = (size_t)HALF * K * 2;
    const size_t tstep = 2 * hstep;
    const unsigned ldsw = (unsigned)wid * 1024u;
    const int aoff = lds_byte(wr * 64 + fr, fq * 8), boff = lds_byte(wc * 32 + fr, fq * 8);
#define PG8_SA(b, h) (((b) * 2 + (h)) * HTB)
#define PG8_SB(b, h) ((4 + (b) * 2 + (h)) * HTB)
#define PG8_STAGE(bufoff, gbase, voff) do { _Pragma("unroll") for (int _i = 0; _i < 2; ++_i) \
        __builtin_amdgcn_global_load_lds((const unsigned*)((const char*)(gbase) + (voff)[_i]), (PG8_LAS unsigned*)(lds + (bufoff) + ldsw + _i * 8192), 16, 0, 0); } while (0)
#define PG8_LDA(dst, b, h) do { _Pragma("unroll") for (int m = 0; m < 4; ++m) _Pragma("unroll") for (int k = 0; k < 2; ++k) dst[m][k] = *(const PG8_LAS bf16x8*)(lds + PG8_SA(b, h) + aoff + m * 2048 + k * 1024); } while (0)
#define PG8_LDB(dst, b, h) do { _Pragma("unroll") for (int n = 0; n < 2; ++n) _Pragma("unroll") for (int k = 0; k < 2; ++k) dst[n][k] = *(const PG8_LAS bf16x8*)(lds + PG8_SB(b, h) + boff + n * 2048 + k * 1024); } while (0)
#define PG8_MMA(ai, bj, At, Bt) do { __builtin_amdgcn_s_setprio(1); _Pragma("unroll") for (int m = 0; m < 4; ++m) _Pragma("unroll") for (int n = 0; n < 2; ++n) _Pragma("unroll") for (int k = 0; k < 2; ++k) \
        acc[ai][bj][m][n] = __builtin_amdgcn_mfma_f32_16x16x32_bf16(Bt[n][k], At[m][k], acc[ai][bj][m][n], 0, 0, 0); __builtin_amdgcn_s_setprio(0); } while (0)
#define PG8_WAIT_V(n) asm volatile("s_waitcnt vmcnt(" #n ")" ::: "memory")
#define PG8_WAIT_L(n) asm volatile("s_waitcnt lgkmcnt(" #n ")" ::: "memory")
#define PG8_BAR __builtin_amdgcn_s_barrier()
#define PG8_SCHED __builtin_amdgcn_sched_barrier(0)
    Unit cur, nxt; int ui = 0;
    if (!S.next(0, cur)) return;
    f32x4 acc[2][2][4][2];
#pragma unroll
    for (int a = 0; a < 2; ++a)
#pragma unroll
        for (int b = 0; b < 2; ++b)
#pragma unroll
            for (int m = 0; m < 4; ++m)
#pragma unroll
                for (int n = 0; n < 2; ++n) acc[a][b][m][n] = (f32x4){0.f, 0.f, 0.f, 0.f};
    bf16x8 At[4][2], B0[2][2], B1[2][2];
    const char* cA = (const char*)g.A + (size_t)cur.pm * tstep; const char* cB = (const char*)g.Bt + (size_t)cur.pn * tstep;
    S.a_ready(cur);
    if constexpr (SP2) {
        PG8_STAGE(PG8_SB(0, 0), cB, voffB); PG8_STAGE(PG8_SB(0, 1), cB + hstep, voffB); PG8_STAGE(PG8_SA(0, 0), cA, voffA); PG8_STAGE(PG8_SA(0, 1), cA + hstep, voffA);
        if (wr == 1) PG8_BAR;
        PG8_WAIT_V(2); PG8_BAR;
        PG8_STAGE(PG8_SB(1, 0), cB + kstep, voffB); PG8_STAGE(PG8_SA(1, 0), cA + kstep, voffA); PG8_STAGE(PG8_SB(1, 1), cB + hstep + kstep, voffB);
        PG8_WAIT_V(6); PG8_BAR;
    } else {
        PG8_STAGE(PG8_SB(0, 0), cB, voffB); PG8_STAGE(PG8_SA(0, 0), cA, voffA); PG8_STAGE(PG8_SB(0, 1), cB + hstep, voffB); PG8_STAGE(PG8_SA(0, 1), cA + hstep, voffA);
        if (wr == 1) PG8_BAR;
        PG8_WAIT_V(4); PG8_BAR;
        PG8_STAGE(PG8_SB(1, 0), cB + kstep, voffB); PG8_STAGE(PG8_SA(1, 0), cA + kstep, voffA); PG8_STAGE(PG8_SB(1, 1), cB + hstep + kstep, voffB);
        PG8_WAIT_V(6); PG8_BAR;
    }
    for (;;) {
        const bool has_next = S.next(ui + 1, nxt);
        const char* nA = has_next ? (const char*)g.A + (size_t)nxt.pm * tstep : cA; const char* nB = has_next ? (const char*)g.Bt + (size_t)nxt.pn * tstep : cB;
        for (int t = 0; t < nt; t += 2) {
            const bool last = (t == nt - 2);
            const char* a1 = cA + (size_t)(t + 1) * kstep;
            const char* a2 = last ? nA : cA + (size_t)(t + 2) * kstep; const char* b2 = last ? nB : cB + (size_t)(t + 2) * kstep;
            const char* a3 = a2 + kstep; const char* b3 = b2 + kstep;
            if (last && has_next) S.a_ready(nxt);
            if constexpr (SP2) {
            PG8_LDB(B0, 0, 0); PG8_LDB(B1, 0, 1); PG8_SCHED; PG8_LDA(At, 0, 0); PG8_STAGE(PG8_SA(1, 1), a1 + hstep, voffA);
            PG8_WAIT_V(8); PG8_WAIT_L(0); PG8_BAR; PG8_MMA(0, 0, At, B0); PG8_MMA(0, 1, At, B1); PG8_BAR; PG8_SCHED;
            PG8_LDA(At, 0, 1); PG8_STAGE(PG8_SB(0, 0), b2, voffB); PG8_STAGE(PG8_SB(0, 1), b2 + hstep, voffB); PG8_STAGE(PG8_SA(0, 0), a2, voffA);
            PG8_WAIT_V(8); PG8_WAIT_L(0); PG8_BAR; PG8_MMA(1, 0, At, B0); PG8_MMA(1, 1, At, B1); PG8_BAR; PG8_SCHED;
            PG8_LDB(B0, 1, 0); PG8_LDB(B1, 1, 1); PG8_SCHED; PG8_LDA(At, 1, 0); PG8_STAGE(PG8_SA(0, 1), a2 + hstep, voffA);
            PG8_WAIT_V(8); PG8_WAIT_L(0); PG8_BAR; PG8_MMA(0, 0, At, B0); PG8_MMA(0, 1, At, B1); PG8_BAR; PG8_SCHED;
            PG8_LDA(At, 1, 1); PG8_STAGE(PG8_SB(1, 0), b3, voffB); PG8_STAGE(PG8_SB(1, 1), b3 + hstep, voffB); PG8_STAGE(PG8_SA(1, 0), a3, voffA);
            PG8_WAIT_V(8); PG8_WAIT_L(0); PG8_BAR; PG8_MMA(1, 0, At, B0); PG8_MMA(1, 1, At, B1); PG8_BAR; PG8_SCHED;
            } else {
            PG8_LDB(B0, 0, 0); PG8_SCHED; PG8_LDA(At, 0, 0); PG8_STAGE(PG8_SA(1, 1), a1 + hstep, voffA);
            PG8_WAIT_L(8); PG8_BAR; PG8_WAIT_L(0); PG8_MMA(0, 0, At, B0); PG8_BAR; PG8_SCHED;
            PG8_LDB(B1, 0, 1); PG8_STAGE(PG8_SB(0, 0), b2, voffB);
            PG8_BAR; PG8_WAIT_L(0); PG8_MMA(0, 1, At, B1); PG8_BAR;
            PG8_LDA(At, 0, 1); PG8_STAGE(PG8_SA(0, 0), a2, voffA);
            PG8_BAR; PG8_WAIT_L(0); PG8_MMA(1, 0, At, B0); PG8_BAR; PG8_SCHED;
            PG8_STAGE(PG8_SB(0, 1), b2 + hstep, voffB);
            PG8_WAIT_V(6); PG8_BAR; PG8_MMA(1, 1, At, B1); PG8_BAR;
            PG8_LDB(B0, 1, 0); PG8_SCHED; PG8_LDA(At, 1, 0); PG8_STAGE(PG8_SA(0, 1), a2 + hstep, voffA);
            PG8_WAIT_L(8); PG8_BAR; PG8_WAIT_L(0); PG8_MMA(0, 0, At, B0); PG8_BAR; PG8_SCHED;
            PG8_LDB(B1, 1, 1); PG8_STAGE(PG8_SB(1, 0), b3, voffB);
            PG8_BAR; PG8_WAIT_L(0); PG8_MMA(0, 1, At, B1); PG8_BAR;
            PG8_LDA(At, 1, 1); PG8_STAGE(PG8_SA(1, 0), a3, voffA);
            PG8_BAR; PG8_WAIT_L(0); PG8_MMA(1, 0, At, B0); PG8_BAR; PG8_SCHED;
            PG8_STAGE(PG8_SB(1, 1), b3 + hstep, voffB);
            PG8_WAIT_V(6); PG8_BAR; PG8_MMA(1, 1, At, B1); PG8_BAR;
            }
        }
        if constexpr (ALIGN_EPI) { if (wr == 0) PG8_BAR; }
        if constexpr (!Epi::AFTER_DRAIN) { E(acc, cur, wr, wc, fr, fq); S.done(cur); }
        if (!has_next) break;
#pragma unroll
        for (int a = 0; a < 2; ++a)
#pragma unroll
            for (int b = 0; b < 2; ++b)
#pragma unroll
                for (int m = 0; m < 4; ++m)
#pragma unroll
                    for (int n = 0; n < 2; ++n) acc[a][b][m][n] = (f32x4){0.f, 0.f, 0.f, 0.f};
        cur = nxt; cA = nA; cB = nB; ++ui;
        if constexpr (ALIGN_EPI) { if (wr == 1) PG8_BAR; }
    }
    PG8_WAIT_V(0);
    if constexpr (!ALIGN_EPI) { if (wr == 0) PG8_BAR; }
    PG8_BAR;
    if constexpr (Epi::AFTER_DRAIN) { E.fused(acc, cur, wr, wc, fr, fq, lds, wid, lane); S.done(cur); }
#undef PG8_SA
#undef PG8_SB
#undef PG8_STAGE
#undef PG8_LDA
#undef PG8_LDB
#undef PG8_MMA
#undef PG8_WAIT_V
#undef PG8_WAIT_L
#undef PG8_BAR
#undef PG8_SCHED
}
}
constexpr int NWAVES = 8;
#ifndef MK_ONE_LAUNCH
#define MK_ONE_LAUNCH 0
#endif
constexpr int BATCH = 2, SEQ = 16384, D = 1024, M = BATCH * SEQ, NPJ = 4096;
constexpr int ATTN_IN = 4104, ML_IN = 4112;
constexpr float RMS_EPS = 1e-6f, LOG2E = 1.4426950408889634f, C2 = 0.125f * 1.4426950408889634f;
constexpr int NPHASE = 10;
constexpr size_t MiB = 1u << 20;
constexpr size_t WS_CTL = 0, CTL_ZERO_BYTES = 1 * MiB;
constexpr size_t WS_LOGF = 1 * MiB, WS_F2 = 2 * MiB, WS_QE = 3 * MiB, WS_KE = 7 * MiB, WS_LI = 11 * MiB, WS_LF = 12 * MiB;
constexpr size_t WS_GB = 13 * MiB, WS_GE = 14 * MiB, WS_GU = 15 * MiB, WS_CHA = 16 * MiB, WS_CHE = 16 * MiB + 65536, WS_CHM = 16 * MiB + 131072;
constexpr size_t WS_DN = 17 * MiB, WS_NS = 17 * MiB + 524288;
constexpr size_t WS_ROPE = 18 * MiB, WS_WIN0 = 26 * MiB, WS_WOUT0 = 34 * MiB, WS_WIN1 = 36 * MiB, WS_WOUT1 = 44 * MiB;
constexpr size_t WS_XN = 48 * MiB;
constexpr size_t WS_PROJ = 112 * MiB;
constexpr size_t WS_OB = 368 * MiB;
constexpr size_t WS_END = 464 * MiB;
constexpr int CW_TMO = 0, CW_CODE = 1, CW_BAR = 4096;
constexpr int RING_OFF = 0, RING_BYTES = 131072;
constexpr int LDSCTL_OFF = RING_BYTES, MISC_OFF = LDSCTL_OFF + 320;
constexpr int LDS_BYTES = 147456;
static_assert(MISC_OFF + 128 <= LDS_BYTES, "LDS map");
#define GAS __attribute__((address_space(1)))
#define LAS __attribute__((address_space(3)))
typedef unsigned short bf16;
typedef unsigned v4u __attribute__((ext_vector_type(4)));
typedef float f32x4 __attribute__((ext_vector_type(4)));
typedef short bf16x8 __attribute__((ext_vector_type(8)));
typedef GAS unsigned gu32;
typedef GAS unsigned long long gu64;
#define RLX_AGENT __ATOMIC_RELAXED, __HIP_MEMORY_SCOPE_AGENT
#define LDS_WAIT() asm volatile("s_waitcnt lgkmcnt(0)" ::: "memory")
#define VM_WAIT() asm volatile("s_waitcnt vmcnt(0)" ::: "memory")
__device__ __forceinline__ unsigned long long rt() { return __builtin_amdgcn_s_memrealtime(); }
__device__ __forceinline__ unsigned f2bf(float f) { unsigned u = __builtin_bit_cast(unsigned, f); return (u + 0x7fffu + ((u >> 16) & 1u)) >> 16; }
__device__ __forceinline__ unsigned pk2(float lo, float hi) { return f2bf(lo) | (f2bf(hi) << 16); }
#define XB_TMO      128
#define XB_XCNT(j)  (256  + 64 * (j))
#define XB_XSUB(j)  (1280 + 64 * (j))
#define XB_XGEN(j)  (2304 + 64 * (j))
#define XB_TOP      3328
#define XB_TOPGEN   3392
#define XCD_BAR_WORDS 3456
#define XB_SPIN_CAP (1u << 18)

__device__ __forceinline__ unsigned xb_ld(unsigned* p)              { return __hip_atomic_load(p, __ATOMIC_RELAXED, __HIP_MEMORY_SCOPE_AGENT); }
__device__ __forceinline__ unsigned xb_add(unsigned* p, unsigned v) { return __hip_atomic_fetch_add(p, v, __ATOMIC_RELAXED, __HIP_MEMORY_SCOPE_AGENT); }
__device__ __forceinline__ unsigned xb_xcc_id() { return (unsigned)__builtin_amdgcn_s_getreg((3 << 11) | 20) & 0xFu; }
#define XB_SPIN(cond, bar) do { unsigned _sp = 0; while (cond) { __builtin_amdgcn_s_sleep(1); \
    if ((++_sp & 255u) == 0u) { if (xb_ld(&(bar)[XB_TMO])) break; if (_sp > XB_SPIN_CAP) { atomicAdd(&(bar)[XB_TMO], 1u); break; } } } } while (0)

struct XcdBarrier {
    unsigned* bar; unsigned x;
    volatile LAS unsigned* st;
};

__device__ __forceinline__ XcdBarrier xcd_barrier_post(unsigned* bar, volatile LAS unsigned* st) {
    XcdBarrier b; b.bar = bar; b.x = xb_xcc_id(); b.st = st;
    if (threadIdx.x == 0) (void)xb_add(&bar[XB_XCNT(b.x)], 1u);
    return b;
}
__device__ __forceinline__ void xcd_barrier_complete(unsigned* bar, unsigned x, unsigned& nloc, unsigned& nx) {
    const unsigned G = gridDim.x * gridDim.y * gridDim.z;
    unsigned sum, cnt, mine, sp = 0u;
    for (;;) {
        sum = 0u; cnt = 0u; mine = 0u;
#pragma unroll
        for (unsigned j = 0; j < 16; ++j) { const unsigned c = xb_ld(&bar[XB_XCNT(j)]); sum += c; cnt += (c > 0u) ? 1u : 0u; mine = (j == x) ? c : mine; }
        if (sum == G) break;
        __builtin_amdgcn_s_sleep(1);
        if ((++sp & 255u) == 0u) { if (xb_ld(&bar[XB_TMO])) break; if (sp > XB_SPIN_CAP) { atomicAdd(&bar[XB_TMO], 1u); break; } }
    }
    nloc = mine > 0u ? mine : 1u; nx = cnt > 0u ? cnt : 1u;
}

__device__ __forceinline__ void xcd_barrier(const XcdBarrier& b) {
    asm volatile("s_waitcnt vmcnt(0)" ::: "memory");
    __syncthreads();
    if (threadIdx.x == 0) {
        unsigned* bar = b.bar;
        __builtin_amdgcn_s_waitcnt(0);
        unsigned nloc = b.st[0], nx = b.st[1];
        if (nloc == 0u) { xcd_barrier_complete(bar, b.x, nloc, nx); b.st[0] = nloc; b.st[1] = nx; }
        const unsigned old = xb_add(&bar[XB_XSUB(b.x)], 1u);
        const unsigned gen = old / nloc;
        if (old + 1u == (gen + 1u) * nloc) {
            __builtin_amdgcn_fence(__ATOMIC_RELEASE, "agent");
            asm volatile("s_waitcnt vmcnt(0)" ::: "memory");
            const unsigned og = xb_add(&bar[XB_TOP], 1u);
            const unsigned tg = og / nx;
            if (og + 1u == (tg + 1u) * nx) xb_add(&bar[XB_TOPGEN], 1u);
            else XB_SPIN(xb_ld(&bar[XB_TOPGEN]) == tg, bar);
            __builtin_amdgcn_fence(__ATOMIC_ACQUIRE, "agent");
            xb_add(&bar[XB_XGEN(b.x)], 1u);
            asm volatile("s_waitcnt vmcnt(0)" ::: "memory");
        } else {
            XB_SPIN(xb_ld(&bar[XB_XGEN(b.x)]) == gen, bar);
            __builtin_amdgcn_fence(__ATOMIC_ACQUIRE, "agent");
            asm volatile("s_waitcnt vmcnt(0)" ::: "memory");
        }
    }
    __syncthreads();
}
__device__ __forceinline__ float wave_sum(float v) {
#pragma unroll
    for (int o = 1; o < 64; o <<= 1) v += __shfl_xor(v, o);
    return v;
}
__device__ __forceinline__ float bf2f(unsigned short b) { return __builtin_bit_cast(float, (unsigned)b << 16); }
__device__ __forceinline__ float bflo(unsigned w) { return __builtin_bit_cast(float, w << 16); }
__device__ __forceinline__ float bfhi(unsigned w) { return __builtin_bit_cast(float, w & 0xffff0000u); }
__device__ __forceinline__ float log_sigmoid_f(float x) { return fminf(x, 0.f) - log1pf(__expf(-fabsf(x))); }
__device__ __forceinline__ float sigmoid_f(float x) { return 1.f / (1.f + __expf(-x)); }
__device__ __forceinline__ float silu_f(float x) { return x / (1.f + __expf(-x)); }

struct Ctx {
    LAS unsigned char* lds; int tid, lane, wave, G, bid;
    const float* in[17]; float* out; unsigned char* ws;
};
__device__ __forceinline__ int src_col0(int P) {
    if (P < 1536) return P;
    if (P < 2560) { const int q = P - 1536, grp = q >> 6, p = q & 63; return 1544 + grp * 64 + 16 * (p >> 5) + 4 * ((p >> 3) & 3) + (p & 3) + 32 * ((p >> 2) & 1); }
    return P + 8;
}
__device__ __forceinline__ int src_col1(int P) { return P < 2048 ? P : P + 16; }
__device__ __forceinline__ void transpose_item(const float* W, int ldw, const float* gain, bf16* WT, LAS float* scr, int kb, int nb, int lane, int srcc) {
    const int k0 = 64 * kb, n0 = 32 * nb;
#pragma unroll 8
    for (int i = 0; i < 32; ++i) { const int kk = 2 * i + (lane >> 5); const float g = gain ? gain[k0 + kk] : 1.f; scr[kk * 33 + (lane & 31)] = W[(size_t)(k0 + kk) * ldw + srcc] * g; }
    LDS_WAIT(); asm volatile("" ::: "memory");
    const int c = lane & 7;
#pragma unroll
    for (int j = 0; j < 4; ++j) { const int n = (lane >> 3) + 8 * j; const LAS float* s = scr + (8 * c) * 33 + n;
        v4u o; o.x = pk2(s[0 * 33], s[1 * 33]); o.y = pk2(s[2 * 33], s[3 * 33]); o.z = pk2(s[4 * 33], s[5 * 33]); o.w = pk2(s[6 * 33], s[7 * 33]);
        *(GAS v4u*)(WT + (size_t)(n0 + n) * 1024 + k0 + 8 * c) = o; }
    LDS_WAIT(); asm volatile("" ::: "memory");
}
__device__ __constant__ const double kInvFreq[32] = {1.0, 0.7498942093324559, 0.5623413251903491, 0.4216965034285822, 0.31622776601683794, 0.23713737056616552, 0.1778279410038923, 0.1333521432163324, 0.1, 0.07498942093324558,
    0.05623413251903491, 0.042169650342858224, 0.03162277660168379, 0.023713737056616554, 0.01778279410038923, 0.01333521432163324, 0.01, 0.007498942093324558, 0.005623413251903491, 0.004216965034285823, 0.0031622776601683794,
    0.0023713737056616554, 0.0017782794100389228, 0.001333521432163324, 0.001, 0.0007498942093324559, 0.0005623413251903491, 0.00042169650342858224, 0.00031622776601683794, 0.00023713737056616554, 0.00017782794100389227, 0.0001333521432163324};

__device__ __forceinline__ void prologue_weights(const Ctx& C) {
    LAS float* scr = (LAS float*)(C.lds + RING_OFF + C.wave * 16384);
    const int gw = C.bid * NWAVES + C.wave, NGW = C.G * NWAVES;
    bf16* Win0 = (bf16*)(C.ws + WS_WIN0); bf16* Wout0 = (bf16*)(C.ws + WS_WOUT0); bf16* Win1 = (bf16*)(C.ws + WS_WIN1); bf16* Wout1 = (bf16*)(C.ws + WS_WOUT1);
    constexpr int I_IN = 16 * 128, I_OUT = 16 * 32, NITEMS = 2 * I_IN + 2 * I_OUT;
    for (int it = gw; it < NITEMS; it += NGW) {
        int r = it;
        if (r < I_IN) { const int kb = r / 128, nb = r % 128; transpose_item(C.in[3], ATTN_IN, C.in[2], Win0, scr, kb, nb, C.lane, src_col0(32 * nb + (C.lane & 31))); continue; } r -= I_IN;
        if (r < I_IN) { const int kb = r / 128, nb = r % 128; transpose_item(C.in[12], ML_IN, C.in[11], Win1, scr, kb, nb, C.lane, src_col1(32 * nb + (C.lane & 31))); continue; } r -= I_IN;
        if (r < I_OUT) { const int kb = r / 32, nb = r % 32; transpose_item(C.in[10], 1024, nullptr, Wout0, scr, kb, nb, C.lane, 32 * nb + (C.lane & 31)); continue; } r -= I_OUT;
        { const int kb = r / 32, nb = r % 32; transpose_item(C.in[15], 1024, nullptr, Wout1, scr, kb, nb, C.lane, 32 * nb + (C.lane & 31)); }
    }
    const int* pos = (const int*)C.in[1]; float* rope = (float*)(C.ws + WS_ROPE);
    for (int idx = C.bid * (NWAVES * 64) + C.tid; idx < M * 32; idx += C.G * NWAVES * 64) { const int m = idx >> 5, i = idx & 31;
        double rev = (double)pos[m] * kInvFreq[i] * 0.15915494309189535; rev -= floor(rev); const float rf = (float)rev;
        *(float2*)(rope + (size_t)idx * 2) = make_float2(__builtin_amdgcn_cosf(rf), __builtin_amdgcn_sinf(rf)); }
}
template <int NG>
__device__ __forceinline__ void norm_gate_phase(const Ctx& C, const float* X, const float* W, int ldw, int gcol0, const float* gain, const float* bias_a, const float* bias_b, bf16* XN, float* outA, float* outB) {
    LAS float* tab = (LAS float*)(C.lds + RING_OFF);
    for (int i = C.tid; i < 1024 * NG; i += NWAVES * 64) { const int k = i / NG, c = i % NG; const int j = k >> 8, l = (k >> 2) & 63, e = k & 3;
        tab[((j * 4 + e) * 64 + l) * NG + c] = W[(size_t)k * ldw + gcol0 + c] * gain[k]; }
    __syncthreads();
    const int gw = C.bid * NWAVES + C.wave, NGW = C.G * NWAVES;
    for (int m = gw; m < M; m += NGW) {
        const GAS f32x4* xr = (const GAS f32x4*)(X + (size_t)m * D) + C.lane;
        f32x4 v[4]; float ss = 0.f;
#pragma unroll
        for (int j = 0; j < 4; ++j) { v[j] = xr[64 * j]; ss += (v[j].x * v[j].x + v[j].y * v[j].y) + (v[j].z * v[j].z + v[j].w * v[j].w); }
        const float rstd = 1.f / sqrtf(wave_sum(ss) * (1.f / D) + RMS_EPS);
        GAS unsigned long long* o8 = (GAS unsigned long long*)(XN + (size_t)m * D) + C.lane;
#pragma unroll
        for (int j = 0; j < 4; ++j) o8[64 * j] = (unsigned long long)pk2(v[j].x * rstd, v[j].y * rstd) | ((unsigned long long)pk2(v[j].z * rstd, v[j].w * rstd) << 32);
        float acc[NG];
#pragma unroll
        for (int c = 0; c < NG; ++c) acc[c] = 0.f;
#pragma unroll
        for (int j = 0; j < 4; ++j)
#pragma unroll
            for (int e = 0; e < 4; ++e) { const float xv = v[j][e]; const LAS f32x4* tp = (const LAS f32x4*)(tab + ((j * 4 + e) * 64 + C.lane) * NG);
#pragma unroll
                for (int c4 = 0; c4 < NG / 4; ++c4) { const f32x4 w = tp[c4]; acc[4 * c4] += xv * w.x; acc[4 * c4 + 1] += xv * w.y; acc[4 * c4 + 2] += xv * w.z; acc[4 * c4 + 3] += xv * w.w; }
                if ((e & 1) == 1) asm volatile("" ::: "memory"); }
        float mine = 0.f;
#pragma unroll
        for (int c = 0; c < NG; ++c) { const float s = wave_sum(acc[c]) * rstd; mine = (C.lane == c) ? s : mine; }
        if (NG == 8) { if (C.lane < 8) outA[(size_t)m * 8 + C.lane] = log_sigmoid_f(mine + bias_a[C.lane]); }
        else { if (C.lane < 8) outA[(size_t)m * 8 + C.lane] = mine + bias_a[C.lane];
               else if (C.lane < 16) outB[(size_t)m * 8 + C.lane - 8] = log_sigmoid_f(mine + bias_b[C.lane - 8]); }
    }
}
__device__ __forceinline__ void cumsum_phase(const Ctx& C) {
    if (C.bid >= 16) return;
    const int bh = C.bid, b = bh >> 3, h = bh & 7, t = C.tid;
    const float* lp = (const float*)(C.ws + WS_LOGF) + ((size_t)b * SEQ + 32 * t) * 8 + h;
    float v[32]; float run = 0.f;
#pragma unroll
    for (int i = 0; i < 32; ++i) { run += lp[i * 8]; v[i] = run; }
    float x = run;
#pragma unroll
    for (int o = 1; o < 64; o <<= 1) { const float y = __shfl_up(x, o); if (C.lane >= o) x += y; }
    volatile LAS float* wt = (volatile LAS float*)(C.lds + LDSCTL_OFF);
    if (C.lane == 63) wt[C.wave] = x;
    __syncthreads();
    float off = x - run;
    for (int w = 0; w < C.wave; ++w) off += wt[w];
    float* F2 = (float*)(C.ws + WS_F2) + (size_t)bh * SEQ + 32 * t;
#pragma unroll
    for (int i = 0; i < 32; ++i) F2[i] = (off + v[i]) * LOG2E;
    __syncthreads();
}
__device__ __forceinline__ void he_cols(int he, int& qc, int& kc, int& vc, int& oc) {
    if (he < 8) { qc = he * 64; kc = 512 + he * 64; vc = 1024 + he * 64; oc = he * 64; }
    else { const int j = he - 8, hd = j >> 2, c = (j >> 1) & 1, e = j & 1; qc = 1536 + (hd * 2 + c) * 64; kc = 2048 + (hd * 2 + c) * 64; vc = 2560 + hd * 128 + e * 64; oc = 512 + j * 64; }
}
__device__ __forceinline__ void naive_attn_phase(const Ctx& C) {
    const bf16* P = (const bf16*)(C.ws + WS_PROJ); bf16* OB = (bf16*)(C.ws + WS_OB); const float* F2 = (const float*)(C.ws + WS_F2);
    const int gw = C.bid * NWAVES + C.wave, NGW = C.G * NWAVES;
    for (int it = gw; it < 2 * 24 * 256; it += NGW) {
        const int rb = 255 - it / 48, r = it % 48, b = r / 24, he = r % 24; int qc, kc, vc, oc; he_cols(he, qc, kc, vc, oc);
        const bool fox = he < 8; const int i = rb * 64 + C.lane; const size_t grow = (size_t)b * SEQ + i;
        float q[64], o[64];
        { const v4u* qp = (const v4u*)(P + grow * NPJ + qc);
#pragma unroll
          for (int c = 0; c < 8; ++c) { const v4u w = qp[c]; q[8 * c] = bflo(w.x); q[8 * c + 1] = bfhi(w.x); q[8 * c + 2] = bflo(w.y); q[8 * c + 3] = bfhi(w.y); q[8 * c + 4] = bflo(w.z); q[8 * c + 5] = bfhi(w.z); q[8 * c + 6] = bflo(w.w); q[8 * c + 7] = bfhi(w.w); } }
#pragma unroll
        for (int d = 0; d < 64; ++d) o[d] = 0.f;
        const float* Fh = F2 + (size_t)(b * 8 + (he & 7)) * SEQ; const float Fi = fox ? Fh[i] : 0.f;
        float mrun = -1e30f, l = 0.f; const int nk = rb * 64 + 64;
        for (int j = 0; j < nk; ++j) {
            const bf16* kr = P + ((size_t)b * SEQ + j) * NPJ; const v4u* kp = (const v4u*)(kr + kc); const v4u* vp = (const v4u*)(kr + vc);
            float s = 0.f;
#pragma unroll
            for (int c = 0; c < 8; ++c) { const v4u w = kp[c]; s += q[8 * c] * bflo(w.x) + q[8 * c + 1] * bfhi(w.x) + q[8 * c + 2] * bflo(w.y) + q[8 * c + 3] * bfhi(w.y) + q[8 * c + 4] * bflo(w.z) + q[8 * c + 5] * bfhi(w.z) + q[8 * c + 6] * bflo(w.w) + q[8 * c + 7] * bfhi(w.w); }
            if (fox) s += Fi - Fh[j];
            const bool valid = j <= i;
            const float mnew = valid ? fmaxf(mrun, s) : mrun;
            const float alpha = __builtin_amdgcn_exp2f(mrun - mnew), p = valid ? __builtin_amdgcn_exp2f(s - mnew) : 0.f;
            mrun = mnew; l = l * alpha + p;
#pragma unroll
            for (int c = 0; c < 8; ++c) { const v4u w = vp[c];
                o[8 * c] = o[8 * c] * alpha + p * bflo(w.x); o[8 * c + 1] = o[8 * c + 1] * alpha + p * bfhi(w.x); o[8 * c + 2] = o[8 * c + 2] * alpha + p * bflo(w.y); o[8 * c + 3] = o[8 * c + 3] * alpha + p * bfhi(w.y);
                o[8 * c + 4] = o[8 * c + 4] * alpha + p * bflo(w.z); o[8 * c + 5] = o[8 * c + 5] * alpha + p * bfhi(w.z); o[8 * c + 6] = o[8 * c + 6] * alpha + p * bflo(w.w); o[8 * c + 7] = o[8 * c + 7] * alpha + p * bfhi(w.w); }
        }
        const float rl = 1.f / l; v4u* op = (v4u*)(OB + grow * 1536 + oc);
#pragma unroll
        for (int c = 0; c < 8; ++c) { v4u w; w.x = pk2(o[8 * c] * rl, o[8 * c + 1] * rl); w.y = pk2(o[8 * c + 2] * rl, o[8 * c + 3] * rl); w.z = pk2(o[8 * c + 4] * rl, o[8 * c + 5] * rl); w.w = pk2(o[8 * c + 6] * rl, o[8 * c + 7] * rl); op[c] = w; }
    }
}
__device__ __forceinline__ void combine_phase(const Ctx& C) {
    const bf16* P = (const bf16*)(C.ws + WS_PROJ); const bf16* OB = (const bf16*)(C.ws + WS_OB); bf16* Y = (bf16*)(C.ws + WS_XN);
    float d1 = C.in[5][C.lane] * C.in[6][C.lane], d2 = C.in[7][C.lane] * C.in[8][C.lane];
    const float lam_init = 0.2f;
    const float lam = __expf(wave_sum(d1)) - __expf(wave_sum(d2)) + lam_init;
    const int gw = C.bid * NWAVES + C.wave, NGW = C.G * NWAVES, l = C.lane;
    const int hd = l >> 4, e = (l >> 3) & 1, d0 = (l & 7) * 8;
    float sg[8];
#pragma unroll
    for (int k = 0; k < 8; ++k) sg[k] = C.in[9][e * 64 + d0 + k] * (1.f - lam_init);
    for (int m = gw; m < M; m += NGW) {
        const bf16* ob = OB + (size_t)m * 1536; const bf16* z = P + (size_t)m * NPJ + 3072; bf16* y = Y + (size_t)m * 1024;
        { const v4u o = *(const v4u*)(ob + 8 * l), zz = *(const v4u*)(z + 8 * l); v4u w;
          w.x = pk2(bflo(o.x) * silu_f(bflo(zz.x)), bfhi(o.x) * silu_f(bfhi(zz.x))); w.y = pk2(bflo(o.y) * silu_f(bflo(zz.y)), bfhi(o.y) * silu_f(bfhi(zz.y)));
          w.z = pk2(bflo(o.z) * silu_f(bflo(zz.z)), bfhi(o.z) * silu_f(bfhi(zz.z))); w.w = pk2(bflo(o.w) * silu_f(bflo(zz.w)), bfhi(o.w) * silu_f(bfhi(zz.w)));
          *(v4u*)(y + 8 * l) = w; }
        const v4u a = *(const v4u*)(ob + 512 + ((hd * 2 + 0) * 2 + e) * 64 + d0), bb = *(const v4u*)(ob + 512 + ((hd * 2 + 1) * 2 + e) * 64 + d0), zz = *(const v4u*)(z + 512 + 8 * l);
        float v[8]; v[0] = bflo(a.x) - lam * bflo(bb.x); v[1] = bfhi(a.x) - lam * bfhi(bb.x); v[2] = bflo(a.y) - lam * bflo(bb.y); v[3] = bfhi(a.y) - lam * bfhi(bb.y);
        v[4] = bflo(a.z) - lam * bflo(bb.z); v[5] = bfhi(a.z) - lam * bfhi(bb.z); v[6] = bflo(a.w) - lam * bflo(bb.w); v[7] = bfhi(a.w) - lam * bfhi(bb.w);
        float ss = 0.f;
#pragma unroll
        for (int k = 0; k < 8; ++k) ss += v[k] * v[k];
#pragma unroll
        for (int o = 1; o < 16; o <<= 1) ss += __shfl_xor(ss, o);
        const float rs = 1.f / sqrtf(ss * (1.f / 128.f) + RMS_EPS);
        float zf[8] = {bflo(zz.x), bfhi(zz.x), bflo(zz.y), bfhi(zz.y), bflo(zz.z), bfhi(zz.z), bflo(zz.w), bfhi(zz.w)};
#pragma unroll
        for (int k = 0; k < 8; ++k) v[k] = v[k] * rs * sg[k] * silu_f(zf[k]);
        v4u w; w.x = pk2(v[0], v[1]); w.y = pk2(v[2], v[3]); w.z = pk2(v[4], v[5]); w.w = pk2(v[6], v[7]);
        *(v4u*)(y + 512 + 8 * l) = w;
    }
}
__device__ __forceinline__ void naive_mlstm_phase(const Ctx& C) {
    if (C.bid >= 16) return;
    const int bh = C.bid, b = bh >> 3, h = bh & 7, tid = C.tid;
    const bf16* P = (const bf16*)(C.ws + WS_PROJ); bf16* Y = (bf16*)(C.ws + WS_XN);
    const float* LI = (const float*)(C.ws + WS_LI); const float* LF = (const float*)(C.ws + WS_LF);
    LAS float* Cs = (LAS float*)(C.lds);
    LAS bf16* qs = (LAS bf16*)(C.lds + 32768);
    LAS bf16* ks = (LAS bf16*)(C.lds + 49152);
    LAS bf16* vs = (LAS bf16*)(C.lds + 65536);
    LAS float* ns = (LAS float*)(C.lds + 98304);
    LAS float* bbs = ns + 64; LAS float* lis = bbs + 128; LAS float* lfs = lis + 128; LAS float* wss = lfs + 128; LAS float* scal = wss + 128;
    for (int i = tid; i < 8192; i += 512) Cs[i] = 0.f;
    if (tid < 64) ns[tid] = 0.f;
    if (tid == 0) scal[0] = 0.f;
    __syncthreads();
    for (int c = 0; c < 128; ++c) {
        const size_t row0 = (size_t)b * SEQ + c * 128;
        for (int i = tid; i < 128 * 8; i += 512) { const int r = i >> 3, ch = i & 7;
            *(LAS v4u*)(qs + r * 64 + ch * 8) = *(const v4u*)(P + (row0 + r) * NPJ + h * 64 + ch * 8);
            *(LAS v4u*)(ks + r * 64 + ch * 8) = *(const v4u*)(P + (row0 + r) * NPJ + 512 + h * 64 + ch * 8); }
        for (int i = tid; i < 128 * 16; i += 512) { const int r = i >> 4, ch = i & 15; *(LAS v4u*)(vs + r * 128 + ch * 8) = *(const v4u*)(P + (row0 + r) * NPJ + 1024 + h * 128 + ch * 8); }
        if (tid < 128) { lis[tid] = LI[(row0 + tid) * 8 + h]; lfs[tid] = LF[(row0 + tid) * 8 + h]; }
        __syncthreads();
        if (tid == 0) { float run = 0.f; for (int t = 0; t < 128; ++t) { run += lfs[t]; bbs[t] = run; } }
        __syncthreads();
        const float mprev = scal[0], a = bbs[127];
        {
            const int t = tid & 127, qd = tid >> 7; const float bt = bbs[t];
            float mt = bt + mprev;
            for (int s = 0; s <= t; ++s) mt = fmaxf(mt, bt - bbs[s] + lis[s]);
            const float w_inter = __expf(bt + mprev - mt);
            float q[64];
#pragma unroll
            for (int d = 0; d < 64; ++d) q[d] = bf2f(qs[t * 64 + d]);
            float num[32]; float den = 0.f;
#pragma unroll
            for (int e = 0; e < 32; ++e) num[e] = 0.f;
            for (int s = 0; s <= t; ++s) {
                float qk = 0.f;
#pragma unroll
                for (int d = 0; d < 64; ++d) qk += q[d] * bf2f(ks[s * 64 + d]);
                const float sv = qk * __expf(bt - bbs[s] + lis[s] - mt); den += sv;
#pragma unroll
                for (int e = 0; e < 32; ++e) num[e] += sv * bf2f(vs[s * 128 + qd * 32 + e]);
            }
            float qn = 0.f;
#pragma unroll
            for (int d = 0; d < 64; ++d) qn += q[d] * ns[d];
            const float denT = w_inter * qn + den, dd = 1.f / fmaxf(fabsf(denT), __expf(-mt));
            const size_t grow = row0 + t; const bf16* og = P + grow * NPJ + 2048 + h * 128 + qd * 32; const bf16* zz = P + grow * NPJ + 3072 + h * 128 + qd * 32; bf16* yo = Y + grow * 1024 + h * 128 + qd * 32;
            float qc[32];
#pragma unroll
            for (int e = 0; e < 32; ++e) qc[e] = 0.f;
#pragma unroll
            for (int d = 0; d < 64; ++d) { const float qv = q[d];
#pragma unroll
                for (int e = 0; e < 32; ++e) qc[e] += qv * Cs[d * 128 + qd * 32 + e];
                asm volatile("" ::: "memory"); }
#pragma unroll
            for (int e = 0; e < 32; ++e) { const float hv = (w_inter * qc[e] + num[e]) * dd;
                yo[e] = (bf16)f2bf(sigmoid_f(bf2f(og[e])) * hv * silu_f(bf2f(zz[e]))); asm volatile("" ::: "memory"); }
        }
        if (tid < 128) wss[tid] = a - bbs[tid] + lis[tid];
        __syncthreads();
        if (tid == 0) { float mx = a + mprev; for (int s = 0; s < 128; ++s) mx = fmaxf(mx, wss[s]); scal[1] = mx; scal[2] = __expf(a + mprev - mx); }
        __syncthreads();
        const float mnew = scal[1], w_old = scal[2];
        __syncthreads();
        if (tid < 128) wss[tid] = __expf(wss[tid] - mnew);
        __syncthreads();
        for (int idx = tid; idx < 8192; idx += 512) { const int d = idx >> 7, e = idx & 127; float acc = 0.f;
            for (int s = 0; s < 128; ++s) acc += wss[s] * bf2f(ks[s * 64 + d]) * bf2f(vs[s * 128 + e]);
            Cs[idx] = w_old * Cs[idx] + acc; }
        if (tid < 64) { float acc = 0.f; for (int s = 0; s < 128; ++s) acc += wss[s] * bf2f(ks[s * 64 + tid]); ns[tid] = w_old * ns[tid] + acc; }
        if (tid == 0) scal[0] = mnew;
        __syncthreads();
    }
}
__device__ __forceinline__ void final_norm_phase(const Ctx& C) {
    const int gw = C.bid * NWAVES + C.wave, NGW = C.G * NWAVES; const float* g = C.in[16];
    f32x4 gv[4];
#pragma unroll
    for (int j = 0; j < 4; ++j) gv[j] = ((const f32x4*)g)[C.lane + 64 * j];
    for (int m = gw; m < M; m += NGW) {
        GAS f32x4* xr = (GAS f32x4*)(C.out + (size_t)m * D) + C.lane;
        f32x4 v[4]; float ss = 0.f;
#pragma unroll
        for (int j = 0; j < 4; ++j) { v[j] = xr[64 * j]; ss += (v[j].x * v[j].x + v[j].y * v[j].y) + (v[j].z * v[j].z + v[j].w * v[j].w); }
        const float rstd = 1.f / sqrtf(wave_sum(ss) * (1.f / D) + RMS_EPS);
#pragma unroll
        for (int j = 0; j < 4; ++j) xr[64 * j] = v[j] * rstd * gv[j];
    }
}
struct Args { const float* in[17]; float* out; unsigned char* ws; int ph_lo, ph_hi; };
__global__ void __launch_bounds__(NWAVES * 64, 2) fwd_kernel(Args args) {
    extern __shared__ __attribute__((aligned(16))) unsigned char lds[];
    Ctx C;
    C.lds = (LAS unsigned char*)lds; C.tid = threadIdx.x; C.lane = C.tid & 63; C.wave = __builtin_amdgcn_readfirstlane(C.tid >> 6); C.G = gridDim.x; C.bid = blockIdx.x;
#pragma unroll
    for (int i = 0; i < 17; ++i) C.in[i] = args.in[i];
    C.out = args.out; C.ws = args.ws;
    volatile LAS unsigned* MISC = (volatile LAS unsigned*)(C.lds + MISC_OFF);
    gu32* ctl = (gu32*)(C.ws + WS_CTL);
    for (int u = C.tid; u < (LDS_BYTES - LDSCTL_OFF) / 4; u += NWAVES * 64) ((LAS unsigned*)(C.lds + LDSCTL_OFF))[u] = 0u;
    __syncthreads();
    XcdBarrier bar; bar.bar = (unsigned*)(ctl + CW_BAR); bar.x = 0; bar.st = nullptr;
    if (MK_ONE_LAUNCH) bar = xcd_barrier_post((unsigned*)(ctl + CW_BAR), MISC + 8);
#define GRID_BAR() do { if (MK_ONE_LAUNCH) xcd_barrier(bar); } while (0)
    const int lo = args.ph_lo, hi = args.ph_hi;
#ifndef PH_MASK
#define PH_MASK 0xffff
#endif
#define IN(k) (((PH_MASK >> (k)) & 1) && lo <= (k) && (k) < hi)
#define BOTH(k) (IN(k) && IN((k) + 1))
    bf16* XN = (bf16*)(C.ws + WS_XN); bf16* PROJ = (bf16*)(C.ws + WS_PROJ);

    if (IN(0)) { prologue_weights(C); __syncthreads();
        norm_gate_phase<8>(C, C.in[0], C.in[3], ATTN_IN, 1536, C.in[2], C.in[4], nullptr, XN, (float*)(C.ws + WS_LOGF), nullptr);
        if (BOTH(0)) GRID_BAR(); }
    if (IN(1)) { cumsum_phase(C);
        pg8::Gemm g{XN, (const bf16*)(C.ws + WS_WIN0), M, NPJ, D}; pg8::StaticOrder S; S.init(M, NPJ, C.G, C.bid);
        pg8::EpiProj0 E{PROJ, (const float*)(C.ws + WS_ROPE), C2};
        pg8::gemm_phase<pg8::EpiProj0, pg8::StaticOrder, true, true>(C.lds + RING_OFF, g, S, E);
        if (BOTH(1)) GRID_BAR(); }
    if (IN(2)) { naive_attn_phase(C); if (BOTH(2)) GRID_BAR(); }
    if (IN(3)) { combine_phase(C); if (BOTH(3)) GRID_BAR(); }
    if (IN(4)) { pg8::Gemm g{XN, (const bf16*)(C.ws + WS_WOUT0), M, D, D}; pg8::StaticOrder S; S.init(M, D, C.G, C.bid);
        pg8::EpiResid E{C.in[0], C.out};
        pg8::gemm_phase<pg8::EpiResid, pg8::StaticOrder, true, true>(C.lds + RING_OFF, g, S, E);
        if (BOTH(4)) GRID_BAR(); }
    if (IN(5)) { norm_gate_phase<16>(C, C.out, C.in[12], ML_IN, 2048, C.in[11], C.in[13], C.in[14], XN, (float*)(C.ws + WS_LI), (float*)(C.ws + WS_LF));
        if (BOTH(5)) GRID_BAR(); }
    if (IN(6)) { pg8::Gemm g{XN, (const bf16*)(C.ws + WS_WIN1), M, NPJ, D}; pg8::StaticOrder S; S.init(M, NPJ, C.G, C.bid);
        pg8::EpiProj1 E{PROJ};
        pg8::gemm_phase<pg8::EpiProj1, pg8::StaticOrder, true, true>(C.lds + RING_OFF, g, S, E);
        if (BOTH(6)) GRID_BAR(); }
    if (IN(7)) { naive_mlstm_phase(C); if (BOTH(7)) GRID_BAR(); }
    if (IN(8)) { pg8::Gemm g{XN, (const bf16*)(C.ws + WS_WOUT1), M, D, D}; pg8::StaticOrder S; S.init(M, D, C.G, C.bid);
        pg8::EpiResid E{C.out, C.out};
        pg8::gemm_phase<pg8::EpiResid, pg8::StaticOrder, true, true>(C.lds + RING_OFF, g, S, E);
        if (BOTH(8)) GRID_BAR(); }
    if (IN(9)) { final_norm_phase(C); }
#undef IN
#undef BOTH
}

extern "C" void kernel_launch(void* const* d_in, const int* in_sizes, int n_in, void* d_out, int out_size, void* d_ws, size_t ws_size, hipStream_t stream) {
    static int grid = 0;
    if (grid == 0) {
        if (n_in != 17 || in_sizes[0] != M * D || out_size != M * D || ws_size < WS_END) { fprintf(stderr, "kernel_launch: unexpected shapes (n_in %d, in0 %d, out %d, ws %zu < %zu); nothing launched\n", n_in, n_in > 0 ? in_sizes[0] : -1, out_size, ws_size, (size_t)WS_END); grid = -1; return; }
        int dev = 0, cus = 0, per_cu = 0;
        if (hipGetDevice(&dev) != hipSuccess || hipDeviceGetAttribute(&cus, hipDeviceAttributeMultiprocessorCount, dev) != hipSuccess) { grid = -1; return; }
        if (hipFuncSetAttribute((const void*)fwd_kernel, hipFuncAttributeMaxDynamicSharedMemorySize, LDS_BYTES) != hipSuccess) { fprintf(stderr, "kernel_launch: hipFuncSetAttribute failed\n"); grid = -1; return; }
        if (hipOccupancyMaxActiveBlocksPerMultiprocessor(&per_cu, (const void*)fwd_kernel, NWAVES * 64, LDS_BYTES) != hipSuccess || per_cu < 1) fprintf(stderr, "kernel_launch: occupancy query reports %d\n", per_cu);
        (void)hipGetLastError();
        grid = cus;
    }
    if (grid < 0) return;
    if (hipMemsetAsync((char*)d_ws + WS_CTL, 0, CTL_ZERO_BYTES, stream) != hipSuccess) return;
    Args a{};
    for (int i = 0; i < 17; ++i) a.in[i] = (const float*)d_in[i];
    a.out = (float*)d_out; a.ws = (unsigned char*)d_ws;
    if (MK_ONE_LAUNCH) { a.ph_lo = 0; a.ph_hi = NPHASE; hipLaunchKernelGGL(fwd_kernel, dim3(grid), dim3(NWAVES * 64), LDS_BYTES, stream, a); }
    else for (int p = 0; p < NPHASE; ++p) { a.ph_lo = p; a.ph_hi = p + 1; hipLaunchKernelGGL(fwd_kernel, dim3(grid), dim3(NWAVES * 64), LDS_BYTES, stream, a); }
}
```

```cpp
#include <hip/hip_runtime.h>
#include <cstdio>
#include <cstdint>
namespace pg8 {
#define PG8_LAS __attribute__((address_space(3)))
typedef unsigned short bf16_t;
typedef short bf16x8 __attribute__((ext_vector_type(8)));
typedef float f32x4 __attribute__((ext_vector_type(4)));
typedef unsigned u32x4 __attribute__((ext_vector_type(4)));
constexpr int BM = 256, BK = 64, HALF = 128, HTB = HALF * BK * 2  , STAGE_BYTES = 8 * HTB, NXCD = 8, WGM = 2;

__host__ __device__ __forceinline__ int lds_byte(int r, int c) { const int st = (r >> 4) * 2 + (c >> 5), rr = r & 15, cc = c & 31, ob = rr * 64 + cc * 2; return st * 1024 + (ob ^ (((ob >> 9) & 1) << 5)); }
__host__ __device__ __forceinline__ void stage_rc(int b, int& R, int& C) { const int st = b / 1024, sb = b % 1024, swz = sb ^ (((sb >> 9) & 1) << 5); R = (st >> 1) * 16 + swz / 64; C = (st & 1) * 32 + (swz % 64) / 2; }
__host__ __device__ __forceinline__ int perm32(int rho) { const int n = rho >> 4, i = rho & 15; return 8 * (i >> 2) + 4 * n + (i & 3); }

struct Unit { int pm, pn; };
struct Gemm { const bf16_t* A; const bf16_t* Bt; int M, N, K; };

struct StaticOrder {
    int nM, nN, nwg, G, c, wgm;
    __host__ __device__ void init(int M, int N, int G_, int c_, int wgm_ = WGM) { nM = M / BM; nN = N / BM; nwg = nM * nN; G = G_; c = c_; wgm = wgm_; }
    __host__ __device__ bool next(int i, Unit& u) const {
        const long L = (long)i * G + c; if (L >= nwg) return false;
        int wgid = (int)L; { const int q = nwg / NXCD, r = nwg % NXCD, xcd = wgid % NXCD, off = wgid / NXCD; wgid = (xcd < r ? xcd * (q + 1) : r * (q + 1) + (xcd - r) * q) + off; }
        const int nig = wgm * nN, gid = wgid / nig, fm = gid * wgm, gsz = (nM - fm) < wgm ? (nM - fm) : wgm;
        u.pm = fm + ((wgid % nig) % gsz); u.pn = (wgid % nig) / gsz; return true;
    }
    __device__ __forceinline__ void a_ready(const Unit&) const {}
    __device__ __forceinline__ void done(const Unit&) const {}
};

__device__ __forceinline__ unsigned cvt_pk_bf16(float lo, float hi) { unsigned r; asm volatile("v_cvt_pk_bf16_f32 %0, %1, %2" : "=v"(r) : "v"(lo), "v"(hi)); return r; }
typedef float f32x2 __attribute__((ext_vector_type(2)));
__device__ __forceinline__ f32x2 gelu_pk(f32x2 v) {
    const f32x2 av = __builtin_elementwise_abs(v), d = av * 0.2316418882f + 1.0f;
    f32x2 t; t.x = __builtin_amdgcn_rcpf(d.x); t.y = __builtin_amdgcn_rcpf(d.y);
    f32x2 q = t * 0.5307027145f + (-0.7265760135f); q = q * t + 0.7107068705f; q = q * t + (-0.142248368f); q = q * t + 0.127414796f; q = q * t;
    const f32x2 s = (v * v) * (-0.72134752044f);
    f32x2 e; e.x = __builtin_amdgcn_exp2f(s.x); e.y = __builtin_amdgcn_exp2f(s.y);
    const f32x2 m = v * (q * e), r = v - m;
    f32x2 o; o.x = v.x < 0.f ? m.x : r.x; o.y = v.y < 0.f ? m.y : r.y; return o;
}

struct EpiProj0 {
    static constexpr bool PERM = true, AFTER_DRAIN = false;
    bf16_t* O; const float* rope; float c2; unsigned* nrm; bf16_t* KT; bf16_t* VT; const float* rstd;
    __device__ __forceinline__ void operator()(const f32x4 (&acc)[2][2][4][2], const Unit& u, int wr, int wc, int fr, int fq) const {
        const int row0 = u.pm * BM + wr * 64 + fr, col0 = u.pn * BM + wc * 32 + 8 * fq, pn = u.pn;
        const bool do_rope = (pn >= 6 && pn <= 9);
        const float sc = (pn <= 1 || pn == 6 || pn == 7) ? c2 : 1.f;
        const int i0 = 16 * (wc & 1) + 4 * fq;
        if (pn < 4 || (pn >= 6 && pn <= 9)) {
            float mx[2] = {0.f, 0.f};
#pragma unroll
            for (int ai = 0; ai < 2; ++ai)
#pragma unroll
                for (int m = 0; m < 4; ++m) { const float scr = sc * rstd[row0 + ai * HALF + m * 16];
#pragma unroll
                    for (int bj = 0; bj < 2; ++bj) { const f32x4 a = acc[ai][bj][m][0] * scr, b = acc[ai][bj][m][1] * scr;
                        float ss = (a[0] * a[0] + a[1] * a[1]) + (a[2] * a[2] + a[3] * a[3]) + (b[0] * b[0] + b[1] * b[1]) + (b[2] * b[2] + b[3] * b[3]);
                        ss += __shfl_xor(ss, 16); ss += __shfl_xor(ss, 32); mx[bj] = fmaxf(mx[bj], ss); } }
#pragma unroll
            for (int bj = 0; bj < 2; ++bj) { float v = mx[bj];
#pragma unroll
                for (int o = 1; o < 16; o <<= 1) v = fmaxf(v, __shfl_xor(v, o));
                if (fr == 0 && fq == 0) { const int dif = pn >= 6 ? 1 : 0, isk = (dif ? pn - 6 : pn) >> 1, b = u.pm >> 6, head = (pn & 1) * 4 + 2 * bj + (wc >> 1), half = wc & 1;
                    __hip_atomic_fetch_max(nrm + dif * 64 + ((isk * 2 + b) * 8 + head) * 2 + half, __builtin_bit_cast(unsigned, v), __ATOMIC_RELAXED, __HIP_MEMORY_SCOPE_AGENT); } }
        }
#pragma unroll
        for (int ai = 0; ai < 2; ++ai)
#pragma unroll
            for (int m = 0; m < 4; ++m) { const int row = row0 + ai * HALF + m * 16; const float scr = sc * rstd[row];
                f32x4 cs0 = {1.f, 0.f, 1.f, 0.f}, cs1 = {1.f, 0.f, 1.f, 0.f};
                if (do_rope) { const f32x4* rp = (const f32x4*)(rope + (size_t)row * 64 + 2 * i0); cs0 = rp[0]; cs1 = rp[1]; }
                const f32x4 c = {cs0[0], cs0[2], cs1[0], cs1[2]}, s = {cs0[1], cs0[3], cs1[1], cs1[3]};
#pragma unroll
                for (int bj = 0; bj < 2; ++bj) { f32x4 v0 = acc[ai][bj][m][0], v1 = acc[ai][bj][m][1];
                    if (do_rope) { const f32x4 o0 = v0 * c - v1 * s, o1 = v0 * s + v1 * c; v0 = o0; v1 = o1; }
                    v0 = v0 * scr; v1 = v1 * scr; u32x4 w; w.x = cvt_pk_bf16(v0[0], v0[1]); w.y = cvt_pk_bf16(v0[2], v0[3]); w.z = cvt_pk_bf16(v1[0], v1[1]); w.w = cvt_pk_bf16(v1[2], v1[3]);
                    if (pn >= 8 && pn <= 11) { const int col = col0 + bj * HALF, b = row >> 14, tile = (row & 16383) >> 6, rin = row & 63;
                        if (pn <= 9) { const int cl = col - 2048, grp = cl >> 6, chunk = (cl & 63) >> 3; *(u32x4*)(KT + ((size_t)((b * 8 + grp) * 256 + tile) * 4096 + chunk * 512 + rin * 8)) = w; }
                        else { const int cl = col - 2560, hd = cl >> 7, dblk = (cl & 127) >> 5, cw = cl & 31; *(u32x4*)(VT + ((size_t)((b * 4 + hd) * 256 + tile) * 8192 + dblk * 2048 + rin * 32 + cw)) = w; } }
                    else *(u32x4*)(O + (size_t)row * 4096 + col0 + bj * HALF) = w; } }
    }
};
typedef _Float16 h2e __attribute__((ext_vector_type(2)));
__device__ __forceinline__ float hf_lo(unsigned w) { return (float)__builtin_bit_cast(h2e, w)[0]; }
__device__ __forceinline__ float hf_hi(unsigned w) { return (float)__builtin_bit_cast(h2e, w)[1]; }
__device__ __forceinline__ unsigned cvt_pk_f16(float lo, float hi) { const f32x2 v = {lo, hi}; return __builtin_bit_cast(unsigned, __builtin_convertvector(v, h2e)); }
struct EpiProj1 {
    static constexpr bool PERM = true, AFTER_DRAIN = false;
    bf16_t* O; const float* rstd;
    __device__ __forceinline__ void operator()(const f32x4 (&acc)[2][2][4][2], const Unit& u, int wr, int wc, int fr, int fq) const {
        const int row0 = u.pm * BM + wr * 64 + fr, col0 = u.pn * BM + wc * 32 + 8 * fq, pn = u.pn;
        const float sc0 = (pn == 2 || pn == 3) ? 0.125f : 1.f;
#pragma unroll
        for (int ai = 0; ai < 2; ++ai)
#pragma unroll
            for (int m = 0; m < 4; ++m) { const int row = row0 + ai * HALF + m * 16; const float sc = sc0 * rstd[row];
                const int b = row >> 14, chunk = (row & 16383) >> 7, rin = row & 127;
#pragma unroll
                for (int bj = 0; bj < 2; ++bj) { const f32x4 v0 = acc[ai][bj][m][0] * sc, v1 = acc[ai][bj][m][1] * sc; const int col = col0 + bj * HALF;
                    if (pn < 8) { u32x4 w; w.x = cvt_pk_f16(v0[0], v0[1]); w.y = cvt_pk_f16(v0[2], v0[3]); w.z = cvt_pk_f16(v1[0], v1[1]); w.w = cvt_pk_f16(v1[2], v1[3]);
                        if (pn < 4) { const int cl = col & 511, head = cl >> 6, d = cl & 63; *(u32x4*)(O + (size_t)(pn >> 1) * 16777216 + ((size_t)((b * 8 + head) * 128 + chunk) * 128 + rin) * 64 + d) = w; }
                        else { const int cl = col - 1024, head = cl >> 7, ev = cl & 127; *(u32x4*)(O + (size_t)33554432 + ((size_t)((b * 8 + head) * 128 + chunk) * 128 + rin) * 128 + ev) = w; } }
                    else {
                        const float g0 = v0[1] / ((1.f + __expf(-v0[0])) * (1.f + __expf(-v0[1]))), g1 = v0[3] / ((1.f + __expf(-v0[2])) * (1.f + __expf(-v0[3])));
                        const float g2 = v1[1] / ((1.f + __expf(-v1[0])) * (1.f + __expf(-v1[1]))), g3 = v1[3] / ((1.f + __expf(-v1[2])) * (1.f + __expf(-v1[3])));
                        typedef unsigned u32x2e __attribute__((ext_vector_type(2))); u32x2e gw; gw.x = cvt_pk_bf16(g0, g1); gw.y = cvt_pk_bf16(g2, g3);
                        const int jg = (col - 2048) >> 1, head = jg >> 7, ev = jg & 127;
                        *(u32x2e*)(O + (size_t)67108864 + ((size_t)((b * 8 + head) * 128 + chunk) * 128 + rin) * 128 + ev) = gw; } } }
    }
};
struct EpiResidF2B {
    static constexpr bool PERM = true, AFTER_DRAIN = false;
    const float* base; bf16_t* out;
    __device__ __forceinline__ void operator()(const f32x4 (&acc)[2][2][4][2], const Unit& u, int wr, int wc, int fr, int fq) const {
        const int row0 = u.pm * BM + wr * 64 + fr, col0 = u.pn * BM + wc * 32 + 8 * fq;
#pragma unroll
        for (int ai = 0; ai < 2; ++ai)
#pragma unroll
            for (int m = 0; m < 4; ++m) { const size_t p = (size_t)(row0 + ai * HALF + m * 16) * 1024 + col0;
#pragma unroll
                for (int bj = 0; bj < 2; ++bj) { const f32x4 v0 = *(const f32x4*)(base + p + bj * HALF) + acc[ai][bj][m][0], v1 = *(const f32x4*)(base + p + bj * HALF + 4) + acc[ai][bj][m][1];
                    u32x4 w; w.x = cvt_pk_f16(v0[0], v0[1]); w.y = cvt_pk_f16(v0[2], v0[3]); w.z = cvt_pk_f16(v1[0], v1[1]); w.w = cvt_pk_f16(v1[2], v1[3]);
                    *(u32x4*)(out + p + bj * HALF) = w; } }
    }
};
struct EpiResidB2B {
    static constexpr bool PERM = true, AFTER_DRAIN = false;
    const bf16_t* base; bf16_t* out;
    __device__ __forceinline__ void operator()(const f32x4 (&acc)[2][2][4][2], const Unit& u, int wr, int wc, int fr, int fq) const {
        const int row0 = u.pm * BM + wr * 64 + fr, col0 = u.pn * BM + wc * 32 + 8 * fq;
#pragma unroll
        for (int ai = 0; ai < 2; ++ai)
#pragma unroll
            for (int m = 0; m < 4; ++m) { const size_t p = (size_t)(row0 + ai * HALF + m * 16) * 1024 + col0;
#pragma unroll
                for (int bj = 0; bj < 2; ++bj) { const u32x4 b = *(const u32x4*)(base + p + bj * HALF);
                    const f32x4 b0 = {hf_lo(b.x), hf_hi(b.x), hf_lo(b.y), hf_hi(b.y)}, b1 = {hf_lo(b.z), hf_hi(b.z), hf_lo(b.w), hf_hi(b.w)};
                    const f32x4 v0 = b0 + acc[ai][bj][m][0], v1 = b1 + acc[ai][bj][m][1];
                    u32x4 w; w.x = cvt_pk_f16(v0[0], v0[1]); w.y = cvt_pk_f16(v0[2], v0[3]); w.z = cvt_pk_f16(v1[0], v1[1]); w.w = cvt_pk_f16(v1[2], v1[3]);
                    *(u32x4*)(out + p + bj * HALF) = w; } }
    }
};

typedef _Float16 h8g __attribute__((ext_vector_type(8)));
template <class Epi, class Sched, bool ALIGN_EPI = false, bool SP2 = false, bool F16 = false>
__device__ __forceinline__ void gemm_phase(PG8_LAS unsigned char* lds, const Gemm g, const Sched& S, const Epi& E) {
    const int tid = threadIdx.x, wid = __builtin_amdgcn_readfirstlane(tid >> 6), lane = tid & 63, wr = wid >> 2, wc = wid & 3, fr = lane & 15, fq = lane >> 4;
    const int K = g.K, nt = K / BK;
    unsigned voffA[2], voffB[2];
#pragma unroll
    for (int i = 0; i < 2; ++i) { int R, C; stage_rc(tid * 16 + i * 8192, R, C); const int Rb = Epi::PERM ? ((R & ~31) + perm32(R & 31)) : R;
        voffA[i] = (unsigned)(R * K + C) * 2u; voffB[i] = (unsigned)(Rb * K + C) * 2u; }
    const size_t kstep = (size_t)(BK * 2);
    const size_t hstep = (size_t)HALF * K * 2;
    const size_t tstep = 2 * hstep;
    const unsigned ldsw = (unsigned)wid * 1024u;
    const int aoff = lds_byte(wr * 64 + fr, fq * 8), boff = lds_byte(wc * 32 + fr, fq * 8);
#define PG8_SA(b, h) (((b) * 2 + (h)) * HTB)
#define PG8_SB(b, h) ((4 + (b) * 2 + (h)) * HTB)
#define PG8_STAGE(bufoff, gbase, voff) do { _Pragma("unroll") for (int _i = 0; _i < 2; ++_i) \
        __builtin_amdgcn_global_load_lds((const unsigned*)((const char*)(gbase) + (voff)[_i]), (PG8_LAS unsigned*)(lds + (bufoff) + ldsw + _i * 8192), 16, 0, 0); } while (0)
#define PG8_LDA(dst, b, h) do { _Pragma("unroll") for (int m = 0; m < 4; ++m) _Pragma("unroll") for (int k = 0; k < 2; ++k) dst[m][k] = *(const PG8_LAS bf16x8*)(lds + PG8_SA(b, h) + aoff + m * 2048 + k * 1024); } while (0)
#define PG8_LDB(dst, b, h) do { _Pragma("unroll") for (int n = 0; n < 2; ++n) _Pragma("unroll") for (int k = 0; k < 2; ++k) dst[n][k] = *(const PG8_LAS bf16x8*)(lds + PG8_SB(b, h) + boff + n * 2048 + k * 1024); } while (0)
#define PG8_MMA(ai, bj, At, Bt) do { __builtin_amdgcn_s_setprio(1); _Pragma("unroll") for (int m = 0; m < 4; ++m) _Pragma("unroll") for (int n = 0; n < 2; ++n) _Pragma("unroll") for (int k = 0; k < 2; ++k) \
        acc[ai][bj][m][n] = F16 ? __builtin_amdgcn_mfma_f32_16x16x32_f16(__builtin_bit_cast(h8g, Bt[n][k]), __builtin_bit_cast(h8g, At[m][k]), acc[ai][bj][m][n], 0, 0, 0) : __builtin_amdgcn_mfma_f32_16x16x32_bf16(Bt[n][k], At[m][k], acc[ai][bj][m][n], 0, 0, 0); __builtin_amdgcn_s_setprio(0); } while (0)
#define PG8_WAIT_V(n) asm volatile("s_waitcnt vmcnt(" #n ")" ::: "memory")
#define PG8_WAIT_L(n) asm volatile("s_waitcnt lgkmcnt(" #n ")" ::: "memory")
#define PG8_BAR __builtin_amdgcn_s_barrier()
#define PG8_SCHED __builtin_amdgcn_sched_barrier(0)
    Unit cur, nxt; int ui = 0;
    if (!S.next(0, cur)) return;
    f32x4 acc[2][2][4][2];
#pragma unroll
    for (int a = 0; a < 2; ++a)
#pragma unroll
        for (int b = 0; b < 2; ++b)
#pragma unroll
            for (int m = 0; m < 4; ++m)
#pragma unroll
                for (int n = 0; n < 2; ++n) acc[a][b][m][n] = (f32x4){0.f, 0.f, 0.f, 0.f};
    bf16x8 At[4][2], B0[2][2], B1[2][2];
    const char* cA = (const char*)g.A + (size_t)cur.pm * tstep; const char* cB = (const char*)g.Bt + (size_t)cur.pn * tstep;
    S.a_ready(cur);
    if constexpr (SP2) {
        PG8_STAGE(PG8_SB(0, 0), cB, voffB); PG8_STAGE(PG8_SB(0, 1), cB + hstep, voffB); PG8_STAGE(PG8_SA(0, 0), cA, voffA); PG8_STAGE(PG8_SA(0, 1), cA + hstep, voffA);
        if (wr == 1) PG8_BAR;
        PG8_WAIT_V(2); PG8_BAR;
        PG8_STAGE(PG8_SB(1, 0), cB + kstep, voffB); PG8_STAGE(PG8_SA(1, 0), cA + kstep, voffA); PG8_STAGE(PG8_SB(1, 1), cB + hstep + kstep, voffB);
        PG8_WAIT_V(6); PG8_BAR;
    } else {
        PG8_STAGE(PG8_SB(0, 0), cB, voffB); PG8_STAGE(PG8_SA(0, 0), cA, voffA); PG8_STAGE(PG8_SB(0, 1), cB + hstep, voffB); PG8_STAGE(PG8_SA(0, 1), cA + hstep, voffA);
        if (wr == 1) PG8_BAR;
        PG8_WAIT_V(4); PG8_BAR;
        PG8_STAGE(PG8_SB(1, 0), cB + kstep, voffB); PG8_STAGE(PG8_SA(1, 0), cA + kstep, voffA); PG8_STAGE(PG8_SB(1, 1), cB + hstep + kstep, voffB);
        PG8_WAIT_V(6); PG8_BAR;
    }
    for (;;) {
        const bool has_next = S.next(ui + 1, nxt);
        const char* nA = has_next ? (const char*)g.A + (size_t)nxt.pm * tstep : cA; const char* nB = has_next ? (const char*)g.Bt + (size_t)nxt.pn * tstep : cB;
        for (int t = 0; t < nt; t += 2) {
            const bool last = (t == nt - 2);
            const char* a1 = cA + (size_t)(t + 1) * kstep;
            const char* a2 = last ? nA : cA + (size_t)(t + 2) * kstep; const char* b2 = last ? nB : cB + (size_t)(t + 2) * kstep;
            const char* a3 = a2 + kstep; const char* b3 = b2 + kstep;
            if (last && has_next) S.a_ready(nxt);
            if constexpr (SP2) {
            PG8_LDB(B0, 0, 0); PG8_LDB(B1, 0, 1); PG8_SCHED; PG8_LDA(At, 0, 0); PG8_STAGE(PG8_SA(1, 1), a1 + hstep, voffA);
            PG8_WAIT_V(8); PG8_WAIT_L(0); PG8_BAR; PG8_MMA(0, 0, At, B0); PG8_MMA(0, 1, At, B1); PG8_BAR; PG8_SCHED;
            PG8_LDA(At, 0, 1); PG8_STAGE(PG8_SB(0, 0), b2, voffB); PG8_STAGE(PG8_SB(0, 1), b2 + hstep, voffB); PG8_STAGE(PG8_SA(0, 0), a2, voffA);
            PG8_WAIT_V(8); PG8_WAIT_L(0); PG8_BAR; PG8_MMA(1, 0, At, B0); PG8_MMA(1, 1, At, B1); PG8_BAR; PG8_SCHED;
            PG8_LDB(B0, 1, 0); PG8_LDB(B1, 1, 1); PG8_SCHED; PG8_LDA(At, 1, 0); PG8_STAGE(PG8_SA(0, 1), a2 + hstep, voffA);
            PG8_WAIT_V(8); PG8_WAIT_L(0); PG8_BAR; PG8_MMA(0, 0, At, B0); PG8_MMA(0, 1, At, B1); PG8_BAR; PG8_SCHED;
            PG8_LDA(At, 1, 1); PG8_STAGE(PG8_SB(1, 0), b3, voffB); PG8_STAGE(PG8_SB(1, 1), b3 + hstep, voffB); PG8_STAGE(PG8_SA(1, 0), a3, voffA);
            PG8_WAIT_V(8); PG8_WAIT_L(0); PG8_BAR; PG8_MMA(1, 0, At, B0); PG8_MMA(1, 1, At, B1); PG8_BAR; PG8_SCHED;
            } else {
            PG8_LDB(B0, 0, 0); PG8_SCHED; PG8_LDA(At, 0, 0); PG8_STAGE(PG8_SA(1, 1), a1 + hstep, voffA);
            PG8_WAIT_L(8); PG8_BAR; PG8_WAIT_L(0); PG8_MMA(0, 0, At, B0); PG8_BAR; PG8_SCHED;
            PG8_LDB(B1, 0, 1); PG8_STAGE(PG8_SB(0, 0), b2, voffB);
            PG8_BAR; PG8_WAIT_L(0); PG8_MMA(0, 1, At, B1); PG8_BAR;
            PG8_LDA(At, 0, 1); PG8_STAGE(PG8_SA(0, 0), a2, voffA);
            PG8_BAR; PG8_WAIT_L(0); PG8_MMA(1, 0, At, B0); PG8_BAR; PG8_SCHED;
            PG8_STAGE(PG8_SB(0, 1), b2 + hstep, voffB);
            PG8_WAIT_V(6); PG8_BAR; PG8_MMA(1, 1, At, B1); PG8_BAR;
            PG8_LDB(B0, 1, 0); PG8_SCHED; PG8_LDA(At, 1, 0); PG8_STAGE(PG8_SA(0, 1), a2 + hstep, voffA);
            PG8_WAIT_L(8); PG8_BAR; PG8_WAIT_L(0); PG8_MMA(0, 0, At, B0); PG8_BAR; PG8_SCHED;
            PG8_LDB(B1, 1, 1); PG8_STAGE(PG8_SB(1, 0), b3, voffB);
            PG8_BAR; PG8_WAIT_L(0); PG8_MMA(0, 1, At, B1); PG8_BAR;
            PG8_LDA(At, 1, 1); PG8_STAGE(PG8_SA(1, 0), a3, voffA);
            PG8_BAR; PG8_WAIT_L(0); PG8_MMA(1, 0, At, B0); PG8_BAR; PG8_SCHED;
            PG8_STAGE(PG8_SB(1, 1), b3 + hstep, voffB);
            PG8_WAIT_V(6); PG8_BAR; PG8_MMA(1, 1, At, B1); PG8_BAR;
            }
        }
        if constexpr (ALIGN_EPI) { if (wr == 0) PG8_BAR; }
        if constexpr (!Epi::AFTER_DRAIN) { E(acc, cur, wr, wc, fr, fq); S.done(cur); }
        if (!has_next) break;
#pragma unroll
        for (int a = 0; a < 2; ++a)
#pragma unroll
            for (int b = 0; b < 2; ++b)
#pragma unroll
                for (int m = 0; m < 4; ++m)
#pragma unroll
                    for (int n = 0; n < 2; ++n) acc[a][b][m][n] = (f32x4){0.f, 0.f, 0.f, 0.f};
        cur = nxt; cA = nA; cB = nB; ++ui;
        if constexpr (ALIGN_EPI) { if (wr == 1) PG8_BAR; }
    }
    PG8_WAIT_V(0);
    if constexpr (!ALIGN_EPI) { if (wr == 0) PG8_BAR; }
    PG8_BAR;
    if constexpr (Epi::AFTER_DRAIN) { E.fused(acc, cur, wr, wc, fr, fq, lds, wid, lane); S.done(cur); }
#undef PG8_SA
#undef PG8_SB
#undef PG8_STAGE
#undef PG8_LDA
#undef PG8_LDB
#undef PG8_MMA
#undef PG8_WAIT_V
#undef PG8_WAIT_L
#undef PG8_BAR
#undef PG8_SCHED
}
}
#include <hip/hip_bf16.h>
#include <cmath>
namespace attn_body {
using bf16=__hip_bfloat16;
using bf16x8=__attribute__((ext_vector_type(8)))short;
using s16x4=__attribute__((ext_vector_type(4)))short;
using f32x16=__attribute__((ext_vector_type(16)))float;
using u32x4=__attribute__((ext_vector_type(4)))unsigned;
constexpr int SEQ=16384,D=64,DM=4096,OPITCH=1536;
constexpr int NW=8,QBLK=32,QB=QBLK*NW,KVBLK=64,NQB=SEQ/QB;
#define LAS3 __attribute__((address_space(3)))
__device__ __forceinline__ int crow(int r,int hi){return (r&3)+8*(r>>2)+4*hi;}
#define SBAR() __builtin_amdgcn_sched_barrier(0)
__device__ __forceinline__ void cmask(f32x16&p0,f32x16&p1,int jb,int qrel,int hi){
  const float NEG=-INFINITY; int kb=64*jb+4*hi;
  #pragma unroll
  for(int r=0;r<16;++r){int kv=kb+(r&3)+8*(r>>2); if(kv>qrel)p0[r]=NEG; if(kv+32>qrel)p1[r]=NEG;}
}

constexpr int NSLOT=3, SLOTB=8192;
constexpr int LDS_K=0, LDS_V=NSLOT*SLOTB, LDS_WS=2*NSLOT*SLOTB, LDS_OST=LDS_WS+NW*64*4, LDS_KE=LDS_OST+NW*4096, LDS_BYTES=LDS_KE+4*1024;
constexpr float C2=0.125f*1.4426950408889634f;
__device__ __forceinline__ void glds16(const void*gsrc,unsigned lds_dst){unsigned keep;
  asm volatile("s_mov_b32 %0, m0\n\ts_mov_b32 m0, %2\n\ts_nop 0\n\tglobal_load_lds_dwordx4 %1, off\n\ts_mov_b32 m0, %0":"=&s"(keep):"v"(gsrc),"s"(lds_dst):"memory");}
__device__ __forceinline__ float max3f(float a,float b,float c){float r;asm("v_max3_f32 %0, %1, %2, %3":"=v"(r):"v"(a),"v"(b),"v"(c));return r;}
__device__ __forceinline__ float max2f(float a,float b){float r;asm("v_max_f32_e32 %0, %1, %2":"=v"(r):"v"(a),"v"(b));return r;}
__device__ __forceinline__ float fadd_s(float a,float b){float r;asm("v_add_f32_e32 %0, %1, %2":"=v"(r):"v"(a),"v"(b));return r;}
__device__ __forceinline__ float fsub_s(float a,float b){float r;asm("v_sub_f32_e32 %0, %1, %2":"=v"(r):"v"(a),"v"(b));return r;}
typedef float f32x2_t __attribute__((ext_vector_type(2))); typedef __bf16 bf16x2_t __attribute__((ext_vector_type(2)));
__device__ __forceinline__ unsigned cvtpk_s(float lo,float hi){f32x2_t v={lo,hi};bf16x2_t b=__builtin_convertvector(v,bf16x2_t);return __builtin_bit_cast(unsigned,b);}
#define WAIT_BAR(N) asm volatile("s_waitcnt vmcnt(" #N ") lgkmcnt(0)\n\ts_barrier":::"memory")

__device__ __forceinline__ void qkt(f32x16&p0,f32x16&p1,const char*Kslot,const bf16x8*qr,const f32x16&negm,int r32,int hi){
  const char*kb=Kslot+hi*1024+r32*16;
  #pragma unroll
  for(int d0=0;d0<4;++d0){
    const bf16x8 b0=*reinterpret_cast<const bf16x8*>(kb+d0*2048);
    const bf16x8 b1=*reinterpret_cast<const bf16x8*>(kb+d0*2048+512);
    if(d0==0){p0=__builtin_amdgcn_mfma_f32_32x32x16_bf16(b0,qr[0],negm,0,0,0);p1=__builtin_amdgcn_mfma_f32_32x32x16_bf16(b1,qr[0],negm,0,0,0);}
    else{p0=__builtin_amdgcn_mfma_f32_32x32x16_bf16(b0,qr[d0],p0,0,0,0);p1=__builtin_amdgcn_mfma_f32_32x32x16_bf16(b1,qr[d0],p1,0,0,0);}}
}
typedef __attribute__((address_space(3))) const char* lds_cptr;
typedef short v4i16_t __attribute__((ext_vector_type(4)));
__device__ __forceinline__ void kload8(bf16x8*kf,lds_cptr kp){
  kf[0]=*(const __attribute__((address_space(3))) bf16x8*)(kp);      kf[1]=*(const __attribute__((address_space(3))) bf16x8*)(kp+512);
  kf[2]=*(const __attribute__((address_space(3))) bf16x8*)(kp+2048); kf[3]=*(const __attribute__((address_space(3))) bf16x8*)(kp+2560);
  kf[4]=*(const __attribute__((address_space(3))) bf16x8*)(kp+4096); kf[5]=*(const __attribute__((address_space(3))) bf16x8*)(kp+4608);
  kf[6]=*(const __attribute__((address_space(3))) bf16x8*)(kp+6144); kf[7]=*(const __attribute__((address_space(3))) bf16x8*)(kp+6656);
}
__device__ __forceinline__ void kload2(bf16x8*kf,lds_cptr kp,int j){ kf[2*j]=*(const __attribute__((address_space(3))) bf16x8*)(kp+j*2048); kf[2*j+1]=*(const __attribute__((address_space(3))) bf16x8*)(kp+j*2048+512); }
__device__ __forceinline__ s16x4 vtr(lds_cptr p){ return __builtin_bit_cast(s16x4,__builtin_amdgcn_ds_read_tr16_b64_v4i16((__attribute__((address_space(3))) v4i16_t*)p)); }
__device__ __forceinline__ float rowmax(const f32x16&p0,const f32x16&p1){
  float a=max3f(p0[0],p0[1],p1[0]),b=max3f(p0[2],p0[3],p1[1]);a=max3f(a,p1[2],p1[3]);
  #pragma unroll
  for(int r=4;r<16;r+=4){a=max3f(a,p0[r],p0[r+1]);b=max3f(b,p0[r+2],p0[r+3]);a=max3f(a,p1[r],p1[r+1]);b=max3f(b,p1[r+2],p1[r+3]);}
  const float m=max2f(a,b);
  auto rr=__builtin_amdgcn_permlane32_swap(__float_as_uint(m),__float_as_uint(m),false,false);
  return max2f(__uint_as_float(rr[0]),__uint_as_float(rr[1]));
}
__device__ __forceinline__ void pv(f32x16*o,int vb,bf16x8 pa0,bf16x8 pa1,bf16x8 pa2,bf16x8 pa3){
  #pragma unroll
  for(int d0=0;d0<2;++d0){s16x4 lo[4],hi[4];
    #pragma unroll
    for(int ks=0;ks<4;++ks){
      asm volatile("ds_read_b64_tr_b16 %0,%1 offset:%c2":"=&v"(lo[ks]):"v"(vb),"i"(d0*4096+ks*1024):"memory");
      asm volatile("ds_read_b64_tr_b16 %0,%1 offset:%c2":"=&v"(hi[ks]):"v"(vb),"i"(d0*4096+ks*1024+512):"memory");}
    asm volatile("s_waitcnt lgkmcnt(0)":::"memory");SBAR();
    #define PK(k) (bf16x8){lo[k][0],lo[k][1],lo[k][2],lo[k][3],hi[k][0],hi[k][1],hi[k][2],hi[k][3]}
    o[d0]=__builtin_amdgcn_mfma_f32_32x32x16_bf16(pa0,PK(0),o[d0],0,0,0);
    o[d0]=__builtin_amdgcn_mfma_f32_32x32x16_bf16(pa1,PK(1),o[d0],0,0,0);
    o[d0]=__builtin_amdgcn_mfma_f32_32x32x16_bf16(pa2,PK(2),o[d0],0,0,0);
    o[d0]=__builtin_amdgcn_mfma_f32_32x32x16_bf16(pa3,PK(3),o[d0],0,0,0);
    #undef PK
  }
}

__device__ __forceinline__ unsigned bf_rne(float f){ unsigned u=__float_as_uint(f); return (u+0x7fffu+((u>>16)&1u))>>16; }
__device__ __forceinline__ bf16x8 make_qre(float a,int hi){
  const unsigned h0=bf_rne(a); const float r1=a-__uint_as_float(h0<<16); const unsigned h1=bf_rne(r1); const float r2=r1-__uint_as_float(h1<<16); const unsigned h2=bf_rne(r2);
  u32x4 w; w.x=hi?0u:(h0|(h1<<16)); w.y=hi?0u:(h2|(0x3F80u<<16)); w.z=hi?0u:(0x3F80u|(0x3F80u<<16)); w.w=0u; return __builtin_bit_cast(bf16x8,w); }
constexpr int ATTN_LDS_BYTES=LDS_BYTES;
#undef SBAR
#undef WAIT_BAR
}
namespace attn256 {
using attn_body::bf16; using attn_body::bf16x8; using attn_body::s16x4; using attn_body::f32x16; using attn_body::u32x4; using attn_body::lds_cptr;
using attn_body::glds16; using attn_body::fadd_s; using attn_body::fsub_s; using attn_body::cvtpk_s; using attn_body::vtr; using attn_body::crow; using attn_body::max3f; using attn_body::max2f;
constexpr int SEQ=16384,DM=4096,OPITCH=512,QBU=256,KVBLK=64;
constexpr int KSLOT=8192,VSLOT=16384;
constexpr int LDS_K=0,LDS_V=4*KSLOT,LDS_WS=LDS_V+4*VSLOT,LDS_KE=LDS_WS+2048,LDS_BYTES=LDS_KE+4096;
#define SBAR() __builtin_amdgcn_sched_barrier(0)
#define WAIT_BAR(N) asm volatile("s_waitcnt vmcnt(" #N ") lgkmcnt(0)\n\ts_barrier":::"memory")
#define LAS3 __attribute__((address_space(3)))
__device__ __forceinline__ void wait_bar_n(int n){ if(n<=0){WAIT_BAR(0);} else if(n==1){WAIT_BAR(1);} else if(n==2){WAIT_BAR(2);} else if(n==3){WAIT_BAR(3);} else {WAIT_BAR(4);} }
template<int THRL,int DVB,bool FOX,bool NOMAX> __device__ __forceinline__ void unit(int MODE,int qb,int t0,const bf16*Qb,const bf16*__restrict__ Kb,const bf16*__restrict__ Vb,bf16*Ob,const bf16*__restrict__ Zb,bf16*Yb,const float*__restrict__ subg,float lam,const float*__restrict__ F2b,const bf16*__restrict__ KEb,char*shm){
  constexpr int NV=DVB/2;
  const int tid=threadIdx.x,lane=tid&63,r32=lane&31,hi=lane>>5; const int wid=__builtin_amdgcn_readfirstlane(tid>>6);
  const int q0=qb*QBU;
  const bf16*Qw=Qb+(long)(q0+wid*32)*DM;
  const unsigned lds0=(unsigned)(uintptr_t)shm;
  float*wsf=(float*)(shm+LDS_WS)+wid*64;
  constexpr bool TILED=(DVB==4)&&!FOX; constexpr long KSTR=TILED?4096:(long)KVBLK*DM, VSTR=TILED?8192:(long)KVBLK*DM, V2=TILED?4096:64;
  const bf16*ksrc=TILED?Kb+(long)t0*KSTR+wid*512+lane*8:Kb+((long)t0*KVBLK+lane)*DM+wid*8;
  const bf16*vsrc=TILED?Vb+(long)t0*VSTR+(wid>>2)*2048+(wid&3)*512+lane*8:Vb+((long)t0*KVBLK+16*(wid&3)+(lane>>2))*DM+(wid>>2)*32+(lane&3)*8;
  const bf16*kesrc=KEb+((long)t0*KVBLK+lane)*8; const unsigned kedst=lds0+LDS_KE; const int xw=(FOX&&wid==0)?1:0;
  const unsigned kdst=lds0+LDS_K+wid*1024, vdst=lds0+LDS_V+(wid>>2)*4096+(wid&3)*1024;
  #define KOFF(t) ((((unsigned)(t))&3u)<<13)
  #define VOFF(t) ((((unsigned)(t))&3u)<<(DVB==4?14:13))
  #define DMA_K(t) glds16(ksrc+(long)(t)*KSTR,(unsigned)__builtin_amdgcn_readfirstlane(kdst+KOFF(t)))
  #define DMA_V(t) do{ glds16(vsrc+(long)(t)*VSTR,(unsigned)__builtin_amdgcn_readfirstlane(vdst+VOFF(t))); if(DVB==4){glds16(vsrc+(long)(t)*VSTR+V2,(unsigned)__builtin_amdgcn_readfirstlane(vdst+VOFF(t)+8192));} }while(0)
  #define DMA_KE(t) do{ if(FOX&&wid==0) glds16(kesrc+(long)(t)*KVBLK*8,(unsigned)__builtin_amdgcn_readfirstlane(kedst+((((unsigned)(t))&3u)<<10))); }while(0)
  const lds_cptr shm3=(lds_cptr)shm;
  const lds_cptr kp0=shm3+LDS_K+hi*1024+r32*16;
  const lds_cptr vp0=shm3+LDS_V+((lane>>4)&1)*32+(lane&3)*8+(4*hi+((lane&15)>>2))*64;
  const lds_cptr kep0=shm3+LDS_KE+r32*16;
  const int NT=(q0+QBU)/KVBLK-t0;
  DMA_KE(0);DMA_KE(1);DMA_KE(2);
  DMA_K(0);DMA_V(0);DMA_K(1);DMA_K(2);DMA_V(1);
  bf16x8 qr[4];
  #pragma unroll
  for(int d0=0;d0<4;++d0)qr[d0]=*reinterpret_cast<const bf16x8*>(&Qw[(long)r32*DM+d0*16+hi*8]);
  float mhat=0.f,l_reg=0.f;f32x16 o[DVB];
  #pragma unroll
  for(int d_=0;d_<DVB;++d_)o[d_]=f32x16{};
  f32x16 negm=f32x16{}; if(!FOX&&!NOMAX){asm volatile("":"+v"(negm));}
  bf16x8 qre=bf16x8{},kef=bf16x8{}; float fq2=0.f;
  if(FOX){ fq2=F2b[q0+wid*32+r32]; qre=attn_body::make_qre(fq2,hi); }
  #define SETREF() do{ if(FOX){ qre=attn_body::make_qre(fq2-mhat,hi); } else { _Pragma("unroll") for(int r=0;r<16;++r)negm[r]=-mhat; asm volatile("":"+v"(negm)); } }while(0)
  const int qrel=wid*32+r32;
  #define CMASK(Px,t,h) do{int jb_=(t)-(NT-4); if(jb_>=0){ const int kb_=64*jb_+32*(h)+4*hi; _Pragma("unroll") for(int r=0;r<16;++r){ if(kb_+(r&3)+8*(r>>2)>qrel)Px[r]=-INFINITY; } } }while(0)
  bool resc=false;
  #define RESC() do{ if(resc){ asm volatile("s_waitcnt lgkmcnt(0)":::"memory"); \
      _Pragma("unroll") for(int d_=0;d_<DVB;++d_) _Pragma("unroll") for(int r=0;r<16;++r)o[d_][r]*=wsf[crow(r,hi)]; } }while(0)
  f32x16 pA,pB; bf16x8 kf[4];
  constexpr bool LMFMA=false; f32x16 ol=f32x16{}; const bf16x8 ones=(bf16x8){0x3F80,0x3F80,0x3F80,0x3F80,0x3F80,0x3F80,0x3F80,0x3F80};
  WAIT_BAR(0);
  if(3<NT){DMA_K(3);DMA_KE(3);}
  DMA_V(2);
  { const char*kb=shm+LDS_K+hi*1024+r32*16;
    if(FOX){ kef=*(const LAS3 bf16x8*)(kep0); pA=__builtin_amdgcn_mfma_f32_32x32x16_bf16(kef,qre,f32x16{},0,0,0); pA=__builtin_amdgcn_mfma_f32_32x32x16_bf16(*reinterpret_cast<const bf16x8*>(kb),qr[0],pA,0,0,0); }
    else pA=__builtin_amdgcn_mfma_f32_32x32x16_bf16(*reinterpret_cast<const bf16x8*>(kb),qr[0],(NOMAX?f32x16{}:negm),0,0,0);
    #pragma unroll
    for(int d0=1;d0<4;++d0)pA=__builtin_amdgcn_mfma_f32_32x32x16_bf16(*reinterpret_cast<const bf16x8*>(kb+d0*2048),qr[d0],pA,0,0,0); }
  #pragma unroll
  for(int d0=0;d0<4;++d0)kf[d0]=*(const LAS3 bf16x8*)(kp0+d0*2048+512);
  if(FOX)kef=*(const LAS3 bf16x8*)(kep0+512);
  asm volatile("s_nop 15\n\ts_nop 7":"+v"(pA));CMASK(pA,0,0);
  { if constexpr(!NOMAX){ float a=max3f(pA[0],pA[1],pA[2]),b=max3f(pA[3],pA[4],pA[5]);a=max3f(a,pA[6],pA[7]);b=max3f(b,pA[8],pA[9]);a=max3f(a,pA[10],pA[11]);b=max3f(b,pA[12],pA[13]);a=max3f(a,pA[14],pA[15]);
    float rm=max2f(a,b); auto rr=__builtin_amdgcn_permlane32_swap(__float_as_uint(rm),__float_as_uint(rm),false,false); rm=max2f(__uint_as_float(rr[0]),__uint_as_float(rr[1]));
    mhat=fadd_s(mhat,rm);
    #pragma unroll
    for(int r=0;r<16;++r)pA[r]=fsub_s(pA[r],rm);
    SETREF(); }
    #pragma unroll
    for(int r=0;r<16;++r)pA[r]=__builtin_amdgcn_exp2f(pA[r]); }
  s16x4 vlo[2*DVB],vhi[2*DVB]; u32x4 pw0,pw1;
  #define PKW(P,B) cvtpk_s(P[B],P[B+1])
  #define PAF(k) __builtin_bit_cast(bf16x8,pw##k)
  #define VFR(i) (bf16x8){vlo[i][0],vlo[i][1],vlo[i][2],vlo[i][3],vhi[i][0],vhi[i][1],vhi[i][2],vhi[i][3]}
  #define PIN(x) asm volatile("":"+v"(x))
  #define MX3(a,b,c) __builtin_fmaxf(__builtin_fmaxf((a),(b)),(c))
  #define GAPA(MF,A0,A1,A2,A3,W0,W1,PW) do{ MF; if constexpr(!LMFMA){ sacc+=A0; sacc+=A1; sacc+=A2; sacc+=A3; PIN(sacc); } W0; W1; PIN(PW); SBAR(); }while(0)
  #define EX(v) __builtin_amdgcn_exp2f(v)
  #define GAPB(MF,X,B) do{ MF; X[B]=EX(X[B]); X[B+1]=EX(X[B+1]); PIN(X); SBAR(); }while(0)
  #define GAPB4(MF,X,B) do{ MF; X[B]=EX(X[B]); X[B+1]=EX(X[B+1]); X[B+2]=EX(X[B+2]); X[B+3]=EX(X[B+3]); PIN(X); SBAR(); }while(0)
  #define VRD(i) do{ vlo[i]=vtr(vp_+(((i)%DVB)*4096+((i)/DVB)*1024)); vhi[i]=vtr(vp_+(((i)%DVB)*4096+((i)/DVB)*1024+512)); SBAR(); }while(0)
  #define KERD(G) do{ if(FOX&&(G)){ kef=*(const LAS3 bf16x8*)(ken_); SBAR(); } }while(0)
  #define CIN0(Cx) (FOX?(Cx):(NOMAX?f32x16{}:negm))
  #define KRD(G,j) do{ if(G){ kf[j]=*(const LAS3 bf16x8*)(kn_+(j)*2048); SBAR(); } }while(0)
  #define SUB(Cx,Px,t,h,VP,KN,KEN,GL,ISSUE) do{ SBAR(); \
    const lds_cptr vp_=(VP); const lds_cptr kn_=(KN); const lds_cptr ken_=(KEN); \
    if(FOX){ Cx=__builtin_amdgcn_mfma_f32_32x32x16_bf16(kef,qre,f32x16{},0,0,0); SBAR(); } \
    VRD(0); float sacc=0.f; \
    GAPA(Cx=__builtin_amdgcn_mfma_f32_32x32x16_bf16(kf[0],qr[0],CIN0(Cx),0,0,0), Px[0],Px[1],Px[2],Px[3],     pw0[0]=PKW(Px,0), pw0[1]=PKW(Px,2), pw0); \
    VRD(1); GAPA(Cx=__builtin_amdgcn_mfma_f32_32x32x16_bf16(kf[1],qr[1],Cx,0,0,0), Px[4],Px[5],Px[6],Px[7],     pw0[2]=PKW(Px,4), pw0[3]=PKW(Px,6), pw0); \
    if(DVB==4){VRD(2);} GAPA(Cx=__builtin_amdgcn_mfma_f32_32x32x16_bf16(kf[2],qr[2],Cx,0,0,0), Px[8],Px[9],Px[10],Px[11],   pw1[0]=PKW(Px,8), pw1[1]=PKW(Px,10), pw1); \
    if(DVB==4){VRD(3);} GAPA(Cx=__builtin_amdgcn_mfma_f32_32x32x16_bf16(kf[3],qr[3],Cx,0,0,0), Px[12],Px[13],Px[14],Px[15], pw1[2]=PKW(Px,12), pw1[3]=PKW(Px,14), pw1); \
    l_reg+=sacc; \
    ISSUE; \
    CMASK(Cx,t,h); \
    if constexpr(!NOMAX) \
    { float a=MX3(Cx[0],Cx[1],Cx[2]),b=MX3(Cx[3],Cx[4],Cx[5]); a=MX3(a,Cx[6],Cx[7]); b=MX3(b,Cx[8],Cx[9]); a=MX3(a,Cx[10],Cx[11]); b=MX3(b,Cx[12],Cx[13]); a=MX3(a,Cx[14],Cx[15]); \
      float rm=__builtin_fmaxf(a,b); { auto rr=__builtin_amdgcn_permlane32_swap(__float_as_uint(rm),__float_as_uint(rm),false,false); rm=__builtin_fmaxf(__uint_as_float(rr[0]),__uint_as_float(rr[1])); } \
      resc=false; \
      if(__builtin_expect(__any(rm>(float)THRL),0)){ const float dl=__builtin_fmaxf(rm,0.f); mhat+=dl; \
        _Pragma("unroll") for(int r=0;r<16;++r){Cx[r]-=dl;} \
        SETREF(); \
        const float f=__builtin_amdgcn_exp2f(-dl); l_reg*=f; if(hi==0)wsf[r32]=f; resc=true; } } \
    SBAR(); \
    if constexpr(DVB==4){ \
    VRD(4); GAPB(o[0]=__builtin_amdgcn_mfma_f32_32x32x16_bf16(PAF(0),VFR(0),o[0],0,0,0), Cx,0); \
    VRD(5); GAPB(o[1]=__builtin_amdgcn_mfma_f32_32x32x16_bf16(PAF(0),VFR(1),o[1],0,0,0), Cx,2); \
    VRD(6); GAPB(o[2]=__builtin_amdgcn_mfma_f32_32x32x16_bf16(PAF(0),VFR(2),o[2],0,0,0), Cx,4); \
    VRD(7); GAPB(o[3]=__builtin_amdgcn_mfma_f32_32x32x16_bf16(PAF(0),VFR(3),o[3],0,0,0), Cx,6); \
    KRD(GL,0); GAPB(o[0]=__builtin_amdgcn_mfma_f32_32x32x16_bf16(PAF(1),VFR(4),o[0],0,0,0), Cx,8); \
    KRD(GL,1); GAPB(o[1]=__builtin_amdgcn_mfma_f32_32x32x16_bf16(PAF(1),VFR(5),o[1],0,0,0), Cx,10); \
    KRD(GL,2); GAPB(o[2]=__builtin_amdgcn_mfma_f32_32x32x16_bf16(PAF(1),VFR(6),o[2],0,0,0), Cx,12); \
    KRD(GL,3); KERD(GL); GAPB(o[3]=__builtin_amdgcn_mfma_f32_32x32x16_bf16(PAF(1),VFR(7),o[3],0,0,0), Cx,14); \
    if constexpr(LMFMA){ ol=__builtin_amdgcn_mfma_f32_32x32x16_bf16(PAF(0),ones,ol,0,0,0); ol=__builtin_amdgcn_mfma_f32_32x32x16_bf16(PAF(1),ones,ol,0,0,0); SBAR(); } \
    } else { \
    VRD(2); GAPB4(o[0]=__builtin_amdgcn_mfma_f32_32x32x16_bf16(PAF(0),VFR(0),o[0],0,0,0), Cx,0); \
    VRD(3); GAPB4(o[1]=__builtin_amdgcn_mfma_f32_32x32x16_bf16(PAF(0),VFR(1),o[1],0,0,0), Cx,4); \
    KRD(GL,0); KRD(GL,1); GAPB4(o[0]=__builtin_amdgcn_mfma_f32_32x32x16_bf16(PAF(1),VFR(2),o[0],0,0,0), Cx,8); \
    KRD(GL,2); KRD(GL,3); KERD(GL); GAPB4(o[1]=__builtin_amdgcn_mfma_f32_32x32x16_bf16(PAF(1),VFR(3),o[1],0,0,0), Cx,12); \
    } \
    RESC(); \
    }while(0)
  SUB(pB,pA,0,1,vp0+VOFF(0),kp0+KOFF(1),kep0+1024,true,(void)0);
  wait_bar_n(NV+1+xw);
  int t=1;
  #undef CMASK
  #define CMASK(Px,t,h) do{}while(0)
  for(;t+4<NT;++t){
    SUB(pA,pB,t,0,vp0+VOFF(t-1)+2048,kp0+KOFF(t)+512,kep0+((((unsigned)(t))&3u)<<10)+512,true,do{DMA_K(t+3);DMA_KE(t+3);DMA_V(t+2);}while(0));
    SUB(pB,pA,t,1,vp0+VOFF(t),kp0+KOFF(t+1),kep0+((((unsigned)(t+1))&3u)<<10),true,(void)0);
    wait_bar_n(NV+1+xw);
  }
  #undef CMASK
  #define CMASK(Px,t,h) do{int jb_=(t)-(NT-4); if(jb_>=0){ const int kb_=64*jb_+32*(h)+4*hi; _Pragma("unroll") for(int r=0;r<16;++r){ if(kb_+(r&3)+8*(r>>2)>qrel)Px[r]=-INFINITY; } } }while(0)
  for(;t<NT;++t){
    SUB(pA,pB,t,0,vp0+VOFF(t-1)+2048,kp0+KOFF(t)+512,kep0+((((unsigned)(t))&3u)<<10)+512,true,do{ if(t+3<NT){DMA_K(t+3);DMA_KE(t+3);} if(t+2<NT)DMA_V(t+2); }while(0));
    SUB(pB,pA,t,1,vp0+VOFF(t),kp0+KOFF(t+1),kep0+((((unsigned)(t+1))&3u)<<10),(t+1<NT),(void)0);
    if(t+3<NT){wait_bar_n(NV+1+xw);} else if(t+2<NT){wait_bar_n(NV);} else {WAIT_BAR(0);}
  }
  { if constexpr(!LMFMA){ float sacc=0.f; _Pragma("unroll") for(int r=0;r<16;++r)sacc+=pB[r]; l_reg+=sacc; }
    pw0=(u32x4){PKW(pB,0),PKW(pB,2),PKW(pB,4),PKW(pB,6)};pw1=(u32x4){PKW(pB,8),PKW(pB,10),PKW(pB,12),PKW(pB,14)};
    const lds_cptr vp_=vp0+VOFF(NT-1)+2048;
    #pragma unroll
    for(int i=0;i<2*DVB;++i){ vlo[i]=vtr(vp_+((i%DVB)*4096+(i/DVB)*1024)); vhi[i]=vtr(vp_+((i%DVB)*4096+(i/DVB)*1024+512)); }
    #pragma unroll
    for(int d_=0;d_<DVB;++d_)o[d_]=__builtin_amdgcn_mfma_f32_32x32x16_bf16(PAF(0),VFR(d_),o[d_],0,0,0);
    #pragma unroll
    for(int d_=0;d_<DVB;++d_)o[d_]=__builtin_amdgcn_mfma_f32_32x32x16_bf16(PAF(1),VFR(DVB+d_),o[d_],0,0,0);
    if constexpr(LMFMA){ ol=__builtin_amdgcn_mfma_f32_32x32x16_bf16(PAF(0),ones,ol,0,0,0); ol=__builtin_amdgcn_mfma_f32_32x32x16_bf16(PAF(1),ones,ol,0,0,0); } }
  #undef PKW
  #undef PAF
  #undef VFR
  #undef PIN
  #undef MX3
  #undef GAPA
  #undef GAPB
  #undef GAPB4
  #undef KERD
  #undef CIN0
  #undef EX
  #undef VRD
  #undef KRD
  #undef SUB
  {auto rr=__builtin_amdgcn_permlane32_swap(__float_as_uint(l_reg),__float_as_uint(l_reg),false,false);l_reg=__uint_as_float(rr[0])+__uint_as_float(rr[1]);}
  if(hi==0)wsf[32+r32]=l_reg;
  asm volatile("s_waitcnt lgkmcnt(0)\n\ts_barrier":::"memory");
  { float rli[16];
    #pragma unroll
    for(int r=0;r<16;++r)rli[r]=__builtin_amdgcn_rcpf(LMFMA?ol[r]:wsf[32+crow(r,hi)]);
    constexpr int OC=32*DVB, CPR=OC/8, RPI=64/CPR;
    bf16*stg=(bf16*)(shm)+wid*4096;
    #pragma unroll
    for(int r=0;r<16;++r){const int orow=crow(r,hi);
      #pragma unroll
      for(int d_=0;d_<DVB;++d_)stg[orow*OC+d_*32+r32]=__float2bfloat16(o[d_][r]*rli[r]);}
    asm volatile("s_waitcnt lgkmcnt(0)":::"memory");
    bf16*Ow=Ob+(long)(q0+wid*32)*OPITCH;
    if constexpr(DVB==2){
    #pragma unroll
    for(int i=0;i<32/RPI;++i){const int row=i*RPI+lane/CPR,ch=lane%CPR; const long grow=q0+wid*32+row; u32x4 v=*(const u32x4*)(stg+row*OC+ch*8); const u32x4 zz=*(const u32x4*)(Zb+grow*DM+ch*8);
      #pragma unroll
      for(int k=0;k<4;++k){ const float z0=__uint_as_float(zz[k]<<16),z1=__uint_as_float(zz[k]&0xffff0000u); v[k]=cvtpk_s(__uint_as_float(v[k]<<16)*(z0/(1.f+__expf(-z0))),__uint_as_float(v[k]&0xffff0000u)*(z1/(1.f+__expf(-z1)))); }
      *(u32x4*)(Yb+grow*1024+ch*8)=v; }
    } else
    if(MODE==0){
    #pragma unroll
    for(int i=0;i<8;++i){const int row=i*4+(lane>>4),ch=lane&15; const u32x4 v=*(const u32x4*)(stg+row*128+ch*8); *(u32x4*)(Ow+(long)row*OPITCH+ch*8)=v;}
    } else {
    const int ch=lane&15; float gg[8];
    #pragma unroll
    for(int k=0;k<8;++k)gg[k]=subg[ch*8+k];
    #pragma unroll
    for(int i=0;i<8;++i){const int row=i*4+(lane>>4); const long grow=q0+wid*32+row;
      const u32x4 v1=*(const u32x4*)(stg+row*128+ch*8), v0=*(const u32x4*)(Ow+(long)row*OPITCH+ch*8), zz=*(const u32x4*)(Zb+grow*DM+ch*8);
      float d[8];
      #pragma unroll
      for(int k=0;k<4;++k){ d[2*k]=__uint_as_float(v0[k]<<16)-lam*__uint_as_float(v1[k]<<16); d[2*k+1]=__uint_as_float(v0[k]&0xffff0000u)-lam*__uint_as_float(v1[k]&0xffff0000u); }
      float ss=0.f;
      #pragma unroll
      for(int k=0;k<8;++k)ss+=d[k]*d[k];
      #pragma unroll
      for(int o_=1;o_<16;o_<<=1)ss+=__shfl_xor(ss,o_);
      const float rs=1.f/sqrtf(ss*(1.f/128.f)+1e-6f); u32x4 w;
      #pragma unroll
      for(int k=0;k<4;++k){ const float z0=__uint_as_float(zz[k]<<16),z1=__uint_as_float(zz[k]&0xffff0000u);
        const float y0=d[2*k]*rs*gg[2*k]*(z0/(1.f+__expf(-z0))), y1=d[2*k+1]*rs*gg[2*k+1]*(z1/(1.f+__expf(-z1))); w[k]=cvtpk_s(y0,y1); }
      *(u32x4*)(Yb+grow*1024+ch*8)=w; }
    } }
  asm volatile("s_waitcnt lgkmcnt(0)\n\ts_barrier":::"memory");
  #undef DMA_K
  #undef DMA_V
  #undef DMA_KE
  #undef SETREF
  #undef KOFF
  #undef VOFF
  #undef CMASK
  #undef RESC
}
#undef SBAR
#undef WAIT_BAR
#undef LAS3
}
constexpr int NWAVES = 8;
#ifndef MK_ONE_LAUNCH
#define MK_ONE_LAUNCH 1
#endif
constexpr int BATCH = 2, SEQ = 16384, D = 1024, M = BATCH * SEQ, NPJ = 4096;
constexpr int ATTN_IN = 4104, ML_IN = 4112;
constexpr float RMS_EPS = 1e-6f, LOG2E = 1.4426950408889634f, C2 = 0.125f * 1.4426950408889634f;
constexpr int NPHASE = 12;
constexpr size_t MiB = 1u << 20;
constexpr size_t WS_CTL = 0, CTL_ZERO_BYTES = 1 * MiB;
constexpr size_t WS_LOGF = 1 * MiB, WS_F2 = 2 * MiB, WS_QE = 3 * MiB, WS_KE = 7 * MiB, WS_LI = 11 * MiB, WS_LF = 12 * MiB;
constexpr size_t WS_GB = 13 * MiB, WS_GE = 14 * MiB, WS_GU = 15 * MiB, WS_CHA = 16 * MiB, WS_CHE = 16 * MiB + 65536, WS_CHM = 16 * MiB + 131072;
constexpr size_t WS_DN = 17 * MiB, WS_NS = 17 * MiB + 524288, WS_SUBG = 16 * MiB + 262144, WS_RSTD = 16 * MiB + 524288;
constexpr size_t WS_ROPE = 18 * MiB, WS_WIN0 = 26 * MiB, WS_WOUT0 = 34 * MiB, WS_WIN1 = 36 * MiB, WS_WOUT1 = 44 * MiB;
constexpr size_t WS_XN = 48 * MiB;
constexpr size_t WS_PROJ = 112 * MiB;
constexpr size_t WS_OB = 368 * MiB;
constexpr size_t WS_END = 464 * MiB;
constexpr int CW_TMO = 0, CW_CODE = 1, CW_BAR = 4096, CW_NRM = 8192, CW_FOXQ = 8192 + 256;
constexpr int RING_OFF = 0, RING_BYTES = 131072;
constexpr int LDSCTL_OFF = RING_BYTES, MISC_OFF = LDSCTL_OFF + 320;
constexpr int LDS_BYTES = 147456;
static_assert(MISC_OFF + 128 <= LDS_BYTES, "LDS map");
#define GAS __attribute__((address_space(1)))
#define LAS __attribute__((address_space(3)))
typedef unsigned short bf16;
typedef unsigned v4u __attribute__((ext_vector_type(4)));
typedef float f32x4 __attribute__((ext_vector_type(4)));
typedef short bf16x8 __attribute__((ext_vector_type(8)));
typedef GAS unsigned gu32;
typedef GAS unsigned long long gu64;
#define RLX_AGENT __ATOMIC_RELAXED, __HIP_MEMORY_SCOPE_AGENT
#define LDS_WAIT() asm volatile("s_waitcnt lgkmcnt(0)" ::: "memory")
#define VM_WAIT() asm volatile("s_waitcnt vmcnt(0)" ::: "memory")
__device__ __forceinline__ unsigned long long rt() { return __builtin_amdgcn_s_memrealtime(); }
__device__ __forceinline__ unsigned f2bf(float f) { unsigned u = __builtin_bit_cast(unsigned, f); return (u + 0x7fffu + ((u >> 16) & 1u)) >> 16; }
__device__ __forceinline__ unsigned pk2(float lo, float hi) { return f2bf(lo) | (f2bf(hi) << 16); }
#define XB_TMO      128
#define XB_XCNT(j)  (256  + 64 * (j))
#define XB_XSUB(j)  (1280 + 64 * (j))
#define XB_XGEN(j)  (2304 + 64 * (j))
#define XB_TOP      3328
#define XB_TOPGEN   3392
#define XCD_BAR_WORDS 3456
#define XB_SPIN_CAP (1u << 18)

__device__ __forceinline__ unsigned xb_ld(unsigned* p)              { return __hip_atomic_load(p, __ATOMIC_RELAXED, __HIP_MEMORY_SCOPE_AGENT); }
__device__ __forceinline__ unsigned xb_add(unsigned* p, unsigned v) { return __hip_atomic_fetch_add(p, v, __ATOMIC_RELAXED, __HIP_MEMORY_SCOPE_AGENT); }
__device__ __forceinline__ unsigned xb_xcc_id() { return (unsigned)__builtin_amdgcn_s_getreg((3 << 11) | 20) & 0xFu; }
#define XB_SPIN(cond, bar) do { unsigned _sp = 0; while (cond) { __builtin_amdgcn_s_sleep(1); \
    if ((++_sp & 255u) == 0u) { if (xb_ld(&(bar)[XB_TMO])) break; if (_sp > XB_SPIN_CAP) { atomicAdd(&(bar)[XB_TMO], 1u); break; } } } } while (0)

struct XcdBarrier {
    unsigned* bar; unsigned x;
    volatile LAS unsigned* st;
};

__device__ __forceinline__ XcdBarrier xcd_barrier_post(unsigned* bar, volatile LAS unsigned* st) {
    XcdBarrier b; b.bar = bar; b.x = xb_xcc_id(); b.st = st;
    if (threadIdx.x == 0) (void)xb_add(&bar[XB_XCNT(b.x)], 1u);
    return b;
}
__device__ __forceinline__ void xcd_barrier_complete(unsigned* bar, unsigned x, unsigned& nloc, unsigned& nx) {
    const unsigned G = gridDim.x * gridDim.y * gridDim.z;
    unsigned sum, cnt, mine, sp = 0u;
    for (;;) {
        sum = 0u; cnt = 0u; mine = 0u;
#pragma unroll
        for (unsigned j = 0; j < 16; ++j) { const unsigned c = xb_ld(&bar[XB_XCNT(j)]); sum += c; cnt += (c > 0u) ? 1u : 0u; mine = (j == x) ? c : mine; }
        if (sum == G) break;
        __builtin_amdgcn_s_sleep(1);
        if ((++sp & 255u) == 0u) { if (xb_ld(&bar[XB_TMO])) break; if (sp > XB_SPIN_CAP) { atomicAdd(&bar[XB_TMO], 1u); break; } }
    }
    nloc = mine > 0u ? mine : 1u; nx = cnt > 0u ? cnt : 1u;
}

__device__ __forceinline__ void xcd_barrier(const XcdBarrier& b) {
    asm volatile("s_waitcnt vmcnt(0)" ::: "memory");
    __syncthreads();
    if (threadIdx.x == 0) {
        unsigned* bar = b.bar;
        __builtin_amdgcn_s_waitcnt(0);
        unsigned nloc = b.st[0], nx = b.st[1];
        if (nloc == 0u) { xcd_barrier_complete(bar, b.x, nloc, nx); b.st[0] = nloc; b.st[1] = nx; }
        const unsigned old = xb_add(&bar[XB_XSUB(b.x)], 1u);
        const unsigned gen = old / nloc;
        if (old + 1u == (gen + 1u) * nloc) {
            __builtin_amdgcn_fence(__ATOMIC_RELEASE, "agent");
            asm volatile("s_waitcnt vmcnt(0)" ::: "memory");
            const unsigned og = xb_add(&bar[XB_TOP], 1u);
            const unsigned tg = og / nx;
            if (og + 1u == (tg + 1u) * nx) xb_add(&bar[XB_TOPGEN], 1u);
            else XB_SPIN(xb_ld(&bar[XB_TOPGEN]) == tg, bar);
            __builtin_amdgcn_fence(__ATOMIC_ACQUIRE, "agent");
            xb_add(&bar[XB_XGEN(b.x)], 1u);
            asm volatile("s_waitcnt vmcnt(0)" ::: "memory");
        } else {
            XB_SPIN(xb_ld(&bar[XB_XGEN(b.x)]) == gen, bar);
            __builtin_amdgcn_fence(__ATOMIC_ACQUIRE, "agent");
            asm volatile("s_waitcnt vmcnt(0)" ::: "memory");
        }
    }
    __syncthreads();
}
__device__ __forceinline__ float wave_sum(float v) {
#pragma unroll
    for (int o = 1; o < 64; o <<= 1) v += __shfl_xor(v, o);
    return v;
}
__device__ __forceinline__ float bf2f(unsigned short b) { return __builtin_bit_cast(float, (unsigned)b << 16); }
__device__ __forceinline__ float bflo(unsigned w) { return __builtin_bit_cast(float, w << 16); }
__device__ __forceinline__ float bfhi(unsigned w) { return __builtin_bit_cast(float, w & 0xffff0000u); }
typedef _Float16 h2p __attribute__((ext_vector_type(2))); typedef float f2p __attribute__((ext_vector_type(2)));
__device__ __forceinline__ unsigned pkh(float lo, float hi) { const f2p v = {lo, hi}; return __builtin_bit_cast(unsigned, __builtin_convertvector(v, h2p)); }
__device__ __forceinline__ float h_lo(unsigned w) { return (float)__builtin_bit_cast(h2p, w)[0]; }
__device__ __forceinline__ float h_hi(unsigned w) { return (float)__builtin_bit_cast(h2p, w)[1]; }
__device__ __forceinline__ float log_sigmoid_f(float x) { return fminf(x, 0.f) - log1pf(__expf(-fabsf(x))); }
__device__ __forceinline__ float sigmoid_f(float x) { return 1.f / (1.f + __expf(-x)); }
__device__ __forceinline__ float silu_f(float x) { return x / (1.f + __expf(-x)); }

typedef unsigned u32x4m __attribute__((ext_vector_type(4)));
struct Ctx {
    LAS unsigned char* lds; char* ldsg; int G, bid;
    float* out; unsigned char* ws;
};
__device__ __forceinline__ const float* kin(int i) { unsigned long long r; const unsigned long long kp = (unsigned long long)__builtin_amdgcn_kernarg_segment_ptr();
    asm volatile("s_load_dwordx2 %0, %1, %2\n\ts_waitcnt lgkmcnt(0)" : "=s"(r) : "s"(kp), "n"(i * 8)); return (const float*)r; }
__device__ __forceinline__ int src_col0(int P) {
    if (P < 1536) return P;
    if (P < 2560) { const int q = P - 1536, grp = q >> 6, p = q & 63; return 1544 + grp * 64 + 16 * (p >> 5) + 4 * ((p >> 3) & 3) + (p & 3) + 32 * ((p >> 2) & 1); }
    return P + 8;
}
__device__ __forceinline__ int src_col1(int P) { if (P < 2048) return P; const int j = (P - 2048) >> 1; return (P & 1) ? 3088 + j : 2064 + j; }
template <bool F16>
__device__ __forceinline__ void transpose_item(const float* W, int ldw, const float* gain, bf16* WT, LAS float* scr, int kb, int nb, int lane, int srcc) {
    const int k0 = 64 * kb, n0 = 32 * nb;
    float wv[32], gv[32];
#pragma unroll
    for (int i = 0; i < 32; ++i) { const int kk = 2 * i + (lane >> 5); gv[i] = gain ? gain[k0 + kk] : 1.f; wv[i] = W[(size_t)(k0 + kk) * ldw + srcc]; }
#pragma unroll
    for (int i = 0; i < 32; ++i) { const int kk = 2 * i + (lane >> 5); scr[kk * 33 + (lane & 31)] = wv[i] * gv[i]; }
    LDS_WAIT(); asm volatile("" ::: "memory");
    const int c = lane & 7;
#pragma unroll
    for (int j = 0; j < 4; ++j) { const int n = (lane >> 3) + 8 * j; const LAS float* s = scr + (8 * c) * 33 + n;
        v4u o; if (F16) { o.x = pkh(s[0 * 33], s[1 * 33]); o.y = pkh(s[2 * 33], s[3 * 33]); o.z = pkh(s[4 * 33], s[5 * 33]); o.w = pkh(s[6 * 33], s[7 * 33]); }
        else { o.x = pk2(s[0 * 33], s[1 * 33]); o.y = pk2(s[2 * 33], s[3 * 33]); o.z = pk2(s[4 * 33], s[5 * 33]); o.w = pk2(s[6 * 33], s[7 * 33]); }
        *(GAS v4u*)(WT + (size_t)(n0 + n) * 1024 + k0 + 8 * c) = o; }
    LDS_WAIT(); asm volatile("" ::: "memory");
}
__device__ __constant__ const double kInvFreq[32] = {1.0, 0.7498942093324559, 0.5623413251903491, 0.4216965034285822, 0.31622776601683794, 0.23713737056616552, 0.1778279410038923, 0.1333521432163324, 0.1, 0.07498942093324558,
    0.05623413251903491, 0.042169650342858224, 0.03162277660168379, 0.023713737056616554, 0.01778279410038923, 0.01333521432163324, 0.01, 0.007498942093324558, 0.005623413251903491, 0.004216965034285823, 0.0031622776601683794,
    0.0023713737056616554, 0.0017782794100389228, 0.001333521432163324, 0.001, 0.0007498942093324559, 0.0005623413251903491, 0.00042169650342858224, 0.00031622776601683794, 0.00023713737056616554, 0.00017782794100389227, 0.0001333521432163324};

__device__ __forceinline__ void prologue_weights(const Ctx& C) {
    LAS float* scr = (LAS float*)(C.lds + RING_OFF + __builtin_amdgcn_readfirstlane((int)threadIdx.x >> 6) * 16384);
    const int gw = C.bid * NWAVES + __builtin_amdgcn_readfirstlane((int)threadIdx.x >> 6), NGW = C.G * NWAVES;
    bf16* Win0 = (bf16*)(C.ws + WS_WIN0); bf16* Wout0 = (bf16*)(C.ws + WS_WOUT0); bf16* Win1 = (bf16*)(C.ws + WS_WIN1); bf16* Wout1 = (bf16*)(C.ws + WS_WOUT1);
    constexpr int I_IN = 16 * 128, I_OUT = 16 * 32, NITEMS = 2 * I_IN + 2 * I_OUT;
    for (int it = gw; it < NITEMS; it += NGW) {
        int r = it;
        if (r < I_IN) { const int kb = r / 128, nb = r % 128; transpose_item<false>(kin(3), ATTN_IN, kin(2), Win0, scr, kb, nb, ((int)threadIdx.x & 63), src_col0(32 * nb + (((int)threadIdx.x & 63) & 31))); continue; } r -= I_IN;
        if (r < I_IN) { const int kb = r / 128, nb = r % 128; transpose_item<true>(kin(12), ML_IN, kin(11), Win1, scr, kb, nb, ((int)threadIdx.x & 63), src_col1(32 * nb + (((int)threadIdx.x & 63) & 31))); continue; } r -= I_IN;
        if (r < I_OUT) { const int kb = r / 32, nb = r % 32; transpose_item<false>(kin(10), 1024, nullptr, Wout0, scr, kb, nb, ((int)threadIdx.x & 63), 32 * nb + (((int)threadIdx.x & 63) & 31)); continue; } r -= I_OUT;
        { const int kb = r / 32, nb = r % 32; transpose_item<false>(kin(15), 1024, nullptr, Wout1, scr, kb, nb, ((int)threadIdx.x & 63), 32 * nb + (((int)threadIdx.x & 63) & 31)); }
    }
    const int* pos = (const int*)kin(1); float* rope = (float*)(C.ws + WS_ROPE);
    for (int idx = C.bid * (NWAVES * 64) + (int)threadIdx.x; idx < M * 32; idx += C.G * NWAVES * 64) { const int m = idx >> 5, i = idx & 31;
        double rev = (double)pos[m] * kInvFreq[i] * 0.15915494309189535; rev -= floor(rev); const float rf = (float)rev;
        *(float2*)(rope + (size_t)idx * 2) = make_float2(__builtin_amdgcn_cosf(rf), __builtin_amdgcn_sinf(rf)); }
}
typedef _Float16 h8n __attribute__((ext_vector_type(8)));
template <int NG, bool B16IN>
__device__ __forceinline__ void norm_gate_phase(const Ctx& C, const void* Xv, const float* W, int ldw, int gcol0, const float* gain, const float* bias_a, const float* bias_b, bf16* XN, float* outA, float* outB, float* rstdo) {
    constexpr int TP = 1032;
    LAS unsigned short* thi = (LAS unsigned short*)(C.lds + RING_OFF); LAS unsigned short* tlo = thi + 16 * TP;
#pragma unroll 8
    for (int i = (int)threadIdx.x; i < 16 * 1024; i += NWAVES * 64) { const int c = i & 15, k = i >> 4; float w = 0.f; if (c < NG) w = W[(size_t)k * ldw + gcol0 + c] * gain[k];
        const _Float16 h = (_Float16)w; const _Float16 l = (_Float16)(w - (float)h); thi[c * TP + k] = __builtin_bit_cast(unsigned short, h); tlo[c * TP + k] = __builtin_bit_cast(unsigned short, l); }
    __syncthreads();
    const int ln = (int)threadIdx.x & 63, r16 = ln & 15, kg = ln >> 4;
    const int gw = C.bid * NWAVES + __builtin_amdgcn_readfirstlane((int)threadIdx.x >> 6), NGW = C.G * NWAVES;
    for (int grp = gw; grp < M / 16; grp += NGW) { const size_t row = (size_t)grp * 16 + r16;
        f32x4 acc = {0.f, 0.f, 0.f, 0.f}; float ss = 0.f;
#pragma unroll 4
        for (int s = 0; s < 32; ++s) { const int k0 = 32 * s + 8 * kg;
            const bf16x8 bh = *(const LAS bf16x8*)(thi + r16 * TP + k0), bl = *(const LAS bf16x8*)(tlo + r16 * TP + k0);
            if (B16IN) { const v4u a = *(const v4u*)((const bf16*)Xv + row * D + k0);
                ss += (h_lo(a.x) * h_lo(a.x) + h_hi(a.x) * h_hi(a.x)) + (h_lo(a.y) * h_lo(a.y) + h_hi(a.y) * h_hi(a.y)) + (h_lo(a.z) * h_lo(a.z) + h_hi(a.z) * h_hi(a.z)) + (h_lo(a.w) * h_lo(a.w) + h_hi(a.w) * h_hi(a.w));
                const h8n af = __builtin_bit_cast(h8n, a);
                acc = __builtin_amdgcn_mfma_f32_16x16x32_f16(af, __builtin_bit_cast(h8n, bh), acc, 0, 0, 0); acc = __builtin_amdgcn_mfma_f32_16x16x32_f16(af, __builtin_bit_cast(h8n, bl), acc, 0, 0, 0);
            } else { const f32x4 x0 = *(const f32x4*)((const float*)Xv + row * D + k0), x1 = *(const f32x4*)((const float*)Xv + row * D + k0 + 4);
                ss += (x0[0] * x0[0] + x0[1] * x0[1]) + (x0[2] * x0[2] + x0[3] * x0[3]) + (x1[0] * x1[0] + x1[1] * x1[1]) + (x1[2] * x1[2] + x1[3] * x1[3]);
                v4u o; o.x = pk2(x0[0], x0[1]); o.y = pk2(x0[2], x0[3]); o.z = pk2(x1[0], x1[1]); o.w = pk2(x1[2], x1[3]); *(v4u*)(XN + row * D + k0) = o;
                v4u ah, al;
                ah.x = pkh(x0[0], x0[1]); ah.y = pkh(x0[2], x0[3]); ah.z = pkh(x1[0], x1[1]); ah.w = pkh(x1[2], x1[3]);
                al.x = pkh(x0[0] - h_lo(ah.x), x0[1] - h_hi(ah.x)); al.y = pkh(x0[2] - h_lo(ah.y), x0[3] - h_hi(ah.y)); al.z = pkh(x1[0] - h_lo(ah.z), x1[1] - h_hi(ah.z)); al.w = pkh(x1[2] - h_lo(ah.w), x1[3] - h_hi(ah.w));
                const h8n afh = __builtin_bit_cast(h8n, ah), afl = __builtin_bit_cast(h8n, al);
                acc = __builtin_amdgcn_mfma_f32_16x16x32_f16(afh, __builtin_bit_cast(h8n, bh), acc, 0, 0, 0); acc = __builtin_amdgcn_mfma_f32_16x16x32_f16(afh, __builtin_bit_cast(h8n, bl), acc, 0, 0, 0);
                acc = __builtin_amdgcn_mfma_f32_16x16x32_f16(afl, __builtin_bit_cast(h8n, bh), acc, 0, 0, 0); } }
        ss += __shfl_xor(ss, 16); ss += __shfl_xor(ss, 32);
        const float rstd = 1.f / sqrtf(ss * (1.f / D) + RMS_EPS);
        if (kg == 0) rstdo[row] = rstd;
#pragma unroll
        for (int i = 0; i < 4; ++i) { const float rs = __shfl(rstd, 4 * kg + i); const float g = acc[i] * rs; const size_t m = (size_t)grp * 16 + 4 * kg + i;
            if (NG == 8) { if (r16 < 8) outA[m * 8 + r16] = log_sigmoid_f(g + bias_a[r16 & 7]); }
            else { if (r16 < 8) outA[m * 8 + r16] = g + bias_a[r16 & 7]; else outB[m * 8 + r16 - 8] = log_sigmoid_f(g + bias_b[r16 & 7]); } }
    }
}
__device__ __forceinline__ void cumsum_phase(const Ctx& C) {
    if (C.bid >= 16) return;
    const int bh = C.bid, b = bh >> 3, h = bh & 7, t = (int)threadIdx.x;
    const float* lp = (const float*)(C.ws + WS_LOGF) + ((size_t)b * SEQ + 32 * t) * 8 + h;
    float v[32]; float run = 0.f;
#pragma unroll
    for (int i = 0; i < 32; ++i) { run += lp[i * 8]; v[i] = run; }
    float x = run;
#pragma unroll
    for (int o = 1; o < 64; o <<= 1) { const float y = __shfl_up(x, o); if (((int)threadIdx.x & 63) >= o) x += y; }
    volatile LAS float* wt = (volatile LAS float*)(C.lds + LDSCTL_OFF);
    if (((int)threadIdx.x & 63) == 63) wt[__builtin_amdgcn_readfirstlane((int)threadIdx.x >> 6)] = x;
    __syncthreads();
    float off = x - run;
    for (int w = 0; w < __builtin_amdgcn_readfirstlane((int)threadIdx.x >> 6); ++w) off += wt[w];
    float* F2 = (float*)(C.ws + WS_F2) + (size_t)bh * SEQ + 32 * t;
    v4u* QE = (v4u*)(C.ws + WS_QE) + (size_t)bh * SEQ + 32 * t; v4u* KE = (v4u*)(C.ws + WS_KE) + (size_t)bh * SEQ + 32 * t;
#pragma unroll
    for (int i = 0; i < 32; ++i) { const float f = (off + v[i]) * LOG2E; F2[i] = f;
        const unsigned h0 = f2bf(f); const float r1 = f - __builtin_bit_cast(float, h0 << 16); const unsigned h1 = f2bf(r1); const float r2 = r1 - __builtin_bit_cast(float, h1 << 16); const unsigned h2 = f2bf(r2);
        v4u q; q.x = h0 | (h1 << 16); q.y = h2 | (0x3F80u << 16); q.z = 0x3F80u | (0x3F80u << 16); q.w = 0u; QE[i] = q;
        v4u k; k.x = 0x3F80u | (0x3F80u << 16); k.y = 0x3F80u | ((h0 ^ 0x8000u) << 16); k.z = (h1 ^ 0x8000u) | ((h2 ^ 0x8000u) << 16); k.w = 0u; KE[i] = k; }
    __syncthreads();
}
__device__ __forceinline__ void he_cols(int he, int& qc, int& kc, int& vc, int& oc) {
    if (he < 8) { qc = he * 64; kc = 512 + he * 64; vc = 1024 + he * 64; oc = he * 64; }
    else { const int j = he - 8, hd = j >> 2, c = (j >> 1) & 1, e = j & 1; qc = 1536 + (hd * 2 + c) * 64; kc = 2048 + (hd * 2 + c) * 64; vc = 2560 + hd * 128 + e * 64; oc = 512 + j * 64; }
}
__device__ __forceinline__ int fox_t0(const float* F2b, int qb, float qk2, int lane) {
    const int NTf = 4 * (qb + 1); const float fq = F2b[qb * 256]; int cnt = 0;
#pragma unroll
    for (int k = 0; k < 4; ++k) { const int t = lane + 64 * k; const bool skip = (t < NTf) && (qk2 + fq - F2b[64 * t + 63] < -150.f); cnt += __builtin_popcountll(__ballot(skip)); }
    int t0 = cnt; if (t0 > NTf - 4) t0 = NTf - 4; return __builtin_amdgcn_readfirstlane(t0);
}
__device__ __forceinline__ void attn_tuned_phase(const Ctx& C) {
    typedef attn_body::bf16 abf;
    const abf* P = (const abf*)(C.ws + WS_PROJ); abf* OB = (abf*)(C.ws + WS_OB); const float* F2 = (const float*)(C.ws + WS_F2); const abf* KE = (const abf*)(C.ws + WS_KE);
    const int vcu = (C.G % 8 == 0) ? (C.bid % 8) * (C.G / 8) + C.bid / 8 : C.bid;
    char* shm = C.ldsg + RING_OFF; gu32* ctl = (gu32*)(C.ws + WS_CTL);
    const int tid = threadIdx.x;
    volatile LAS unsigned* qslot = (volatile LAS unsigned*)(C.lds + LDSCTL_OFF + 64);
    bool fox_nomax, diff_nomax;
    { const int l = tid & 63; float bound = 0.f;
      if (l < 32) { const int dif = l >> 4, i = l & 15; const gu32* nq = ctl + CW_NRM + dif * 64 + i * 2; const gu32* nk = nq + 32;
          const float qn2 = __builtin_bit_cast(float, __hip_atomic_load(nq, RLX_AGENT)) + __builtin_bit_cast(float, __hip_atomic_load(nq + 1, RLX_AGENT));
          const float kn2 = __builtin_bit_cast(float, __hip_atomic_load(nk, RLX_AGENT)) + __builtin_bit_cast(float, __hip_atomic_load(nk + 1, RLX_AGENT));
          bound = 1.02f * sqrtf(qn2 * kn2); }
      const unsigned long long ok = __ballot(bound <= 100.f);
      fox_nomax = (ok & 0xffffull) == 0xffffull; diff_nomax = ((ok >> 16) & 0xffffull) == 0xffffull; }
#ifndef ATT_NO_DIFF
    float lam;
    { const int l = tid & 63; const float d1 = kin(5)[l] * kin(6)[l], d2 = kin(7)[l] * kin(8)[l]; lam = __expf(wave_sum(d1)) - __expf(wave_sum(d2)) + 0.2f; }
    float* subg = (float*)(C.ws + WS_SUBG);
    if (tid < 128) subg[tid] = kin(9)[tid] * 0.8f;
    abf* Yd = (abf*)(C.ws + WS_XN);
#define DIFF_LOOP(NM) _Pragma("nounroll") \
    for (int it = 0; it < 8 * 8 * 64; ++it) { const int p = vcu + (it >> 2) * C.G; if (p >= 8 * 32) break; \
        const int bh = p >> 5, s = p & 31, b = bh >> 2, hd = bh & 3, c = it & 1, qb = (it & 2) ? 63 - s : s; \
        const abf* Pb = P + (size_t)b * SEQ * NPJ; abf* Osc = OB + (size_t)b * SEQ * 512 + hd * 128; \
        const abf* KTb = (const abf*)(C.ws + WS_OB + 32 * MiB) + (size_t)((b * 8 + hd * 2 + c) * 256) * 4096; const abf* VTb = (const abf*)(C.ws + WS_OB + 64 * MiB) + (size_t)((b * 4 + hd) * 256) * 8192; \
        attn256::unit<8, 4, false, NM>(c, qb, 0, Pb + 1536 + (hd * 2 + c) * 64, KTb, VTb, Osc, Pb + 3072 + 512 + hd * 128, Yd + (size_t)b * SEQ * 1024 + 512 + hd * 128, subg, lam, nullptr, nullptr, shm); }
    if (diff_nomax) { DIFF_LOOP(true) } else { DIFF_LOOP(false) }
#undef DIFF_LOOP
#endif
#ifndef ATT_NO_FOX
    if (tid == 0) *qslot = __hip_atomic_fetch_add(ctl + CW_FOXQ, 1u, RLX_AGENT);
    __syncthreads();
    unsigned u = __builtin_amdgcn_readfirstlane(*qslot);
#define FOX_LOOP(NM) _Pragma("nounroll") \
    while (u < 1024u) { \
        __syncthreads(); \
        if (tid == 0) *qslot = __hip_atomic_fetch_add(ctl + CW_FOXQ, 1u, RLX_AGENT); \
        const int qb = 63 - (int)(u >> 4), bh = (int)(u & 15u), b = bh >> 3, he = bh & 7; int qc, kc, vc, oc; he_cols(he, qc, kc, vc, oc); \
        const gu32* nq = ctl + CW_NRM + ((0 * 2 + b) * 8 + he) * 2; const gu32* nk = ctl + CW_NRM + ((1 * 2 + b) * 8 + he) * 2; \
        const float qn2 = __builtin_bit_cast(float, __hip_atomic_load(nq, RLX_AGENT)) + __builtin_bit_cast(float, __hip_atomic_load(nq + 1, RLX_AGENT)); \
        const float kn2 = __builtin_bit_cast(float, __hip_atomic_load(nk, RLX_AGENT)) + __builtin_bit_cast(float, __hip_atomic_load(nk + 1, RLX_AGENT)); \
        const float qk2 = 2.04f * sqrtf(qn2 * kn2); \
        const float* F2b = F2 + (size_t)bh * SEQ; \
        const int t0 = fox_t0(F2b, qb, qk2, tid & 63); \
        const abf* Pb = P + (size_t)b * SEQ * NPJ; \
        attn256::unit<8, 2, true, NM>(2, qb, t0, Pb + qc, Pb + kc, Pb + vc, nullptr, Pb + 3072 + oc, (abf*)(C.ws + WS_XN) + (size_t)b * SEQ * 1024 + oc, nullptr, 0.f, F2b, KE + (size_t)bh * SEQ * 8, shm); \
        u = __builtin_amdgcn_readfirstlane(*qslot); }
    if (fox_nomax) { FOX_LOOP(true) } else { FOX_LOOP(false) }
#undef FOX_LOOP
#endif
}
__device__ __forceinline__ void final_norm_phase(const Ctx& C, const bf16* X2) {
    const int lane = (int)threadIdx.x & 63, gw = C.bid * NWAVES + __builtin_amdgcn_readfirstlane((int)threadIdx.x >> 6), NGW = C.G * NWAVES; const float* g = kin(16);
    f32x4 gv[4];
#pragma unroll
    for (int j = 0; j < 4; ++j) gv[j] = ((const f32x4*)g)[lane + 64 * j];
    unsigned long long nh[4];
#define FN_LOAD(mm) do { const GAS unsigned long long* xb = (const GAS unsigned long long*)(X2 + (size_t)(mm) * D) + lane; _Pragma("unroll") for (int j = 0; j < 4; ++j) nh[j] = xb[64 * j]; } while (0)
    if (gw < M) FN_LOAD(gw);
    for (int m = gw; m < M; m += NGW) {
        f32x4 v[4]; float ss = 0.f;
#pragma unroll
        for (int j = 0; j < 4; ++j) { const unsigned long long w = nh[j]; const unsigned lo = (unsigned)w, hi = (unsigned)(w >> 32); v[j] = (f32x4){h_lo(lo), h_hi(lo), h_lo(hi), h_hi(hi)};
            ss += (v[j].x * v[j].x + v[j].y * v[j].y) + (v[j].z * v[j].z + v[j].w * v[j].w); }
        if (m + NGW < M) FN_LOAD(m + NGW);
        const float rstd = 1.f / sqrtf(wave_sum(ss) * (1.f / D) + RMS_EPS);
        GAS f32x4* xr = (GAS f32x4*)(C.out + (size_t)m * D) + lane;
#pragma unroll
        for (int j = 0; j < 4; ++j) xr[64 * j] = v[j] * rstd * gv[j];
    }
}
#undef FN_LOAD
typedef float f32x16m __attribute__((ext_vector_type(16)));
typedef _Float16 h8m __attribute__((ext_vector_type(8))); typedef _Float16 h2m __attribute__((ext_vector_type(2))); typedef float f2m __attribute__((ext_vector_type(2)));
__device__ __forceinline__ unsigned pkh2(float lo, float hi) { const f2m v = {lo, hi}; return __builtin_bit_cast(unsigned, __builtin_convertvector(v, h2m)); }
__device__ __forceinline__ float hlo(unsigned w) { return (float)__builtin_bit_cast(h2m, w)[0]; }
__device__ __forceinline__ float hhi(unsigned w) { return (float)__builtin_bit_cast(h2m, w)[1]; }
#define MFMA_H(a, b, c) __builtin_amdgcn_mfma_f32_32x32x16_f16(__builtin_bit_cast(h8m, (a)), __builtin_bit_cast(h8m, (b)), (c), 0, 0, 0)
typedef short s16x4m __attribute__((ext_vector_type(4)));
__device__ __forceinline__ int crow_m(int reg, int hh) { return (reg & 3) + 8 * (reg >> 2) + 4 * hh; }
__device__ __forceinline__ s16x4m tr4(const LAS unsigned char* p) { return __builtin_bit_cast(s16x4m, __builtin_amdgcn_ds_read_tr16_b64_v4i16((LAS s16x4m*)p)); }
__device__ __forceinline__ bf16x8 tr_frag(const LAS unsigned char* base, int stride, int row0, int col0, int lane, int hmul, int rstep) {
    const int hh = lane >> 5, blk = (lane >> 4) & 1, q = (lane & 15) >> 2, p = lane & 3;
    const LAS unsigned char* a = base + (row0 + hmul * hh + q) * stride + (col0 + 16 * blk + 4 * p) * 2;
    const s16x4m lo = tr4(a), hi = tr4(a + rstep * stride);
    return (bf16x8){lo[0], lo[1], lo[2], lo[3], hi[0], hi[1], hi[2], hi[3]};
}
__device__ __forceinline__ void mlstm_scan_phase(const Ctx& C) {
    const int lane = threadIdx.x & 63, gw = C.bid * NWAVES + __builtin_amdgcn_readfirstlane((int)threadIdx.x >> 6), NGW = C.G * NWAVES;
    const float* LI = (const float*)(C.ws + WS_LI); const float* LF = (const float*)(C.ws + WS_LF);
    float* GB = (float*)(C.ws + WS_GB); float* GE = (float*)(C.ws + WS_GE); float* GU = (float*)(C.ws + WS_GU); float* CHA = (float*)(C.ws + WS_CHA); float* CHE = (float*)(C.ws + WS_CHE);
    for (int id = gw; id < 2048; id += NGW) { const int bh = id >> 7, c = id & 127, b = bh >> 3, h = bh & 7; const size_t r0 = (size_t)b * SEQ + c * 128 + 2 * lane;
        const float lf0 = LF[r0 * 8 + h], lf1 = LF[(r0 + 1) * 8 + h], li0 = LI[r0 * 8 + h], li1 = LI[(r0 + 1) * 8 + h];
        const float ps = lf0 + lf1; float x = ps;
#pragma unroll
        for (int o = 1; o < 64; o <<= 1) { const float y = __shfl_up(x, o); if (lane >= o) x += y; }
        const float b0 = (x - ps) + lf0, b1 = x, e0 = li0 - b0, e1 = li1 - b1;
        float y = fmaxf(e0, e1);
#pragma unroll
        for (int o = 1; o < 64; o <<= 1) { const float z = __shfl_up(y, o); if (lane >= o) y = fmaxf(y, z); }
        float prev = __shfl_up(y, 1); if (lane == 0) prev = -INFINITY;
        const float u0 = fmaxf(prev, e0), u1 = fmaxf(u0, e1);
        const size_t o2 = (size_t)id * 128 + 2 * lane;
        *(float2*)(GB + o2) = make_float2(b0, b1); *(float2*)(GE + o2) = make_float2(e0, e1); *(float2*)(GU + o2) = make_float2(u0, u1);
        if (lane == 63) { CHA[id] = b1; CHE[id] = u1; }
    }
}
__device__ __forceinline__ void mlstm_dc_phase(const Ctx& C) {
    const int tid = threadIdx.x, lane = tid & 63, wave = __builtin_amdgcn_readfirstlane(tid >> 6);
    const bf16* P = (const bf16*)(C.ws + WS_PROJ); bf16* DC = (bf16*)(C.ws + WS_OB); float* DN = (float*)(C.ws + WS_DN);
    const float* GE = (const float*)(C.ws + WS_GE); const float* CHE = (const float*)(C.ws + WS_CHE);
    LAS unsigned char* Ks = C.lds; LAS unsigned char* Vs = C.lds + 18432; LAS float* wsm = (LAS float*)(C.lds + 53248);
    v4u pk[2], pv[4]; float pge = 0.f, pche = 0.f;
#define M3_LOAD(u_) do { const int bh_ = (u_) >> 7, c_ = (u_) & 127, b_ = bh_ >> 3, h_ = bh_ & 7; const size_t r0_ = (size_t)b_ * SEQ + c_ * 128; \
        _Pragma("unroll") for (int i = 0; i < 2; ++i) { const int idx = tid + 512 * i, r = idx >> 3, ch = idx & 7; pk[i] = *(const v4u*)(P + (size_t)16777216 + (size_t)(u_) * 8192 + r * 64 + ch * 8); } \
        _Pragma("unroll") for (int i = 0; i < 4; ++i) { const int idx = tid + 512 * i, r = idx >> 4, ch = idx & 15; pv[i] = *(const v4u*)(P + (size_t)33554432 + (size_t)(u_) * 16384 + r * 128 + ch * 8); } \
        pche = CHE[(u_)]; if (tid < 128) pge = GE[(size_t)(u_) * 128 + tid]; } while (0)
    int unit = C.bid; if (unit < 2048) M3_LOAD(unit);
    while (unit < 2048) {
        if (tid < 128) wsm[tid] = __expf(pge - pche);
#pragma unroll
        for (int i = 0; i < 2; ++i) { const int idx = tid + 512 * i, r = idx >> 3, ch = idx & 7; *(LAS v4u*)(Ks + r * 144 + ch * 16) = pk[i]; }
        __syncthreads();
#pragma unroll
        for (int i = 0; i < 4; ++i) { const int idx = tid + 512 * i, r = idx >> 4, ch = idx & 15; const v4u v = pv[i]; const float w = wsm[r]; v4u o;
            o.x = pkh2(hlo(v.x) * w, hhi(v.x) * w); o.y = pkh2(hlo(v.y) * w, hhi(v.y) * w); o.z = pkh2(hlo(v.z) * w, hhi(v.z) * w); o.w = pkh2(hlo(v.w) * w, hhi(v.w) * w);
            *(LAS v4u*)(Vs + r * 272 + ch * 16) = o; }
        __syncthreads();
        const int cur = unit; unit += C.G; if (unit < 2048) M3_LOAD(unit);
        { const int db = wave >> 2, eb = wave & 3, r = lane & 31, hh = lane >> 5; f32x16m acc = {};
#pragma unroll
          for (int ks = 0; ks < 8; ++ks) { const bf16x8 a = tr_frag(Ks, 144, 16 * ks, 32 * db, lane, 8, 4), bb = tr_frag(Vs, 272, 16 * ks, 32 * eb, lane, 8, 4);
              acc = MFMA_H(a, bb, acc); }
          bf16* o = DC + (size_t)cur * 8192 + (size_t)(32 * eb + r) * 64 + 32 * db + 4 * hh;
#pragma unroll
          for (int g = 0; g < 4; ++g) { unsigned long long w = (unsigned long long)pkh2(acc[4 * g], acc[4 * g + 1]) | ((unsigned long long)pkh2(acc[4 * g + 2], acc[4 * g + 3]) << 32); *(unsigned long long*)(o + 8 * g) = w; } }
        if (tid < 64) { float acc = 0.f; for (int s = 0; s < 128; ++s) acc += wsm[s] * (float)*(const LAS _Float16*)(Ks + s * 144 + tid * 2); DN[(size_t)cur * 64 + tid] = acc; }
        __syncthreads();
    }
#undef M3_LOAD
}
__device__ __forceinline__ void mlstm_state_phase(const Ctx& C) {
    const int tid = threadIdx.x;
    const bf16* DC = (const bf16*)(C.ws + WS_OB); bf16* CST = (bf16*)(C.ws + WS_OB + 64 * MiB); const float* DN = (const float*)(C.ws + WS_DN); float* NS = (float*)(C.ws + WS_NS);
    const float* CHA = (const float*)(C.ws + WS_CHA); const float* CHE = (const float*)(C.ws + WS_CHE); float* CHM = (float*)(C.ws + WS_CHM);
    LAS float* wold = (LAS float*)(C.lds); LAS float* scl = wold + 128; LAS float* aa = scl + 128; LAS float* ee = aa + 128;
    for (int vb = C.bid; vb < 256; vb += C.G) { const int bh = vb >> 4, part = vb & 15;
        if (tid < 128) { aa[tid] = CHA[bh * 128 + tid]; ee[tid] = CHE[bh * 128 + tid]; }
        __syncthreads();
        if (tid < 64) { const float a0 = aa[2 * tid], e0 = ee[2 * tid], a1 = aa[2 * tid + 1], e1 = ee[2 * tid + 1];
            float A = a0 + a1, B = fmaxf(e0 + a0 + a1, e1 + a1);
#pragma unroll
            for (int o = 1; o < 64; o <<= 1) { const float Ap = __shfl_up(A, o), Bp = __shfl_up(B, o); if (tid >= o) { B = fmaxf(Bp + A, B); A = Ap + A; } }
            float Ae = __shfl_up(A, 1), Be = __shfl_up(B, 1); if (tid == 0) { Ae = 0.f; Be = -INFINITY; }
            const float m0 = fmaxf(0.f + Ae, Be), mx0 = fmaxf(m0, e0), m1 = a0 + mx0, mx1 = fmaxf(m1, e1);
            wold[2 * tid] = __expf(m0 - mx0); scl[2 * tid] = __expf(e0 - mx0); wold[2 * tid + 1] = __expf(m1 - mx1); scl[2 * tid + 1] = __expf(e1 - mx1);
            if (part == 0) { CHM[bh * 128 + 2 * tid] = m0; CHM[bh * 128 + 2 * tid + 1] = m1; } }
        __syncthreads();
        { const size_t idx = (size_t)part * 512 + tid; const bf16* dc = DC + (size_t)bh * 128 * 8192 + idx; bf16* cs = CST + (size_t)bh * 128 * 8192 + idx; float cv = 0.f;
#pragma unroll 16
          for (int c = 0; c < 128; ++c) { const float d = (float)__builtin_bit_cast(_Float16, dc[(size_t)c * 8192]); cs[(size_t)c * 8192] = __builtin_bit_cast(unsigned short, (_Float16)fminf(fmaxf(cv, -60000.f), 60000.f)); cv = wold[c] * cv + scl[c] * d; } }
        if (part == 0 && tid < 64) { const float* dn = DN + (size_t)bh * 128 * 64 + tid; float* ns = NS + (size_t)bh * 128 * 64 + tid; float nv = 0.f;
#pragma unroll 8
          for (int c = 0; c < 128; ++c) { const float d = dn[c * 64]; ns[c * 64] = nv; nv = wold[c] * nv + scl[c] * d; } }
        __syncthreads();
    }
#undef M5_LOAD
}
__device__ __forceinline__ void mlstm_out_phase(const Ctx& C) {
    const int tid = threadIdx.x, lane = tid & 63, wave = __builtin_amdgcn_readfirstlane(tid >> 6);
    const bf16* P = (const bf16*)(C.ws + WS_PROJ); bf16* Y = (bf16*)(C.ws + WS_XN); const bf16* CST = (const bf16*)(C.ws + WS_OB + 64 * MiB); const float* NS = (const float*)(C.ws + WS_NS);
    const float* GB = (const float*)(C.ws + WS_GB); const float* GE = (const float*)(C.ws + WS_GE); const float* GU = (const float*)(C.ws + WS_GU); const float* CHM = (const float*)(C.ws + WS_CHM);
    LAS unsigned char* Qs = C.lds; LAS unsigned char* Ks = C.lds + 18432; LAS unsigned char* Vs = C.lds + 36864; LAS unsigned char* Cts = C.lds + 71680;
    LAS float* e2 = (LAS float*)(C.lds + 90112); LAS float* M2 = e2 + 128; LAS float* wint = M2 + 128; LAS float* flr = wint + 128; LAS float* nsl = flr + 128; LAS float* invw = nsl + 64 + wave * 32;
    LAS float* Hs = (LAS float*)(C.lds);
    v4u pq[2], pkk[2], pc[2], pv[4], pog[4]; float pe = 0.f, pu = 0.f, pb = 0.f, pns = 0.f, pmc = 0.f;
#define M5_LOAD(u_) do { const int bh_ = (u_) >> 7, c_ = (u_) & 127, b_ = bh_ >> 3, h_ = bh_ & 7; const size_t r0_ = (size_t)b_ * SEQ + c_ * 128; \
        _Pragma("unroll") for (int i = 0; i < 2; ++i) { const int idx = tid + 512 * i, r = idx >> 3, ch = idx & 7; const bf16* src = P + (size_t)(u_) * 8192 + r * 64 + ch * 8; \
            pq[i] = *(const v4u*)(src); pkk[i] = *(const v4u*)(src + 16777216); pc[i] = *(const v4u*)(CST + (size_t)(u_) * 8192 + r * 64 + ch * 8); } \
        _Pragma("unroll") for (int i = 0; i < 4; ++i) { const int idx = tid + 512 * i, r = idx >> 4, ch = idx & 15; pv[i] = *(const v4u*)(P + (size_t)33554432 + (size_t)(u_) * 16384 + r * 128 + ch * 8); } \
        pmc = CHM[(u_)]; if (tid < 128) { const size_t gi = (size_t)(u_) * 128 + tid; pe = GE[gi]; pu = GU[gi]; pb = GB[gi]; } else if (tid < 192) pns = NS[(size_t)(u_) * 64 + tid - 128]; } while (0)
    int unit = C.bid; if (unit < 2048) M5_LOAD(unit);
    while (unit < 2048) { const int bh = unit >> 7, c = unit & 127, b = bh >> 3, h = bh & 7; const size_t row0 = (size_t)b * SEQ + c * 128;
        { const float mc = pmc;
          if (tid < 128) { const float Mt = fmaxf(mc, pu); e2[tid] = pe * LOG2E; M2[tid] = Mt * LOG2E; wint[tid] = __expf(mc - Mt); flr[tid] = __expf(-(pb + Mt)); }
          else if (tid < 192) nsl[tid - 128] = pns; }
#pragma unroll
        for (int i = 0; i < 2; ++i) { const int idx = tid + 512 * i, r = idx >> 3, ch = idx & 7; *(LAS v4u*)(Qs + r * 144 + ch * 16) = pq[i]; *(LAS v4u*)(Ks + r * 144 + ch * 16) = pkk[i]; *(LAS v4u*)(Cts + r * 144 + ch * 16) = pc[i]; }
#pragma unroll
        for (int i = 0; i < 4; ++i) { const int idx = tid + 512 * i, r = idx >> 4, ch = idx & 15; *(LAS v4u*)(Vs + r * 272 + ch * 16) = pv[i]; }
        __syncthreads();
        { const int nxt = unit + C.G; if (nxt < 2048) M5_LOAD(nxt); }
        const int tb = wave & 3, eh = wave >> 2, r = lane & 31, hh = lane >> 5;
        f32x16m acc[2]; acc[0] = f32x16m{}; acc[1] = f32x16m{};
        bf16x8 qf[4];
#pragma unroll
        for (int kd = 0; kd < 4; ++kd) qf[kd] = *(const LAS bf16x8*)(Qs + (32 * tb + r) * 144 + (16 * kd + 8 * hh) * 2);
#pragma unroll
        for (int kd = 0; kd < 4; ++kd)
#pragma unroll
            for (int j = 0; j < 2; ++j) { const bf16x8 cf = *(const LAS bf16x8*)(Cts + (64 * eh + 32 * j + r) * 144 + (16 * kd + 8 * hh) * 2); acc[j] = MFMA_H(qf[kd], cf, acc[j]); }
#pragma unroll
        for (int g = 0; g < 4; ++g) { const f32x4 w4 = *(const LAS f32x4*)(wint + 32 * tb + 8 * g + 4 * hh);
#pragma unroll
            for (int i = 0; i < 4; ++i) { acc[0][4 * g + i] *= w4[i]; acc[1][4 * g + i] *= w4[i]; } }
        float qn = 0.f;
#pragma unroll
        for (int c4 = 0; c4 < 4; ++c4) { const v4u qv = *(const LAS v4u*)(Qs + (32 * tb + r) * 144 + (32 * hh + 8 * c4) * 2); const f32x4 n0 = *(const LAS f32x4*)(nsl + 32 * hh + 8 * c4), n1 = *(const LAS f32x4*)(nsl + 32 * hh + 8 * c4 + 4);
            qn += hlo(qv.x) * n0[0] + hhi(qv.x) * n0[1] + hlo(qv.y) * n0[2] + hhi(qv.y) * n0[3] + hlo(qv.z) * n1[0] + hhi(qv.z) * n1[1] + hlo(qv.w) * n1[2] + hhi(qv.w) * n1[3]; }
        float den = 0.f; const float M2t = M2[32 * tb + r];
        for (int sb = 0; sb <= tb; ++sb) {
            f32x16m X = {};
#pragma unroll
            for (int kd = 0; kd < 4; ++kd) { const bf16x8 kf = *(const LAS bf16x8*)(Ks + (32 * sb + r) * 144 + (16 * kd + 8 * hh) * 2); X = MFMA_H(kf, qf[kd], X); }
#pragma unroll
            for (int g = 0; g < 4; ++g) { const f32x4 e4 = *(const LAS f32x4*)(e2 + 32 * sb + 8 * g + 4 * hh);
#pragma unroll
                for (int i = 0; i < 4; ++i) { const bool valid = (sb < tb) || (8 * g + 4 * hh + i <= r); const float p = valid ? X[4 * g + i] * __builtin_amdgcn_exp2f(e4[i] - M2t) : 0.f; den += p; X[4 * g + i] = p; } }
#pragma unroll
            for (int ks2 = 0; ks2 < 2; ++ks2) { u32x4m pw; pw.x = pkh2(X[8 * ks2], X[8 * ks2 + 1]); pw.y = pkh2(X[8 * ks2 + 2], X[8 * ks2 + 3]); pw.z = pkh2(X[8 * ks2 + 4], X[8 * ks2 + 5]); pw.w = pkh2(X[8 * ks2 + 6], X[8 * ks2 + 7]);
                const bf16x8 pf = __builtin_bit_cast(bf16x8, pw);
#pragma unroll
                for (int j = 0; j < 2; ++j) { const bf16x8 vf = tr_frag(Vs, 272, 32 * sb + 16 * ks2, 64 * eh + 32 * j, lane, 4, 8); acc[j] = MFMA_H(pf, vf, acc[j]); } }
        }
        { const auto rr = __builtin_amdgcn_permlane32_swap(__float_as_uint(den), __float_as_uint(den), false, false); den = __uint_as_float(rr[0]) + __uint_as_float(rr[1]);
          const auto r2 = __builtin_amdgcn_permlane32_swap(__float_as_uint(qn), __float_as_uint(qn), false, false); qn = __uint_as_float(r2[0]) + __uint_as_float(r2[1]); }
        const float denT = wint[32 * tb + r] * qn + den, invv = 1.f / fmaxf(fabsf(denT), flr[32 * tb + r]);
        if (hh == 0) invw[r] = invv;
        LDS_WAIT();
#pragma unroll
        for (int g = 0; g < 4; ++g) { const f32x4 i4 = *(const LAS f32x4*)(invw + 8 * g + 4 * hh);
#pragma unroll
            for (int i = 0; i < 4; ++i) { acc[0][4 * g + i] *= i4[i]; acc[1][4 * g + i] *= i4[i]; } }
#pragma unroll
        for (int i = 0; i < 4; ++i) { const int idx = tid + 512 * i, t = idx >> 4, ch = idx & 15; pog[i] = *(const v4u*)(P + (size_t)67108864 + (size_t)unit * 16384 + t * 128 + ch * 8); }
        __syncthreads();
#pragma unroll
        for (int j = 0; j < 2; ++j)
#pragma unroll
            for (int reg = 0; reg < 16; ++reg) Hs[(32 * tb + crow_m(reg, hh)) * 132 + 64 * eh + 32 * j + r] = acc[j][reg];
        __syncthreads();
#pragma unroll
        for (int i = 0; i < 4; ++i) { const int idx = tid + 512 * i, t = idx >> 4, ch = idx & 15; const f32x4 h0 = *(const LAS f32x4*)(Hs + t * 132 + ch * 8), h1 = *(const LAS f32x4*)(Hs + t * 132 + ch * 8 + 4);
            const v4u gg = pog[i]; v4u o;
            o.x = pk2(bflo(gg.x) * h0[0], bfhi(gg.x) * h0[1]); o.y = pk2(bflo(gg.y) * h0[2], bfhi(gg.y) * h0[3]); o.z = pk2(bflo(gg.z) * h1[0], bfhi(gg.z) * h1[1]); o.w = pk2(bflo(gg.w) * h1[2], bfhi(gg.w) * h1[3]);
            *(v4u*)(Y + (row0 + t) * 1024 + h * 128 + ch * 8) = o; }
        unit += C.G;
        __syncthreads();
    }
#undef M5_LOAD
}
#ifndef WGM_PROJ
#define WGM_PROJ 2
#endif
#ifndef WGM_OUT
#define WGM_OUT 2
#endif
struct Args { const float* in[17]; float* out; unsigned char* ws; int ph_lo, ph_hi; };
__global__ void __launch_bounds__(NWAVES * 64, 2) fwd_kernel(Args args) {
    extern __shared__ __attribute__((aligned(16))) unsigned char lds[];
    Ctx C;
    C.lds = (LAS unsigned char*)lds; C.ldsg = (char*)lds; C.G = gridDim.x; C.bid = blockIdx.x;
    C.out = args.out; C.ws = args.ws;
    volatile LAS unsigned* MISC = (volatile LAS unsigned*)(C.lds + MISC_OFF);
    gu32* ctl = (gu32*)(C.ws + WS_CTL);
    for (int u = (int)threadIdx.x; u < (LDS_BYTES - LDSCTL_OFF) / 4; u += NWAVES * 64) ((LAS unsigned*)(C.lds + LDSCTL_OFF))[u] = 0u;
    __syncthreads();
    XcdBarrier bar; bar.bar = (unsigned*)(ctl + CW_BAR); bar.x = 0; bar.st = nullptr;
    if (MK_ONE_LAUNCH) bar = xcd_barrier_post((unsigned*)(ctl + CW_BAR), MISC + 8);
#define GRID_BAR() do { if (MK_ONE_LAUNCH) xcd_barrier(bar); } while (0)
    const int lo = args.ph_lo, hi = args.ph_hi;
#ifndef PH_MASK
#define PH_MASK 0xffff
#endif
#define IN(k) (((PH_MASK >> (k)) & 1) && lo <= (k) && (k) < hi)
#define BOTH(k) (IN(k) && IN((k) + 1))
    bf16* XN = (bf16*)(C.ws + WS_XN); bf16* PROJ = (bf16*)(C.ws + WS_PROJ);
    bf16* X1B = (bf16*)C.out;
    bf16* X2B = (bf16*)(C.ws + WS_OB);

    if (IN(0)) { prologue_weights(C); __syncthreads();
        norm_gate_phase<8, false>(C, kin(0), kin(3), ATTN_IN, 1536, kin(2), kin(4), nullptr, XN, (float*)(C.ws + WS_LOGF), nullptr, (float*)(C.ws + WS_RSTD));
        if (BOTH(0)) GRID_BAR(); }
    if (IN(1)) { cumsum_phase(C);
      {
        pg8::Gemm g{XN, (const bf16*)(C.ws + WS_WIN0), M, NPJ, D}; pg8::StaticOrder S; S.init(M, NPJ, C.G, C.bid, WGM_PROJ);
        pg8::EpiProj0 E{PROJ, (const float*)(C.ws + WS_ROPE), C2, (unsigned*)(ctl + CW_NRM), (bf16*)(C.ws + WS_OB + 32 * MiB), (bf16*)(C.ws + WS_OB + 64 * MiB), (const float*)(C.ws + WS_RSTD)};
        pg8::gemm_phase<pg8::EpiProj0, pg8::StaticOrder, true, true>(C.lds + RING_OFF, g, S, E);
        if (BOTH(1)) GRID_BAR(); } }
    if (IN(2)) { attn_tuned_phase(C);
        if (BOTH(2)) GRID_BAR(); }
    if (IN(4)) { pg8::Gemm g{XN, (const bf16*)(C.ws + WS_WOUT0), M, D, D}; pg8::StaticOrder S; S.init(M, D, C.G, C.bid, WGM_OUT);
        pg8::EpiResidF2B E{kin(0), X1B};
        pg8::gemm_phase<pg8::EpiResidF2B, pg8::StaticOrder, true, true>(C.lds + RING_OFF, g, S, E);
        if (BOTH(4)) GRID_BAR(); }
    if (IN(5)) { norm_gate_phase<16, true>(C, X1B, kin(12), ML_IN, 2048, kin(11), kin(13), kin(14), nullptr, (float*)(C.ws + WS_LI), (float*)(C.ws + WS_LF), (float*)(C.ws + WS_RSTD));
        if (BOTH(5)) GRID_BAR(); }
    if (IN(6)) { mlstm_scan_phase(C);
        pg8::Gemm g{X1B, (const bf16*)(C.ws + WS_WIN1), M, NPJ, D}; pg8::StaticOrder S; S.init(M, NPJ, C.G, C.bid, WGM_PROJ);
        pg8::EpiProj1 E{PROJ, (const float*)(C.ws + WS_RSTD)};
        pg8::gemm_phase<pg8::EpiProj1, pg8::StaticOrder, true, true, true>(C.lds + RING_OFF, g, S, E);
        if (BOTH(6)) GRID_BAR(); }
    {
    if (IN(7)) { mlstm_dc_phase(C); if (BOTH(7)) GRID_BAR(); }
    if (IN(8)) {
        mlstm_state_phase(C);
        if (BOTH(8)) GRID_BAR(); }
    if (IN(9)) {
        mlstm_out_phase(C);
        if (BOTH(9)) GRID_BAR(); }
    }
    if (IN(10)) { pg8::Gemm g{XN, (const bf16*)(C.ws + WS_WOUT1), M, D, D}; pg8::StaticOrder S; S.init(M, D, C.G, C.bid, WGM_OUT);
        pg8::EpiResidB2B E{X1B, X2B};
        pg8::gemm_phase<pg8::EpiResidB2B, pg8::StaticOrder, true, true>(C.lds + RING_OFF, g, S, E);
        if (BOTH(10)) GRID_BAR(); }
    if (IN(11)) { final_norm_phase(C, X2B); }
#undef IN
#undef BOTH
}

extern "C" void kernel_launch(void* const* d_in, const int* in_sizes, int n_in, void* d_out, int out_size, void* d_ws, size_t ws_size, hipStream_t stream) {
    static int grid = 0;
    if (grid == 0) {
        if (n_in != 17 || in_sizes[0] != M * D || out_size != M * D || ws_size < WS_END) { fprintf(stderr, "kernel_launch: unexpected shapes (n_in %d, in0 %d, out %d, ws %zu < %zu); nothing launched\n", n_in, n_in > 0 ? in_sizes[0] : -1, out_size, ws_size, (size_t)WS_END); grid = -1; return; }
        int dev = 0, cus = 0, per_cu = 0;
        if (hipGetDevice(&dev) != hipSuccess || hipDeviceGetAttribute(&cus, hipDeviceAttributeMultiprocessorCount, dev) != hipSuccess) { grid = -1; return; }
        if (hipFuncSetAttribute((const void*)fwd_kernel, hipFuncAttributeMaxDynamicSharedMemorySize, LDS_BYTES) != hipSuccess) { fprintf(stderr, "kernel_launch: hipFuncSetAttribute failed\n"); grid = -1; return; }
        if (hipOccupancyMaxActiveBlocksPerMultiprocessor(&per_cu, (const void*)fwd_kernel, NWAVES * 64, LDS_BYTES) != hipSuccess || per_cu < 1) fprintf(stderr, "kernel_launch: occupancy query reports %d\n", per_cu);
        (void)hipGetLastError();
        grid = cus;
    }
    if (grid < 0) return;
    if (hipMemsetAsync((char*)d_ws + WS_CTL, 0, CTL_ZERO_BYTES, stream) != hipSuccess) return;
    Args a{};
    for (int i = 0; i < 17; ++i) a.in[i] = (const float*)d_in[i];
    a.out = (float*)d_out; a.ws = (unsigned char*)d_ws;
    if (MK_ONE_LAUNCH) { a.ph_lo = 0; a.ph_hi = NPHASE; hipLaunchKernelGGL(fwd_kernel, dim3(grid), dim3(NWAVES * 64), LDS_BYTES, stream, a); }
    else for (int p = 0; p < NPHASE; ++p) { a.ph_lo = p; a.ph_hi = p + 1; hipLaunchKernelGGL(fwd_kernel, dim3(grid), dim3(NWAVES * 64), LDS_BYTES, stream, a); }
}
```

```cpp
#include <hip/hip_runtime.h>
#include <cstdio>
#include <cstdint>
namespace pg8 {
#define PG8_LAS __attribute__((address_space(3)))
typedef unsigned short bf16_t;
typedef short bf16x8 __attribute__((ext_vector_type(8)));
typedef float f32x4 __attribute__((ext_vector_type(4)));
typedef unsigned u32x4 __attribute__((ext_vector_type(4)));
constexpr int BM = 256, BK = 64, HALF = 128, HTB = HALF * BK * 2  , STAGE_BYTES = 8 * HTB, NXCD = 8, WGM = 2;

__host__ __device__ __forceinline__ int lds_byte(int r, int c) { const int st = (r >> 4) * 2 + (c >> 5), rr = r & 15, cc = c & 31, ob = rr * 64 + cc * 2; return st * 1024 + (ob ^ (((ob >> 9) & 1) << 5)); }
__host__ __device__ __forceinline__ void stage_rc(int b, int& R, int& C) { const int st = b / 1024, sb = b % 1024, swz = sb ^ (((sb >> 9) & 1) << 5); R = (st >> 1) * 16 + swz / 64; C = (st & 1) * 32 + (swz % 64) / 2; }
__host__ __device__ __forceinline__ int perm32(int rho) { const int n = rho >> 4, i = rho & 15; return 8 * (i >> 2) + 4 * n + (i & 3); }

struct Unit { int pm, pn; };
struct Gemm { const bf16_t* A; const bf16_t* Bt; int M, N, K; };

struct StaticOrder {
    int nM, nN, nwg, G, c, wgm;
    __host__ __device__ void init(int M, int N, int G_, int c_, int wgm_ = WGM) { nM = M / BM; nN = N / BM; nwg = nM * nN; G = G_; c = c_; wgm = wgm_; }
    __host__ __device__ bool next(int i, Unit& u) const {
        const long L = (long)i * G + c; if (L >= nwg) return false;
        int wgid = (int)L; { const int q = nwg / NXCD, r = nwg % NXCD, xcd = wgid % NXCD, off = wgid / NXCD; wgid = (xcd < r ? xcd * (q + 1) : r * (q + 1) + (xcd - r) * q) + off; }
        const int nig = wgm * nN, gid = wgid / nig, fm = gid * wgm, gsz = (nM - fm) < wgm ? (nM - fm) : wgm;
        u.pm = fm + ((wgid % nig) % gsz); u.pn = (wgid % nig) / gsz; return true;
    }
    __device__ __forceinline__ void a_ready(const Unit&) const {}
    __device__ __forceinline__ void done(const Unit&) const {}
};

__device__ __forceinline__ unsigned cvt_pk_bf16(float lo, float hi) { unsigned r; asm volatile("v_cvt_pk_bf16_f32 %0, %1, %2" : "=v"(r) : "v"(lo), "v"(hi)); return r; }
typedef float f32x2 __attribute__((ext_vector_type(2)));
__device__ __forceinline__ f32x2 gelu_pk(f32x2 v) {
    const f32x2 av = __builtin_elementwise_abs(v), d = av * 0.2316418882f + 1.0f;
    f32x2 t; t.x = __builtin_amdgcn_rcpf(d.x); t.y = __builtin_amdgcn_rcpf(d.y);
    f32x2 q = t * 0.5307027145f + (-0.7265760135f); q = q * t + 0.7107068705f; q = q * t + (-0.142248368f); q = q * t + 0.127414796f; q = q * t;
    const f32x2 s = (v * v) * (-0.72134752044f);
    f32x2 e; e.x = __builtin_amdgcn_exp2f(s.x); e.y = __builtin_amdgcn_exp2f(s.y);
    const f32x2 m = v * (q * e), r = v - m;
    f32x2 o; o.x = v.x < 0.f ? m.x : r.x; o.y = v.y < 0.f ? m.y : r.y; return o;
}

struct EpiProj0 {
    static constexpr bool PERM = true, AFTER_DRAIN = false;
    bf16_t* O; const float* rope; float c2; unsigned* nrm; bf16_t* KT; bf16_t* VT; const float* rstd;
    __device__ __forceinline__ void operator()(const f32x4 (&acc)[2][2][4][2], const Unit& u, int wr, int wc, int fr, int fq) const {
        const int row0 = u.pm * BM + wr * 64 + fr, col0 = u.pn * BM + wc * 32 + 8 * fq, pn = u.pn;
        const bool do_rope = (pn >= 6 && pn <= 9);
        const float sc = (pn <= 1 || pn == 6 || pn == 7) ? c2 : 1.f;
        const int i0 = 16 * (wc & 1) + 4 * fq;
        if (pn < 4 || (pn >= 6 && pn <= 9)) {
            float mx[2] = {0.f, 0.f};
#pragma unroll
            for (int ai = 0; ai < 2; ++ai)
#pragma unroll
                for (int m = 0; m < 4; ++m) { const float scr = sc * rstd[row0 + ai * HALF + m * 16];
#pragma unroll
                    for (int bj = 0; bj < 2; ++bj) { const f32x4 a = acc[ai][bj][m][0] * scr, b = acc[ai][bj][m][1] * scr;
                        float ss = (a[0] * a[0] + a[1] * a[1]) + (a[2] * a[2] + a[3] * a[3]) + (b[0] * b[0] + b[1] * b[1]) + (b[2] * b[2] + b[3] * b[3]);
                        ss += __shfl_xor(ss, 16); ss += __shfl_xor(ss, 32); mx[bj] = fmaxf(mx[bj], ss); } }
#pragma unroll
            for (int bj = 0; bj < 2; ++bj) { float v = mx[bj];
#pragma unroll
                for (int o = 1; o < 16; o <<= 1) v = fmaxf(v, __shfl_xor(v, o));
                if (fr == 0 && fq == 0) { const int dif = pn >= 6 ? 1 : 0, isk = (dif ? pn - 6 : pn) >> 1, b = u.pm >> 6, head = (pn & 1) * 4 + 2 * bj + (wc >> 1), half = wc & 1;
                    __hip_atomic_fetch_max(nrm + dif * 64 + ((isk * 2 + b) * 8 + head) * 2 + half, __builtin_bit_cast(unsigned, v), __ATOMIC_RELAXED, __HIP_MEMORY_SCOPE_AGENT); } }
        }
#pragma unroll
        for (int ai = 0; ai < 2; ++ai)
#pragma unroll
            for (int m = 0; m < 4; ++m) { const int row = row0 + ai * HALF + m * 16; const float scr = sc * rstd[row];
                f32x4 cs0 = {1.f, 0.f, 1.f, 0.f}, cs1 = {1.f, 0.f, 1.f, 0.f};
                if (do_rope) { const f32x4* rp = (const f32x4*)(rope + (size_t)row * 64 + 2 * i0); cs0 = rp[0]; cs1 = rp[1]; }
                const f32x4 c = {cs0[0], cs0[2], cs1[0], cs1[2]}, s = {cs0[1], cs0[3], cs1[1], cs1[3]};
#pragma unroll
                for (int bj = 0; bj < 2; ++bj) { f32x4 v0 = acc[ai][bj][m][0], v1 = acc[ai][bj][m][1];
                    if (do_rope) { const f32x4 o0 = v0 * c - v1 * s, o1 = v0 * s + v1 * c; v0 = o0; v1 = o1; }
                    v0 = v0 * scr; v1 = v1 * scr; u32x4 w; w.x = cvt_pk_bf16(v0[0], v0[1]); w.y = cvt_pk_bf16(v0[2], v0[3]); w.z = cvt_pk_bf16(v1[0], v1[1]); w.w = cvt_pk_bf16(v1[2], v1[3]);
                    if (pn >= 8 && pn <= 11) { const int col = col0 + bj * HALF, b = row >> 14, tile = (row & 16383) >> 6, rin = row & 63;
                        if (pn <= 9) { const int cl = col - 2048, grp = cl >> 6, chunk = (cl & 63) >> 3; *(u32x4*)(KT + ((size_t)((b * 8 + grp) * 256 + tile) * 4096 + chunk * 512 + rin * 8)) = w; }
                        else { const int cl = col - 2560, hd = cl >> 7, dblk = (cl & 127) >> 5, cw = cl & 31; *(u32x4*)(VT + ((size_t)((b * 4 + hd) * 256 + tile) * 8192 + dblk * 2048 + rin * 32 + cw)) = w; } }
                    else *(u32x4*)(O + (size_t)row * 4096 + col0 + bj * HALF) = w; } }
    }
};
typedef _Float16 h2e __attribute__((ext_vector_type(2)));
__device__ __forceinline__ float hf_lo(unsigned w) { return (float)__builtin_bit_cast(h2e, w)[0]; }
__device__ __forceinline__ float hf_hi(unsigned w) { return (float)__builtin_bit_cast(h2e, w)[1]; }
__device__ __forceinline__ unsigned cvt_pk_f16(float lo, float hi) { const f32x2 v = {lo, hi}; return __builtin_bit_cast(unsigned, __builtin_convertvector(v, h2e)); }
struct EpiProj1 {
    static constexpr bool PERM = true, AFTER_DRAIN = false;
    bf16_t* O; const float* rstd;
    __device__ __forceinline__ void operator()(const f32x4 (&acc)[2][2][4][2], const Unit& u, int wr, int wc, int fr, int fq) const {
        const int row0 = u.pm * BM + wr * 64 + fr, col0 = u.pn * BM + wc * 32 + 8 * fq, pn = u.pn;
        const float sc0 = (pn == 2 || pn == 3) ? 0.125f : 1.f;
#pragma unroll
        for (int ai = 0; ai < 2; ++ai)
#pragma unroll
            for (int m = 0; m < 4; ++m) { const int row = row0 + ai * HALF + m * 16; const float sc = sc0 * rstd[row];
                const int b = row >> 14, chunk = (row & 16383) >> 7, rin = row & 127;
#pragma unroll
                for (int bj = 0; bj < 2; ++bj) { const f32x4 v0 = acc[ai][bj][m][0] * sc, v1 = acc[ai][bj][m][1] * sc; const int col = col0 + bj * HALF;
                    if (pn < 8) { u32x4 w; w.x = cvt_pk_f16(v0[0], v0[1]); w.y = cvt_pk_f16(v0[2], v0[3]); w.z = cvt_pk_f16(v1[0], v1[1]); w.w = cvt_pk_f16(v1[2], v1[3]);
                        if (pn < 4) { const int cl = col & 511, head = cl >> 6, d = cl & 63; *(u32x4*)(O + (size_t)(pn >> 1) * 16777216 + ((size_t)((b * 8 + head) * 128 + chunk) * 128 + rin) * 64 + d) = w; }
                        else { const int cl = col - 1024, head = cl >> 7, ev = cl & 127; *(u32x4*)(O + (size_t)33554432 + ((size_t)((b * 8 + head) * 128 + chunk) * 128 + rin) * 128 + ev) = w; } }
                    else {
                        const float g0 = v0[1] / ((1.f + __expf(-v0[0])) * (1.f + __expf(-v0[1]))), g1 = v0[3] / ((1.f + __expf(-v0[2])) * (1.f + __expf(-v0[3])));
                        const float g2 = v1[1] / ((1.f + __expf(-v1[0])) * (1.f + __expf(-v1[1]))), g3 = v1[3] / ((1.f + __expf(-v1[2])) * (1.f + __expf(-v1[3])));
                        typedef unsigned u32x2e __attribute__((ext_vector_type(2))); u32x2e gw; gw.x = cvt_pk_bf16(g0, g1); gw.y = cvt_pk_bf16(g2, g3);
                        const int jg = (col - 2048) >> 1, head = jg >> 7, ev = jg & 127;
                        *(u32x2e*)(O + (size_t)67108864 + ((size_t)((b * 8 + head) * 128 + chunk) * 128 + rin) * 128 + ev) = gw; } } }
    }
};
struct EpiResidF2B {
    static constexpr bool PERM = true, AFTER_DRAIN = false;
    const float* base; bf16_t* out;
    __device__ __forceinline__ void operator()(const f32x4 (&acc)[2][2][4][2], const Unit& u, int wr, int wc, int fr, int fq) const {
        const int row0 = u.pm * BM + wr * 64 + fr, col0 = u.pn * BM + wc * 32 + 8 * fq;
#pragma unroll
        for (int ai = 0; ai < 2; ++ai)
#pragma unroll
            for (int m = 0; m < 4; ++m) { const size_t p = (size_t)(row0 + ai * HALF + m * 16) * 1024 + col0;
#pragma unroll
                for (int bj = 0; bj < 2; ++bj) { const f32x4 v0 = *(const f32x4*)(base + p + bj * HALF) + acc[ai][bj][m][0], v1 = *(const f32x4*)(base + p + bj * HALF + 4) + acc[ai][bj][m][1];
                    u32x4 w; w.x = cvt_pk_f16(v0[0], v0[1]); w.y = cvt_pk_f16(v0[2], v0[3]); w.z = cvt_pk_f16(v1[0], v1[1]); w.w = cvt_pk_f16(v1[2], v1[3]);
                    *(u32x4*)(out + p + bj * HALF) = w; } }
    }
};
struct EpiResidB2B {
    static constexpr bool PERM = true, AFTER_DRAIN = false;
    const bf16_t* base; bf16_t* out;
    __device__ __forceinline__ void operator()(const f32x4 (&acc)[2][2][4][2], const Unit& u, int wr, int wc, int fr, int fq) const {
        const int row0 = u.pm * BM + wr * 64 + fr, col0 = u.pn * BM + wc * 32 + 8 * fq;
#pragma unroll
        for (int ai = 0; ai < 2; ++ai)
#pragma unroll
            for (int m = 0; m < 4; ++m) { const size_t p = (size_t)(row0 + ai * HALF + m * 16) * 1024 + col0;
#pragma unroll
                for (int bj = 0; bj < 2; ++bj) { const u32x4 b = *(const u32x4*)(base + p + bj * HALF);
                    const f32x4 b0 = {hf_lo(b.x), hf_hi(b.x), hf_lo(b.y), hf_hi(b.y)}, b1 = {hf_lo(b.z), hf_hi(b.z), hf_lo(b.w), hf_hi(b.w)};
                    const f32x4 v0 = b0 + acc[ai][bj][m][0], v1 = b1 + acc[ai][bj][m][1];
                    u32x4 w; w.x = cvt_pk_f16(v0[0], v0[1]); w.y = cvt_pk_f16(v0[2], v0[3]); w.z = cvt_pk_f16(v1[0], v1[1]); w.w = cvt_pk_f16(v1[2], v1[3]);
                    *(u32x4*)(out + p + bj * HALF) = w; } }
    }
};

typedef _Float16 h8g __attribute__((ext_vector_type(8)));
template <class Epi, class Sched, bool ALIGN_EPI = false, bool SP2 = false, bool F16 = false>
__device__ __forceinline__ void gemm_phase(PG8_LAS unsigned char* lds, const Gemm g, const Sched& S, const Epi& E) {
    const int tid = threadIdx.x, wid = __builtin_amdgcn_readfirstlane(tid >> 6), lane = tid & 63, wr = wid >> 2, wc = wid & 3, fr = lane & 15, fq = lane >> 4;
    const int K = g.K, nt = K / BK;
    unsigned voffA[2], voffB[2];
#pragma unroll
    for (int i = 0; i < 2; ++i) { int R, C; stage_rc(tid * 16 + i * 8192, R, C); const int Rb = Epi::PERM ? ((R & ~31) + perm32(R & 31)) : R;
        voffA[i] = (unsigned)(R * K + C) * 2u; voffB[i] = (unsigned)(Rb * K + C) * 2u; }
    const size_t kstep = (size_t)(BK * 2);
    const size_t hstep = (size_t)HALF * K * 2;
    const size_t tstep = 2 * hstep;
    const unsigned ldsw = (unsigned)wid * 1024u;
    const int aoff = lds_byte(wr * 64 + fr, fq * 8), boff = lds_byte(wc * 32 + fr, fq * 8);
#define PG8_SA(b, h) (((b) * 2 + (h)) * HTB)
#define PG8_SB(b, h) ((4 + (b) * 2 + (h)) * HTB)
#define PG8_STAGE(bufoff, gbase, voff) do { _Pragma("unroll") for (int _i = 0; _i < 2; ++_i) \
        __builtin_amdgcn_global_load_lds((const unsigned*)((const char*)(gbase) + (voff)[_i]), (PG8_LAS unsigned*)(lds + (bufoff) + ldsw + _i * 8192), 16, 0, 0); } while (0)
#define PG8_LDA(dst, b, h) do { _Pragma("unroll") for (int m = 0; m < 4; ++m) _Pragma("unroll") for (int k = 0; k < 2; ++k) dst[m][k] = *(const PG8_LAS bf16x8*)(lds + PG8_SA(b, h) + aoff + m * 2048 + k * 1024); } while (0)
#define PG8_LDB(dst, b, h) do { _Pragma("unroll") for (int n = 0; n < 2; ++n) _Pragma("unroll") for (int k = 0; k < 2; ++k) dst[n][k] = *(const PG8_LAS bf16x8*)(lds + PG8_SB(b, h) + boff + n * 2048 + k * 1024); } while (0)
#define PG8_MMA(ai, bj, At, Bt) do { __builtin_amdgcn_s_setprio(1); _Pragma("unroll") for (int m = 0; m < 4; ++m) _Pragma("unroll") for (int n = 0; n < 2; ++n) _Pragma("unroll") for (int k = 0; k < 2; ++k) \
        acc[ai][bj][m][n] = F16 ? __builtin_amdgcn_mfma_f32_16x16x32_f16(__builtin_bit_cast(h8g, Bt[n][k]), __builtin_bit_cast(h8g, At[m][k]), acc[ai][bj][m][n], 0, 0, 0) : __builtin_amdgcn_mfma_f32_16x16x32_bf16(Bt[n][k], At[m][k], acc[ai][bj][m][n], 0, 0, 0); __builtin_amdgcn_s_setprio(0); } while (0)
#define PG8_WAIT_V(n) asm volatile("s_waitcnt vmcnt(" #n ")" ::: "memory")
#define PG8_WAIT_L(n) asm volatile("s_waitcnt lgkmcnt(" #n ")" ::: "memory")
#define PG8_BAR __builtin_amdgcn_s_barrier()
#define PG8_SCHED __builtin_amdgcn_sched_barrier(0)
    Unit cur, nxt; int ui = 0;
    if (!S.next(0, cur)) return;
    f32x4 acc[2][2][4][2];
#pragma unroll
    for (int a = 0; a < 2; ++a)
#pragma unroll
        for (int b = 0; b < 2; ++b)
#pragma unroll
            for (int m = 0; m < 4; ++m)
#pragma unroll
                for (int n = 0; n < 2; ++n) acc[a][b][m][n] = (f32x4){0.f, 0.f, 0.f, 0.f};
    bf16x8 At[4][2], B0[2][2], B1[2][2];
    const char* cA = (const char*)g.A + (size_t)cur.pm * tstep; const char* cB = (const char*)g.Bt + (size_t)cur.pn * tstep;
    S.a_ready(cur);
    if constexpr (SP2) {
        PG8_STAGE(PG8_SB(0, 0), cB, voffB); PG8_STAGE(PG8_SB(0, 1), cB + hstep, voffB); PG8_STAGE(PG8_SA(0, 0), cA, voffA); PG8_STAGE(PG8_SA(0, 1), cA + hstep, voffA);
        if (wr == 1) PG8_BAR;
        PG8_WAIT_V(2); PG8_BAR;
        PG8_STAGE(PG8_SB(1, 0), cB + kstep, voffB); PG8_STAGE(PG8_SA(1, 0), cA + kstep, voffA); PG8_STAGE(PG8_SB(1, 1), cB + hstep + kstep, voffB);
        PG8_WAIT_V(6); PG8_BAR;
    } else {
        PG8_STAGE(PG8_SB(0, 0), cB, voffB); PG8_STAGE(PG8_SA(0, 0), cA, voffA); PG8_STAGE(PG8_SB(0, 1), cB + hstep, voffB); PG8_STAGE(PG8_SA(0, 1), cA + hstep, voffA);
        if (wr == 1) PG8_BAR;
        PG8_WAIT_V(4); PG8_BAR;
        PG8_STAGE(PG8_SB(1, 0), cB + kstep, voffB); PG8_STAGE(PG8_SA(1, 0), cA + kstep, voffA); PG8_STAGE(PG8_SB(1, 1), cB + hstep + kstep, voffB);
        PG8_WAIT_V(6); PG8_BAR;
    }
    for (;;) {
        const bool has_next = S.next(ui + 1, nxt);
        const char* nA = has_next ? (const char*)g.A + (size_t)nxt.pm * tstep : cA; const char* nB = has_next ? (const char*)g.Bt + (size_t)nxt.pn * tstep : cB;
        for (int t = 0; t < nt; t += 2) {
            const bool last = (t == nt - 2);
            const char* a1 = cA + (size_t)(t + 1) * kstep;
            const char* a2 = last ? nA : cA + (size_t)(t + 2) * kstep; const char* b2 = last ? nB : cB + (size_t)(t + 2) * kstep;
            const char* a3 = a2 + kstep; const char* b3 = b2 + kstep;
            if (last && has_next) S.a_ready(nxt);
            if constexpr (SP2) {
            PG8_LDB(B0, 0, 0); PG8_LDB(B1, 0, 1); PG8_SCHED; PG8_LDA(At, 0, 0); PG8_STAGE(PG8_SA(1, 1), a1 + hstep, voffA);
            PG8_WAIT_V(8); PG8_WAIT_L(0); PG8_BAR; PG8_MMA(0, 0, At, B0); PG8_MMA(0, 1, At, B1); PG8_BAR; PG8_SCHED;
            PG8_LDA(At, 0, 1); PG8_STAGE(PG8_SB(0, 0), b2, voffB); PG8_STAGE(PG8_SB(0, 1), b2 + hstep, voffB); PG8_STAGE(PG8_SA(0, 0), a2, voffA);
            PG8_WAIT_V(8); PG8_WAIT_L(0); PG8_BAR; PG8_MMA(1, 0, At, B0); PG8_MMA(1, 1, At, B1); PG8_BAR; PG8_SCHED;
            PG8_LDB(B0, 1, 0); PG8_LDB(B1, 1, 1); PG8_SCHED; PG8_LDA(At, 1, 0); PG8_STAGE(PG8_SA(0, 1), a2 + hstep, voffA);
            PG8_WAIT_V(8); PG8_WAIT_L(0); PG8_BAR; PG8_MMA(0, 0, At, B0); PG8_MMA(0, 1, At, B1); PG8_BAR; PG8_SCHED;
            PG8_LDA(At, 1, 1); PG8_STAGE(PG8_SB(1, 0), b3, voffB); PG8_STAGE(PG8_SB(1, 1), b3 + hstep, voffB); PG8_STAGE(PG8_SA(1, 0), a3, voffA);
            PG8_WAIT_V(8); PG8_WAIT_L(0); PG8_BAR; PG8_MMA(1, 0, At, B0); PG8_MMA(1, 1, At, B1); PG8_BAR; PG8_SCHED;
            } else {
            PG8_LDB(B0, 0, 0); PG8_SCHED; PG8_LDA(At, 0, 0); PG8_STAGE(PG8_SA(1, 1), a1 + hstep, voffA);
            PG8_WAIT_L(8); PG8_BAR; PG8_WAIT_L(0); PG8_MMA(0, 0, At, B0); PG8_BAR; PG8_SCHED;
            PG8_LDB(B1, 0, 1); PG8_STAGE(PG8_SB(0, 0), b2, voffB);
            PG8_BAR; PG8_WAIT_L(0); PG8_MMA(0, 1, At, B1); PG8_BAR;
            PG8_LDA(At, 0, 1); PG8_STAGE(PG8_SA(0, 0), a2, voffA);
            PG8_BAR; PG8_WAIT_L(0); PG8_MMA(1, 0, At, B0); PG8_BAR; PG8_SCHED;
            PG8_STAGE(PG8_SB(0, 1), b2 + hstep, voffB);
            PG8_WAIT_V(6); PG8_BAR; PG8_MMA(1, 1, At, B1); PG8_BAR;
            PG8_LDB(B0, 1, 0); PG8_SCHED; PG8_LDA(At, 1, 0); PG8_STAGE(PG8_SA(0, 1), a2 + hstep, voffA);
            PG8_WAIT_L(8); PG8_BAR; PG8_WAIT_L(0); PG8_MMA(0, 0, At, B0); PG8_BAR; PG8_SCHED;
            PG8_LDB(B1, 1, 1); PG8_STAGE(PG8_SB(1, 0), b3, voffB);
            PG8_BAR; PG8_WAIT_L(0); PG8_MMA(0, 1, At, B1); PG8_BAR;
            PG8_LDA(At, 1, 1); PG8_STAGE(PG8_SA(1, 0), a3, voffA);
            PG8_BAR; PG8_WAIT_L(0); PG8_MMA(1, 0, At, B0); PG8_BAR; PG8_SCHED;
            PG8_STAGE(PG8_SB(1, 1), b3 + hstep, voffB);
            PG8_WAIT_V(6); PG8_BAR; PG8_MMA(1, 1, At, B1); PG8_BAR;
            }
        }
        if constexpr (ALIGN_EPI) { if (wr == 0) PG8_BAR; }
        if constexpr (!Epi::AFTER_DRAIN) { E(acc, cur, wr, wc, fr, fq); S.done(cur); }
        if (!has_next) break;
#pragma unroll
        for (int a = 0; a < 2; ++a)
#pragma unroll
            for (int b = 0; b < 2; ++b)
#pragma unroll
                for (int m = 0; m < 4; ++m)
#pragma unroll
                    for (int n = 0; n < 2; ++n) acc[a][b][m][n] = (f32x4){0.f, 0.f, 0.f, 0.f};
        cur = nxt; cA = nA; cB = nB; ++ui;
        if constexpr (ALIGN_EPI) { if (wr == 1) PG8_BAR; }
    }
    PG8_WAIT_V(0);
    if constexpr (!ALIGN_EPI) { if (wr == 0) PG8_BAR; }
    PG8_BAR;
    if constexpr (Epi::AFTER_DRAIN) { E.fused(acc, cur, wr, wc, fr, fq, lds, wid, lane); S.done(cur); }
#undef PG8_SA
#undef PG8_SB
#undef PG8_STAGE
#undef PG8_LDA
#undef PG8_LDB
#undef PG8_MMA
#undef PG8_WAIT_V
#undef PG8_WAIT_L
#undef PG8_BAR
#undef PG8_SCHED
}
}
#include <hip/hip_bf16.h>
#include <cmath>
namespace attn_body {
using bf16=__hip_bfloat16;
using bf16x8=__attribute__((ext_vector_type(8)))short;
using s16x4=__attribute__((ext_vector_type(4)))short;
using f32x16=__attribute__((ext_vector_type(16)))float;
using u32x4=__attribute__((ext_vector_type(4)))unsigned;
constexpr int SEQ=16384,D=64,DM=4096,OPITCH=1536;
constexpr int NW=8,QBLK=32,QB=QBLK*NW,KVBLK=64,NQB=SEQ/QB;
#define LAS3 __attribute__((address_space(3)))
__device__ __forceinline__ int crow(int r,int hi){return (r&3)+8*(r>>2)+4*hi;}
#define SBAR() __builtin_amdgcn_sched_barrier(0)
__device__ __forceinline__ void cmask(f32x16&p0,f32x16&p1,int jb,int qrel,int hi){
  const float NEG=-INFINITY; int kb=64*jb+4*hi;
  #pragma unroll
  for(int r=0;r<16;++r){int kv=kb+(r&3)+8*(r>>2); if(kv>qrel)p0[r]=NEG; if(kv+32>qrel)p1[r]=NEG;}
}

constexpr int NSLOT=3, SLOTB=8192;
constexpr int LDS_K=0, LDS_V=NSLOT*SLOTB, LDS_WS=2*NSLOT*SLOTB, LDS_OST=LDS_WS+NW*64*4, LDS_KE=LDS_OST+NW*4096, LDS_BYTES=LDS_KE+4*1024;
constexpr float C2=0.125f*1.4426950408889634f;
__device__ __forceinline__ void glds16(const void*gsrc,unsigned lds_dst){unsigned keep;
  asm volatile("s_mov_b32 %0, m0\n\ts_mov_b32 m0, %2\n\ts_nop 0\n\tglobal_load_lds_dwordx4 %1, off\n\ts_mov_b32 m0, %0":"=&s"(keep):"v"(gsrc),"s"(lds_dst):"memory");}
__device__ __forceinline__ float max3f(float a,float b,float c){float r;asm("v_max3_f32 %0, %1, %2, %3":"=v"(r):"v"(a),"v"(b),"v"(c));return r;}
__device__ __forceinline__ float max2f(float a,float b){float r;asm("v_max_f32_e32 %0, %1, %2":"=v"(r):"v"(a),"v"(b));return r;}
__device__ __forceinline__ float fadd_s(float a,float b){float r;asm("v_add_f32_e32 %0, %1, %2":"=v"(r):"v"(a),"v"(b));return r;}
__device__ __forceinline__ float fsub_s(float a,float b){float r;asm("v_sub_f32_e32 %0, %1, %2":"=v"(r):"v"(a),"v"(b));return r;}
typedef float f32x2_t __attribute__((ext_vector_type(2))); typedef __bf16 bf16x2_t __attribute__((ext_vector_type(2)));
__device__ __forceinline__ unsigned cvtpk_s(float lo,float hi){f32x2_t v={lo,hi};bf16x2_t b=__builtin_convertvector(v,bf16x2_t);return __builtin_bit_cast(unsigned,b);}
#define WAIT_BAR(N) asm volatile("s_waitcnt vmcnt(" #N ") lgkmcnt(0)\n\ts_barrier":::"memory")

__device__ __forceinline__ void qkt(f32x16&p0,f32x16&p1,const char*Kslot,const bf16x8*qr,const f32x16&negm,int r32,int hi){
  const char*kb=Kslot+hi*1024+r32*16;
  #pragma unroll
  for(int d0=0;d0<4;++d0){
    const bf16x8 b0=*reinterpret_cast<const bf16x8*>(kb+d0*2048);
    const bf16x8 b1=*reinterpret_cast<const bf16x8*>(kb+d0*2048+512);
    if(d0==0){p0=__builtin_amdgcn_mfma_f32_32x32x16_bf16(b0,qr[0],negm,0,0,0);p1=__builtin_amdgcn_mfma_f32_32x32x16_bf16(b1,qr[0],negm,0,0,0);}
    else{p0=__builtin_amdgcn_mfma_f32_32x32x16_bf16(b0,qr[d0],p0,0,0,0);p1=__builtin_amdgcn_mfma_f32_32x32x16_bf16(b1,qr[d0],p1,0,0,0);}}
}
typedef __attribute__((address_space(3))) const char* lds_cptr;
typedef short v4i16_t __attribute__((ext_vector_type(4)));
__device__ __forceinline__ void kload8(bf16x8*kf,lds_cptr kp){
  kf[0]=*(const __attribute__((address_space(3))) bf16x8*)(kp);      kf[1]=*(const __attribute__((address_space(3))) bf16x8*)(kp+512);
  kf[2]=*(const __attribute__((address_space(3))) bf16x8*)(kp+2048); kf[3]=*(const __attribute__((address_space(3))) bf16x8*)(kp+2560);
  kf[4]=*(const __attribute__((address_space(3))) bf16x8*)(kp+4096); kf[5]=*(const __attribute__((address_space(3))) bf16x8*)(kp+4608);
  kf[6]=*(const __attribute__((address_space(3))) bf16x8*)(kp+6144); kf[7]=*(const __attribute__((address_space(3))) bf16x8*)(kp+6656);
}
__device__ __forceinline__ void kload2(bf16x8*kf,lds_cptr kp,int j){ kf[2*j]=*(const __attribute__((address_space(3))) bf16x8*)(kp+j*2048); kf[2*j+1]=*(const __attribute__((address_space(3))) bf16x8*)(kp+j*2048+512); }
__device__ __forceinline__ s16x4 vtr(lds_cptr p){ return __builtin_bit_cast(s16x4,__builtin_amdgcn_ds_read_tr16_b64_v4i16((__attribute__((address_space(3))) v4i16_t*)p)); }
__device__ __forceinline__ float rowmax(const f32x16&p0,const f32x16&p1){
  float a=max3f(p0[0],p0[1],p1[0]),b=max3f(p0[2],p0[3],p1[1]);a=max3f(a,p1[2],p1[3]);
  #pragma unroll
  for(int r=4;r<16;r+=4){a=max3f(a,p0[r],p0[r+1]);b=max3f(b,p0[r+2],p0[r+3]);a=max3f(a,p1[r],p1[r+1]);b=max3f(b,p1[r+2],p1[r+3]);}
  const float m=max2f(a,b);
  auto rr=__builtin_amdgcn_permlane32_swap(__float_as_uint(m),__float_as_uint(m),false,false);
  return max2f(__uint_as_float(rr[0]),__uint_as_float(rr[1]));
}
__device__ __forceinline__ void pv(f32x16*o,int vb,bf16x8 pa0,bf16x8 pa1,bf16x8 pa2,bf16x8 pa3){
  #pragma unroll
  for(int d0=0;d0<2;++d0){s16x4 lo[4],hi[4];
    #pragma unroll
    for(int ks=0;ks<4;++ks){
      asm volatile("ds_read_b64_tr_b16 %0,%1 offset:%c2":"=&v"(lo[ks]):"v"(vb),"i"(d0*4096+ks*1024):"memory");
      asm volatile("ds_read_b64_tr_b16 %0,%1 offset:%c2":"=&v"(hi[ks]):"v"(vb),"i"(d0*4096+ks*1024+512):"memory");}
    asm volatile("s_waitcnt lgkmcnt(0)":::"memory");SBAR();
    #define PK(k) (bf16x8){lo[k][0],lo[k][1],lo[k][2],lo[k][3],hi[k][0],hi[k][1],hi[k][2],hi[k][3]}
    o[d0]=__builtin_amdgcn_mfma_f32_32x32x16_bf16(pa0,PK(0),o[d0],0,0,0);
    o[d0]=__builtin_amdgcn_mfma_f32_32x32x16_bf16(pa1,PK(1),o[d0],0,0,0);
    o[d0]=__builtin_amdgcn_mfma_f32_32x32x16_bf16(pa2,PK(2),o[d0],0,0,0);
    o[d0]=__builtin_amdgcn_mfma_f32_32x32x16_bf16(pa3,PK(3),o[d0],0,0,0);
    #undef PK
  }
}

__device__ __forceinline__ unsigned bf_rne(float f){ unsigned u=__float_as_uint(f); return (u+0x7fffu+((u>>16)&1u))>>16; }
__device__ __forceinline__ bf16x8 make_qre(float a,int hi){
  const unsigned h0=bf_rne(a); const float r1=a-__uint_as_float(h0<<16); const unsigned h1=bf_rne(r1); const float r2=r1-__uint_as_float(h1<<16); const unsigned h2=bf_rne(r2);
  u32x4 w; w.x=hi?0u:(h0|(h1<<16)); w.y=hi?0u:(h2|(0x3F80u<<16)); w.z=hi?0u:(0x3F80u|(0x3F80u<<16)); w.w=0u; return __builtin_bit_cast(bf16x8,w); }
constexpr int ATTN_LDS_BYTES=LDS_BYTES;
#undef SBAR
#undef WAIT_BAR
}
namespace attn256 {
using attn_body::bf16; using attn_body::bf16x8; using attn_body::s16x4; using attn_body::f32x16; using attn_body::u32x4; using attn_body::lds_cptr;
using attn_body::glds16; using attn_body::fadd_s; using attn_body::fsub_s; using attn_body::cvtpk_s; using attn_body::vtr; using attn_body::crow; using attn_body::max3f; using attn_body::max2f;
constexpr int SEQ=16384,DM=4096,OPITCH=512,QBU=256,KVBLK=64;
constexpr int KSLOT=8192,VSLOT=16384;
constexpr int LDS_K=0,LDS_V=4*KSLOT,LDS_WS=LDS_V+4*VSLOT,LDS_KE=LDS_WS+2048,LDS_BYTES=LDS_KE+4096;
#define SBAR() __builtin_amdgcn_sched_barrier(0)
#define WAIT_BAR(N) asm volatile("s_waitcnt vmcnt(" #N ") lgkmcnt(0)\n\ts_barrier":::"memory")
#define LAS3 __attribute__((address_space(3)))
__device__ __forceinline__ void wait_bar_n(int n){ if(n<=0){WAIT_BAR(0);} else if(n==1){WAIT_BAR(1);} else if(n==2){WAIT_BAR(2);} else if(n==3){WAIT_BAR(3);} else {WAIT_BAR(4);} }
template<int THRL,int DVB,bool FOX,bool NOMAX> __device__ __forceinline__ void unit(int MODE,int qb,int t0,const bf16*Qb,const bf16*__restrict__ Kb,const bf16*__restrict__ Vb,bf16*Ob,const bf16*__restrict__ Zb,bf16*Yb,const float*__restrict__ subg,float lam,const float*__restrict__ F2b,const bf16*__restrict__ KEb,char*shm){
  constexpr int NV=DVB/2;
  const int tid=threadIdx.x,lane=tid&63,r32=lane&31,hi=lane>>5; const int wid=__builtin_amdgcn_readfirstlane(tid>>6);
  const int q0=qb*QBU;
  const bf16*Qw=Qb+(long)(q0+wid*32)*DM;
  const unsigned lds0=(unsigned)(uintptr_t)shm;
  float*wsf=(float*)(shm+LDS_WS)+wid*64;
  constexpr bool TILED=(DVB==4)&&!FOX; constexpr long KSTR=TILED?4096:(long)KVBLK*DM, VSTR=TILED?8192:(long)KVBLK*DM, V2=TILED?4096:64;
  const bf16*ksrc=TILED?Kb+(long)t0*KSTR+wid*512+lane*8:Kb+((long)t0*KVBLK+lane)*DM+wid*8;
  const bf16*vsrc=TILED?Vb+(long)t0*VSTR+(wid>>2)*2048+(wid&3)*512+lane*8:Vb+((long)t0*KVBLK+16*(wid&3)+(lane>>2))*DM+(wid>>2)*32+(lane&3)*8;
  const bf16*kesrc=KEb+((long)t0*KVBLK+lane)*8; const unsigned kedst=lds0+LDS_KE; const int xw=(FOX&&wid==0)?1:0;
  const unsigned kdst=lds0+LDS_K+wid*1024, vdst=lds0+LDS_V+(wid>>2)*4096+(wid&3)*1024;
  #define KOFF(t) ((((unsigned)(t))&3u)<<13)
  #define VOFF(t) ((((unsigned)(t))&3u)<<(DVB==4?14:13))
  #define DMA_K(t) glds16(ksrc+(long)(t)*KSTR,(unsigned)__builtin_amdgcn_readfirstlane(kdst+KOFF(t)))
  #define DMA_V(t) do{ glds16(vsrc+(long)(t)*VSTR,(unsigned)__builtin_amdgcn_readfirstlane(vdst+VOFF(t))); if(DVB==4){glds16(vsrc+(long)(t)*VSTR+V2,(unsigned)__builtin_amdgcn_readfirstlane(vdst+VOFF(t)+8192));} }while(0)
  #define DMA_KE(t) do{ if(FOX&&wid==0) glds16(kesrc+(long)(t)*KVBLK*8,(unsigned)__builtin_amdgcn_readfirstlane(kedst+((((unsigned)(t))&3u)<<10))); }while(0)
  const lds_cptr shm3=(lds_cptr)shm;
  const lds_cptr kp0=shm3+LDS_K+hi*1024+r32*16;
  const lds_cptr vp0=shm3+LDS_V+((lane>>4)&1)*32+(lane&3)*8+(4*hi+((lane&15)>>2))*64;
  const lds_cptr kep0=shm3+LDS_KE+r32*16;
  const int NT=(q0+QBU)/KVBLK-t0;
  DMA_KE(0);DMA_KE(1);DMA_KE(2);
  DMA_K(0);DMA_V(0);DMA_K(1);DMA_K(2);DMA_V(1);
  bf16x8 qr[4];
  #pragma unroll
  for(int d0=0;d0<4;++d0)qr[d0]=*reinterpret_cast<const bf16x8*>(&Qw[(long)r32*DM+d0*16+hi*8]);
  float mhat=0.f,l_reg=0.f;f32x16 o[DVB];
  #pragma unroll
  for(int d_=0;d_<DVB;++d_)o[d_]=f32x16{};
  f32x16 negm=f32x16{}; if(!FOX&&!NOMAX){asm volatile("":"+v"(negm));}
  bf16x8 qre=bf16x8{},kef=bf16x8{}; float fq2=0.f;
  if(FOX){ fq2=F2b[q0+wid*32+r32]; qre=attn_body::make_qre(fq2,hi); }
  #define SETREF() do{ if(FOX){ qre=attn_body::make_qre(fq2-mhat,hi); } else { _Pragma("unroll") for(int r=0;r<16;++r)negm[r]=-mhat; asm volatile("":"+v"(negm)); } }while(0)
  const int qrel=wid*32+r32;
  #define CMASK(Px,t,h) do{int jb_=(t)-(NT-4); if(jb_>=0){ const int kb_=64*jb_+32*(h)+4*hi; _Pragma("unroll") for(int r=0;r<16;++r){ if(kb_+(r&3)+8*(r>>2)>qrel)Px[r]=-INFINITY; } } }while(0)
  bool resc=false;
  #define RESC() do{ if(resc){ asm volatile("s_waitcnt lgkmcnt(0)":::"memory"); \
      _Pragma("unroll") for(int d_=0;d_<DVB;++d_) _Pragma("unroll") for(int r=0;r<16;++r)o[d_][r]*=wsf[crow(r,hi)]; } }while(0)
  f32x16 pA,pB; bf16x8 kf[4];
  constexpr bool RESP=false;
  constexpr bool LMFMA=false; f32x16 ol=f32x16{}; const bf16x8 ones=(bf16x8){0x3F80,0x3F80,0x3F80,0x3F80,0x3F80,0x3F80,0x3F80,0x3F80};
  WAIT_BAR(0);
  if(3<NT){DMA_K(3);DMA_KE(3);}
  DMA_V(2);
  { const char*kb=shm+LDS_K+hi*1024+r32*16;
    if(FOX){ kef=*(const LAS3 bf16x8*)(kep0); pA=__builtin_amdgcn_mfma_f32_32x32x16_bf16(kef,qre,f32x16{},0,0,0); pA=__builtin_amdgcn_mfma_f32_32x32x16_bf16(*reinterpret_cast<const bf16x8*>(kb),qr[0],pA,0,0,0); }
    else pA=__builtin_amdgcn_mfma_f32_32x32x16_bf16(*reinterpret_cast<const bf16x8*>(kb),qr[0],(NOMAX?f32x16{}:negm),0,0,0);
    #pragma unroll
    for(int d0=1;d0<4;++d0)pA=__builtin_amdgcn_mfma_f32_32x32x16_bf16(*reinterpret_cast<const bf16x8*>(kb+d0*2048),qr[d0],pA,0,0,0); }
  #pragma unroll
  for(int d0=0;d0<4;++d0)kf[d0]=*(const LAS3 bf16x8*)(kp0+d0*2048+512);
  if(FOX)kef=*(const LAS3 bf16x8*)(kep0+512);
  asm volatile("s_nop 15\n\ts_nop 7":"+v"(pA));CMASK(pA,0,0);
  { if constexpr(!NOMAX){ float a=max3f(pA[0],pA[1],pA[2]),b=max3f(pA[3],pA[4],pA[5]);a=max3f(a,pA[6],pA[7]);b=max3f(b,pA[8],pA[9]);a=max3f(a,pA[10],pA[11]);b=max3f(b,pA[12],pA[13]);a=max3f(a,pA[14],pA[15]);
    float rm=max2f(a,b); auto rr=__builtin_amdgcn_permlane32_swap(__float_as_uint(rm),__float_as_uint(rm),false,false); rm=max2f(__uint_as_float(rr[0]),__uint_as_float(rr[1]));
    mhat=fadd_s(mhat,rm);
    #pragma unroll
    for(int r=0;r<16;++r)pA[r]=fsub_s(pA[r],rm);
    SETREF(); }
    #pragma unroll
    for(int r=0;r<16;++r)pA[r]=__builtin_amdgcn_exp2f(pA[r]); }
  s16x4 vlo[2*DVB],vhi[2*DVB]; u32x4 pw0,pw1;
  #define PKW(P,B) cvtpk_s(P[B],P[B+1])
  #define PAF(k) __builtin_bit_cast(bf16x8,pw##k)
  #define VFR(i) (bf16x8){vlo[i][0],vlo[i][1],vlo[i][2],vlo[i][3],vhi[i][0],vhi[i][1],vhi[i][2],vhi[i][3]}
  #define PIN(x) asm volatile("":"+v"(x))
  #define MX3(a,b,c) __builtin_fmaxf(__builtin_fmaxf((a),(b)),(c))
  #define GAPA(MF,A0,A1,A2,A3,W0,W1,PW) do{ MF; if constexpr(!LMFMA){ sacc+=A0; sacc+=A1; sacc+=A2; sacc+=A3; PIN(sacc); } W0; W1; PIN(PW); SBAR(); }while(0)
  #define EX(v) __builtin_amdgcn_exp2f(v)
  #define GAPB(MF,X,B) do{ MF; X[B]=EX(X[B]); X[B+1]=EX(X[B+1]); PIN(X); SBAR(); }while(0)
  #define GAPB3(MF,X,B) do{ MF; X[B]=EX(X[B]); X[B+1]=EX(X[B+1]); X[B+2]=EX(X[B+2]); PIN(X); SBAR(); }while(0)
  #define GAPA0(MF) do{ MF; SBAR(); }while(0)
  #define GAPB4(MF,X,B) do{ MF; X[B]=EX(X[B]); X[B+1]=EX(X[B+1]); X[B+2]=EX(X[B+2]); X[B+3]=EX(X[B+3]); PIN(X); SBAR(); }while(0)
  #define VRD(i) do{ vlo[i]=vtr(vp_+(((i)%DVB)*4096+((i)/DVB)*1024)); vhi[i]=vtr(vp_+(((i)%DVB)*4096+((i)/DVB)*1024+512)); SBAR(); }while(0)
  #define KERD(G) do{ if(FOX&&(G)){ kef=*(const LAS3 bf16x8*)(ken_); SBAR(); } }while(0)
  #define CIN0(Cx) (FOX?(Cx):(NOMAX?f32x16{}:negm))
  #define KRD(G,j) do{ if(G){ kf[j]=*(const LAS3 bf16x8*)(kn_+(j)*2048); SBAR(); } }while(0)
  #define SUB(Cx,Px,t,h,VP,KN,KEN,GL,ISSUE) do{ SBAR(); \
    const lds_cptr vp_=(VP); const lds_cptr kn_=(KN); const lds_cptr ken_=(KEN); \
    if(FOX){ Cx=__builtin_amdgcn_mfma_f32_32x32x16_bf16(kef,qre,f32x16{},0,0,0); SBAR(); } \
    VRD(0); float sacc=0.f; \
    GAPA(Cx=__builtin_amdgcn_mfma_f32_32x32x16_bf16(kf[0],qr[0],CIN0(Cx),0,0,0), Px[0],Px[1],Px[2],Px[3],     pw0[0]=PKW(Px,0), pw0[1]=PKW(Px,2), pw0); \
    VRD(1); GAPA(Cx=__builtin_amdgcn_mfma_f32_32x32x16_bf16(kf[1],qr[1],Cx,0,0,0), Px[4],Px[5],Px[6],Px[7],     pw0[2]=PKW(Px,4), pw0[3]=PKW(Px,6), pw0); \
    if constexpr(RESP){ VRD(2); GAPA0(Cx=__builtin_amdgcn_mfma_f32_32x32x16_bf16(kf[2],qr[2],Cx,0,0,0)); VRD(3); GAPA0(Cx=__builtin_amdgcn_mfma_f32_32x32x16_bf16(kf[3],qr[3],Cx,0,0,0)); } else { \
    if(DVB==4){VRD(2);} GAPA(Cx=__builtin_amdgcn_mfma_f32_32x32x16_bf16(kf[2],qr[2],Cx,0,0,0), Px[8],Px[9],Px[10],Px[11],   pw1[0]=PKW(Px,8), pw1[1]=PKW(Px,10), pw1); \
    if(DVB==4){VRD(3);} GAPA(Cx=__builtin_amdgcn_mfma_f32_32x32x16_bf16(kf[3],qr[3],Cx,0,0,0), Px[12],Px[13],Px[14],Px[15], pw1[2]=PKW(Px,12), pw1[3]=PKW(Px,14), pw1); \
    l_reg+=sacc; } \
    ISSUE; \
    CMASK(Cx,t,h); \
    if constexpr(!NOMAX) \
    { float a=MX3(Cx[0],Cx[1],Cx[2]),b=MX3(Cx[3],Cx[4],Cx[5]); a=MX3(a,Cx[6],Cx[7]); b=MX3(b,Cx[8],Cx[9]); a=MX3(a,Cx[10],Cx[11]); b=MX3(b,Cx[12],Cx[13]); a=MX3(a,Cx[14],Cx[15]); \
      float rm=__builtin_fmaxf(a,b); { auto rr=__builtin_amdgcn_permlane32_swap(__float_as_uint(rm),__float_as_uint(rm),false,false); rm=__builtin_fmaxf(__uint_as_float(rr[0]),__uint_as_float(rr[1])); } \
      resc=false; \
      if(__builtin_expect(__any(rm>(float)THRL),0)){ const float dl=__builtin_fmaxf(rm,0.f); mhat+=dl; \
        _Pragma("unroll") for(int r=0;r<16;++r){Cx[r]-=dl;} \
        SETREF(); \
        const float f=__builtin_amdgcn_exp2f(-dl); l_reg*=f; if(hi==0)wsf[r32]=f; resc=true; } } \
    SBAR(); \
    if constexpr(RESP){ \
    VRD(4); GAPA(o[0]=__builtin_amdgcn_mfma_f32_32x32x16_bf16(PAF(0),VFR(0),o[0],0,0,0), Px[8],Px[9],Px[10],Px[11],   pw1[0]=PKW(Px,8), pw1[1]=PKW(Px,10), pw1); \
    VRD(5); GAPA(o[1]=__builtin_amdgcn_mfma_f32_32x32x16_bf16(PAF(0),VFR(1),o[1],0,0,0), Px[12],Px[13],Px[14],Px[15], pw1[2]=PKW(Px,12), pw1[3]=PKW(Px,14), pw1); \
    l_reg+=sacc; \
    VRD(6); GAPB3(o[2]=__builtin_amdgcn_mfma_f32_32x32x16_bf16(PAF(0),VFR(2),o[2],0,0,0), Cx,0); \
    VRD(7); GAPB3(o[3]=__builtin_amdgcn_mfma_f32_32x32x16_bf16(PAF(0),VFR(3),o[3],0,0,0), Cx,3); \
    KRD(GL,0); GAPB3(o[0]=__builtin_amdgcn_mfma_f32_32x32x16_bf16(PAF(1),VFR(4),o[0],0,0,0), Cx,6); \
    KRD(GL,1); GAPB3(o[1]=__builtin_amdgcn_mfma_f32_32x32x16_bf16(PAF(1),VFR(5),o[1],0,0,0), Cx,9); \
    KRD(GL,2); GAPB(o[2]=__builtin_amdgcn_mfma_f32_32x32x16_bf16(PAF(1),VFR(6),o[2],0,0,0), Cx,12); \
    KRD(GL,3); KERD(GL); GAPB(o[3]=__builtin_amdgcn_mfma_f32_32x32x16_bf16(PAF(1),VFR(7),o[3],0,0,0), Cx,14); \
    } else if constexpr(DVB==4){ \
    VRD(4); GAPB(o[0]=__builtin_amdgcn_mfma_f32_32x32x16_bf16(PAF(0),VFR(0),o[0],0,0,0), Cx,0); \
    VRD(5); GAPB(o[1]=__builtin_amdgcn_mfma_f32_32x32x16_bf16(PAF(0),VFR(1),o[1],0,0,0), Cx,2); \
    VRD(6); GAPB(o[2]=__builtin_amdgcn_mfma_f32_32x32x16_bf16(PAF(0),VFR(2),o[2],0,0,0), Cx,4); \
    VRD(7); GAPB(o[3]=__builtin_amdgcn_mfma_f32_32x32x16_bf16(PAF(0),VFR(3),o[3],0,0,0), Cx,6); \
    KRD(GL,0); GAPB(o[0]=__builtin_amdgcn_mfma_f32_32x32x16_bf16(PAF(1),VFR(4),o[0],0,0,0), Cx,8); \
    KRD(GL,1); GAPB(o[1]=__builtin_amdgcn_mfma_f32_32x32x16_bf16(PAF(1),VFR(5),o[1],0,0,0), Cx,10); \
    KRD(GL,2); GAPB(o[2]=__builtin_amdgcn_mfma_f32_32x32x16_bf16(PAF(1),VFR(6),o[2],0,0,0), Cx,12); \
    KRD(GL,3); KERD(GL); GAPB(o[3]=__builtin_amdgcn_mfma_f32_32x32x16_bf16(PAF(1),VFR(7),o[3],0,0,0), Cx,14); \
    if constexpr(LMFMA){ ol=__builtin_amdgcn_mfma_f32_32x32x16_bf16(PAF(0),ones,ol,0,0,0); ol=__builtin_amdgcn_mfma_f32_32x32x16_bf16(PAF(1),ones,ol,0,0,0); SBAR(); } \
    } else { \
    VRD(2); GAPB4(o[0]=__builtin_amdgcn_mfma_f32_32x32x16_bf16(PAF(0),VFR(0),o[0],0,0,0), Cx,0); \
    VRD(3); GAPB4(o[1]=__builtin_amdgcn_mfma_f32_32x32x16_bf16(PAF(0),VFR(1),o[1],0,0,0), Cx,4); \
    KRD(GL,0); KRD(GL,1); GAPB4(o[0]=__builtin_amdgcn_mfma_f32_32x32x16_bf16(PAF(1),VFR(2),o[0],0,0,0), Cx,8); \
    KRD(GL,2); KRD(GL,3); KERD(GL); GAPB4(o[1]=__builtin_amdgcn_mfma_f32_32x32x16_bf16(PAF(1),VFR(3),o[1],0,0,0), Cx,12); \
    } \
    RESC(); \
    }while(0)
  SUB(pB,pA,0,1,vp0+VOFF(0),kp0+KOFF(1),kep0+1024,true,(void)0);
  wait_bar_n(NV+1+xw);
  int t=1;
  #undef CMASK
  #define CMASK(Px,t,h) do{}while(0)
  for(;t+4<NT;++t){
    SUB(pA,pB,t,0,vp0+VOFF(t-1)+2048,kp0+KOFF(t)+512,kep0+((((unsigned)(t))&3u)<<10)+512,true,do{DMA_K(t+3);DMA_KE(t+3);DMA_V(t+2);}while(0));
    SUB(pB,pA,t,1,vp0+VOFF(t),kp0+KOFF(t+1),kep0+((((unsigned)(t+1))&3u)<<10),true,(void)0);
    wait_bar_n(NV+1+xw);
  }
  #undef CMASK
  #define CMASK(Px,t,h) do{int jb_=(t)-(NT-4); if(jb_>=0){ const int kb_=64*jb_+32*(h)+4*hi; _Pragma("unroll") for(int r=0;r<16;++r){ if(kb_+(r&3)+8*(r>>2)>qrel)Px[r]=-INFINITY; } } }while(0)
  for(;t<NT;++t){
    SUB(pA,pB,t,0,vp0+VOFF(t-1)+2048,kp0+KOFF(t)+512,kep0+((((unsigned)(t))&3u)<<10)+512,true,do{ if(t+3<NT){DMA_K(t+3);DMA_KE(t+3);} if(t+2<NT)DMA_V(t+2); }while(0));
    SUB(pB,pA,t,1,vp0+VOFF(t),kp0+KOFF(t+1),kep0+((((unsigned)(t+1))&3u)<<10),(t+1<NT),(void)0);
    if(t+3<NT){wait_bar_n(NV+1+xw);} else if(t+2<NT){wait_bar_n(NV);} else {WAIT_BAR(0);}
  }
  { if constexpr(!LMFMA){ float sacc=0.f; _Pragma("unroll") for(int r=0;r<16;++r)sacc+=pB[r]; l_reg+=sacc; }
    pw0=(u32x4){PKW(pB,0),PKW(pB,2),PKW(pB,4),PKW(pB,6)};pw1=(u32x4){PKW(pB,8),PKW(pB,10),PKW(pB,12),PKW(pB,14)};
    const lds_cptr vp_=vp0+VOFF(NT-1)+2048;
    #pragma unroll
    for(int i=0;i<2*DVB;++i){ vlo[i]=vtr(vp_+((i%DVB)*4096+(i/DVB)*1024)); vhi[i]=vtr(vp_+((i%DVB)*4096+(i/DVB)*1024+512)); }
    #pragma unroll
    for(int d_=0;d_<DVB;++d_)o[d_]=__builtin_amdgcn_mfma_f32_32x32x16_bf16(PAF(0),VFR(d_),o[d_],0,0,0);
    #pragma unroll
    for(int d_=0;d_<DVB;++d_)o[d_]=__builtin_amdgcn_mfma_f32_32x32x16_bf16(PAF(1),VFR(DVB+d_),o[d_],0,0,0);
    if constexpr(LMFMA){ ol=__builtin_amdgcn_mfma_f32_32x32x16_bf16(PAF(0),ones,ol,0,0,0); ol=__builtin_amdgcn_mfma_f32_32x32x16_bf16(PAF(1),ones,ol,0,0,0); } }
  #undef PKW
  #undef PAF
  #undef VFR
  #undef PIN
  #undef MX3
  #undef GAPA
  #undef GAPB
  #undef GAPB4
  #undef GAPB3
  #undef GAPA0
  #undef KERD
  #undef CIN0
  #undef EX
  #undef VRD
  #undef KRD
  #undef SUB
  {auto rr=__builtin_amdgcn_permlane32_swap(__float_as_uint(l_reg),__float_as_uint(l_reg),false,false);l_reg=__uint_as_float(rr[0])+__uint_as_float(rr[1]);}
  if(hi==0)wsf[32+r32]=l_reg;
  asm volatile("s_waitcnt lgkmcnt(0)\n\ts_barrier":::"memory");
  { float rli[16];
    #pragma unroll
    for(int r=0;r<16;++r)rli[r]=__builtin_amdgcn_rcpf(LMFMA?ol[r]:wsf[32+crow(r,hi)]);
    constexpr int OC=32*DVB, CPR=OC/8, RPI=64/CPR;
    bf16*stg=(bf16*)(shm)+wid*4096;
    #pragma unroll
    for(int r=0;r<16;++r){const int orow=crow(r,hi);
      #pragma unroll
      for(int d_=0;d_<DVB;++d_)stg[orow*OC+d_*32+r32]=__float2bfloat16(o[d_][r]*rli[r]);}
    asm volatile("s_waitcnt lgkmcnt(0)":::"memory");
    bf16*Ow=Ob+(long)(q0+wid*32)*OPITCH;
    if constexpr(DVB==2){
    #pragma unroll
    for(int i=0;i<32/RPI;++i){const int row=i*RPI+lane/CPR,ch=lane%CPR; const long grow=q0+wid*32+row; u32x4 v=*(const u32x4*)(stg+row*OC+ch*8); const u32x4 zz=*(const u32x4*)(Zb+grow*DM+ch*8);
      #pragma unroll
      for(int k=0;k<4;++k){ const float z0=__uint_as_float(zz[k]<<16),z1=__uint_as_float(zz[k]&0xffff0000u); v[k]=cvtpk_s(__uint_as_float(v[k]<<16)*(z0/(1.f+__expf(-z0))),__uint_as_float(v[k]&0xffff0000u)*(z1/(1.f+__expf(-z1)))); }
      *(u32x4*)(Yb+grow*1024+ch*8)=v; }
    } else
    if(MODE==0){
    #pragma unroll
    for(int i=0;i<8;++i){const int row=i*4+(lane>>4),ch=lane&15; const u32x4 v=*(const u32x4*)(stg+row*128+ch*8); *(u32x4*)(Ow+(long)row*OPITCH+ch*8)=v;}
    } else {
    const int ch=lane&15; float gg[8];
    #pragma unroll
    for(int k=0;k<8;++k)gg[k]=subg[ch*8+k];
    #pragma unroll
    for(int i=0;i<8;++i){const int row=i*4+(lane>>4); const long grow=q0+wid*32+row;
      const u32x4 v1=*(const u32x4*)(stg+row*128+ch*8), v0=*(const u32x4*)(Ow+(long)row*OPITCH+ch*8), zz=*(const u32x4*)(Zb+grow*DM+ch*8);
      float d[8];
      #pragma unroll
      for(int k=0;k<4;++k){ d[2*k]=__uint_as_float(v0[k]<<16)-lam*__uint_as_float(v1[k]<<16); d[2*k+1]=__uint_as_float(v0[k]&0xffff0000u)-lam*__uint_as_float(v1[k]&0xffff0000u); }
      float ss=0.f;
      #pragma unroll
      for(int k=0;k<8;++k)ss+=d[k]*d[k];
      #pragma unroll
      for(int o_=1;o_<16;o_<<=1)ss+=__shfl_xor(ss,o_);
      const float rs=1.f/sqrtf(ss*(1.f/128.f)+1e-6f); u32x4 w;
      #pragma unroll
      for(int k=0;k<4;++k){ const float z0=__uint_as_float(zz[k]<<16),z1=__uint_as_float(zz[k]&0xffff0000u);
        const float y0=d[2*k]*rs*gg[2*k]*(z0/(1.f+__expf(-z0))), y1=d[2*k+1]*rs*gg[2*k+1]*(z1/(1.f+__expf(-z1))); w[k]=cvtpk_s(y0,y1); }
      *(u32x4*)(Yb+grow*1024+ch*8)=w; }
    } }
  asm volatile("s_waitcnt lgkmcnt(0)\n\ts_barrier":::"memory");
  #undef DMA_K
  #undef DMA_V
  #undef DMA_KE
  #undef SETREF
  #undef KOFF
  #undef VOFF
  #undef CMASK
  #undef RESC
}
#undef SBAR
#undef WAIT_BAR
#undef LAS3
}
constexpr int NWAVES = 8;
#ifndef MK_ONE_LAUNCH
#define MK_ONE_LAUNCH 1
#endif
constexpr int BATCH = 2, SEQ = 16384, D = 1024, M = BATCH * SEQ, NPJ = 4096;
constexpr int ATTN_IN = 4104, ML_IN = 4112;
constexpr float RMS_EPS = 1e-6f, LOG2E = 1.4426950408889634f, C2 = 0.125f * 1.4426950408889634f;
constexpr int NPHASE = 12;
constexpr size_t MiB = 1u << 20;
constexpr size_t WS_CTL = 0, CTL_ZERO_BYTES = 1 * MiB;
constexpr size_t WS_LOGF = 1 * MiB, WS_F2 = 2 * MiB, WS_QE = 3 * MiB, WS_KE = 7 * MiB, WS_LI = 11 * MiB, WS_LF = 12 * MiB;
constexpr size_t WS_GB = 13 * MiB, WS_GE = 14 * MiB, WS_GU = 15 * MiB, WS_CHA = 16 * MiB, WS_CHE = 16 * MiB + 65536, WS_CHM = 16 * MiB + 131072;
constexpr size_t WS_DN = 17 * MiB, WS_NS = 17 * MiB + 524288, WS_SUBG = 16 * MiB + 262144, WS_RSTD = 16 * MiB + 524288;
constexpr size_t WS_ROPE = 18 * MiB, WS_WIN0 = 26 * MiB, WS_WOUT0 = 34 * MiB, WS_WIN1 = 36 * MiB, WS_WOUT1 = 44 * MiB;
constexpr size_t WS_XN = 48 * MiB;
constexpr size_t WS_PROJ = 112 * MiB;
constexpr size_t WS_OB = 368 * MiB;
constexpr size_t WS_END = 464 * MiB;
constexpr int CW_TMO = 0, CW_CODE = 1, CW_BAR = 4096, CW_NRM = 8192, CW_FOXQ = 8192 + 256;
constexpr int RING_OFF = 0, RING_BYTES = 131072;
constexpr int LDSCTL_OFF = RING_BYTES, MISC_OFF = LDSCTL_OFF + 320;
constexpr int LDS_BYTES = 147456;
static_assert(MISC_OFF + 128 <= LDS_BYTES, "LDS map");
#define GAS __attribute__((address_space(1)))
#define LAS __attribute__((address_space(3)))
typedef unsigned short bf16;
typedef unsigned v4u __attribute__((ext_vector_type(4)));
typedef float f32x4 __attribute__((ext_vector_type(4)));
typedef short bf16x8 __attribute__((ext_vector_type(8)));
typedef GAS unsigned gu32;
typedef GAS unsigned long long gu64;
#define RLX_AGENT __ATOMIC_RELAXED, __HIP_MEMORY_SCOPE_AGENT
#define LDS_WAIT() asm volatile("s_waitcnt lgkmcnt(0)" ::: "memory")
#define VM_WAIT() asm volatile("s_waitcnt vmcnt(0)" ::: "memory")
__device__ __forceinline__ unsigned long long rt() { return __builtin_amdgcn_s_memrealtime(); }
__device__ __forceinline__ unsigned f2bf(float f) { unsigned u = __builtin_bit_cast(unsigned, f); return (u + 0x7fffu + ((u >> 16) & 1u)) >> 16; }
__device__ __forceinline__ unsigned pk2(float lo, float hi) { return f2bf(lo) | (f2bf(hi) << 16); }
#define XB_TMO      128
#define XB_XCNT(j)  (256  + 64 * (j))
#define XB_XSUB(j)  (1280 + 64 * (j))
#define XB_XGEN(j)  (2304 + 64 * (j))
#define XB_TOP      3328
#define XB_TOPGEN   3392
#define XCD_BAR_WORDS 3456
#define XB_SPIN_CAP (1u << 18)

__device__ __forceinline__ unsigned xb_ld(unsigned* p)              { return __hip_atomic_load(p, __ATOMIC_RELAXED, __HIP_MEMORY_SCOPE_AGENT); }
__device__ __forceinline__ unsigned xb_add(unsigned* p, unsigned v) { return __hip_atomic_fetch_add(p, v, __ATOMIC_RELAXED, __HIP_MEMORY_SCOPE_AGENT); }
__device__ __forceinline__ unsigned xb_xcc_id() { return (unsigned)__builtin_amdgcn_s_getreg((3 << 11) | 20) & 0xFu; }
#define XB_SPIN(cond, bar) do { unsigned _sp = 0; while (cond) { __builtin_amdgcn_s_sleep(1); \
    if ((++_sp & 255u) == 0u) { if (xb_ld(&(bar)[XB_TMO])) break; if (_sp > XB_SPIN_CAP) { atomicAdd(&(bar)[XB_TMO], 1u); break; } } } } while (0)

struct XcdBarrier {
    unsigned* bar; unsigned x;
    volatile LAS unsigned* st;
};

__device__ __forceinline__ XcdBarrier xcd_barrier_post(unsigned* bar, volatile LAS unsigned* st) {
    XcdBarrier b; b.bar = bar; b.x = xb_xcc_id(); b.st = st;
    if (threadIdx.x == 0) (void)xb_add(&bar[XB_XCNT(b.x)], 1u);
    return b;
}
__device__ __forceinline__ void xcd_barrier_complete(unsigned* bar, unsigned x, unsigned& nloc, unsigned& nx) {
    const unsigned G = gridDim.x * gridDim.y * gridDim.z;
    unsigned sum, cnt, mine, sp = 0u;
    for (;;) {
        sum = 0u; cnt = 0u; mine = 0u;
#pragma unroll
        for (unsigned j = 0; j < 16; ++j) { const unsigned c = xb_ld(&bar[XB_XCNT(j)]); sum += c; cnt += (c > 0u) ? 1u : 0u; mine = (j == x) ? c : mine; }
        if (sum == G) break;
        __builtin_amdgcn_s_sleep(1);
        if ((++sp & 255u) == 0u) { if (xb_ld(&bar[XB_TMO])) break; if (sp > XB_SPIN_CAP) { atomicAdd(&bar[XB_TMO], 1u); break; } }
    }
    nloc = mine > 0u ? mine : 1u; nx = cnt > 0u ? cnt : 1u;
}

__device__ __forceinline__ void xcd_barrier(const XcdBarrier& b) {
    asm volatile("s_waitcnt vmcnt(0)" ::: "memory");
    __syncthreads();
    if (threadIdx.x == 0) {
        unsigned* bar = b.bar;
        __builtin_amdgcn_s_waitcnt(0);
        unsigned nloc = b.st[0], nx = b.st[1];
        if (nloc == 0u) { xcd_barrier_complete(bar, b.x, nloc, nx); b.st[0] = nloc; b.st[1] = nx; }
        const unsigned old = xb_add(&bar[XB_XSUB(b.x)], 1u);
        const unsigned gen = old / nloc;
        if (old + 1u == (gen + 1u) * nloc) {
            __builtin_amdgcn_fence(__ATOMIC_RELEASE, "agent");
            asm volatile("s_waitcnt vmcnt(0)" ::: "memory");
            const unsigned og = xb_add(&bar[XB_TOP], 1u);
            const unsigned tg = og / nx;
            if (og + 1u == (tg + 1u) * nx) xb_add(&bar[XB_TOPGEN], 1u);
            else XB_SPIN(xb_ld(&bar[XB_TOPGEN]) == tg, bar);
            __builtin_amdgcn_fence(__ATOMIC_ACQUIRE, "agent");
            xb_add(&bar[XB_XGEN(b.x)], 1u);
            asm volatile("s_waitcnt vmcnt(0)" ::: "memory");
        } else {
            XB_SPIN(xb_ld(&bar[XB_XGEN(b.x)]) == gen, bar);
            __builtin_amdgcn_fence(__ATOMIC_ACQUIRE, "agent");
            asm volatile("s_waitcnt vmcnt(0)" ::: "memory");
        }
    }
    __syncthreads();
}
__device__ __forceinline__ float wave_sum(float v) {
#pragma unroll
    for (int o = 1; o < 64; o <<= 1) v += __shfl_xor(v, o);
    return v;
}
__device__ __forceinline__ float bf2f(unsigned short b) { return __builtin_bit_cast(float, (unsigned)b << 16); }
__device__ __forceinline__ float bflo(unsigned w) { return __builtin_bit_cast(float, w << 16); }
__device__ __forceinline__ float bfhi(unsigned w) { return __builtin_bit_cast(float, w & 0xffff0000u); }
typedef _Float16 h2p __attribute__((ext_vector_type(2))); typedef float f2p __attribute__((ext_vector_type(2)));
__device__ __forceinline__ unsigned pkh(float lo, float hi) { const f2p v = {lo, hi}; return __builtin_bit_cast(unsigned, __builtin_convertvector(v, h2p)); }
__device__ __forceinline__ float h_lo(unsigned w) { return (float)__builtin_bit_cast(h2p, w)[0]; }
__device__ __forceinline__ float h_hi(unsigned w) { return (float)__builtin_bit_cast(h2p, w)[1]; }
__device__ __forceinline__ float log_sigmoid_f(float x) { return fminf(x, 0.f) - log1pf(__expf(-fabsf(x))); }
__device__ __forceinline__ float sigmoid_f(float x) { return 1.f / (1.f + __expf(-x)); }
__device__ __forceinline__ float silu_f(float x) { return x / (1.f + __expf(-x)); }

typedef unsigned u32x4m __attribute__((ext_vector_type(4)));
struct Ctx {
    LAS unsigned char* lds; char* ldsg; int G, bid;
    float* out; unsigned char* ws;
};
__device__ __forceinline__ const float* kin(int i) { unsigned long long r; const unsigned long long kp = (unsigned long long)__builtin_amdgcn_kernarg_segment_ptr();
    asm volatile("s_load_dwordx2 %0, %1, %2\n\ts_waitcnt lgkmcnt(0)" : "=s"(r) : "s"(kp), "n"(i * 8)); return (const float*)r; }
__device__ __forceinline__ int src_col0(int P) {
    if (P < 1536) return P;
    if (P < 2560) { const int q = P - 1536, grp = q >> 6, p = q & 63; return 1544 + grp * 64 + 16 * (p >> 5) + 4 * ((p >> 3) & 3) + (p & 3) + 32 * ((p >> 2) & 1); }
    return P + 8;
}
__device__ __forceinline__ int src_col1(int P) { if (P < 2048) return P; const int j = (P - 2048) >> 1; return (P & 1) ? 3088 + j : 2064 + j; }
template <bool F16>
__device__ __forceinline__ void transpose_item(const float* W, int ldw, const float* gain, bf16* WT, LAS float* scr, int kb, int nb, int lane, int srcc) {
    const int k0 = 64 * kb, n0 = 32 * nb;
    float wv[32], gv[32];
#pragma unroll
    for (int i = 0; i < 32; ++i) { const int kk = 2 * i + (lane >> 5); gv[i] = gain ? gain[k0 + kk] : 1.f; wv[i] = W[(size_t)(k0 + kk) * ldw + srcc]; }
#pragma unroll
    for (int i = 0; i < 32; ++i) { const int kk = 2 * i + (lane >> 5); scr[kk * 33 + (lane & 31)] = wv[i] * gv[i]; }
    LDS_WAIT(); asm volatile("" ::: "memory");
    const int c = lane & 7;
#pragma unroll
    for (int j = 0; j < 4; ++j) { const int n = (lane >> 3) + 8 * j; const LAS float* s = scr + (8 * c) * 33 + n;
        v4u o; if (F16) { o.x = pkh(s[0 * 33], s[1 * 33]); o.y = pkh(s[2 * 33], s[3 * 33]); o.z = pkh(s[4 * 33], s[5 * 33]); o.w = pkh(s[6 * 33], s[7 * 33]); }
        else { o.x = pk2(s[0 * 33], s[1 * 33]); o.y = pk2(s[2 * 33], s[3 * 33]); o.z = pk2(s[4 * 33], s[5 * 33]); o.w = pk2(s[6 * 33], s[7 * 33]); }
        *(GAS v4u*)(WT + (size_t)(n0 + n) * 1024 + k0 + 8 * c) = o; }
    LDS_WAIT(); asm volatile("" ::: "memory");
}
__device__ __constant__ const double kInvFreq[32] = {1.0, 0.7498942093324559, 0.5623413251903491, 0.4216965034285822, 0.31622776601683794, 0.23713737056616552, 0.1778279410038923, 0.1333521432163324, 0.1, 0.07498942093324558,
    0.05623413251903491, 0.042169650342858224, 0.03162277660168379, 0.023713737056616554, 0.01778279410038923, 0.01333521432163324, 0.01, 0.007498942093324558, 0.005623413251903491, 0.004216965034285823, 0.0031622776601683794,
    0.0023713737056616554, 0.0017782794100389228, 0.001333521432163324, 0.001, 0.0007498942093324559, 0.0005623413251903491, 0.00042169650342858224, 0.00031622776601683794, 0.00023713737056616554, 0.00017782794100389227, 0.0001333521432163324};

__device__ __forceinline__ void prologue_weights(const Ctx& C) {
    LAS float* scr = (LAS float*)(C.lds + RING_OFF + __builtin_amdgcn_readfirstlane((int)threadIdx.x >> 6) * 16384);
    const int gw = C.bid * NWAVES + __builtin_amdgcn_readfirstlane((int)threadIdx.x >> 6), NGW = C.G * NWAVES;
    bf16* Win0 = (bf16*)(C.ws + WS_WIN0); bf16* Wout0 = (bf16*)(C.ws + WS_WOUT0); bf16* Win1 = (bf16*)(C.ws + WS_WIN1); bf16* Wout1 = (bf16*)(C.ws + WS_WOUT1);
    constexpr int I_IN = 16 * 128, I_OUT = 16 * 32, NITEMS = 2 * I_IN + 2 * I_OUT;
    for (int it = gw; it < NITEMS; it += NGW) {
        int r = it;
        if (r < I_IN) { const int kb = r / 128, nb = r % 128; transpose_item<false>(kin(3), ATTN_IN, kin(2), Win0, scr, kb, nb, ((int)threadIdx.x & 63), src_col0(32 * nb + (((int)threadIdx.x & 63) & 31))); continue; } r -= I_IN;
        if (r < I_IN) { const int kb = r / 128, nb = r % 128; transpose_item<true>(kin(12), ML_IN, kin(11), Win1, scr, kb, nb, ((int)threadIdx.x & 63), src_col1(32 * nb + (((int)threadIdx.x & 63) & 31))); continue; } r -= I_IN;
        if (r < I_OUT) { const int kb = r / 32, nb = r % 32; transpose_item<false>(kin(10), 1024, nullptr, Wout0, scr, kb, nb, ((int)threadIdx.x & 63), 32 * nb + (((int)threadIdx.x & 63) & 31)); continue; } r -= I_OUT;
        { const int kb = r / 32, nb = r % 32; transpose_item<false>(kin(15), 1024, nullptr, Wout1, scr, kb, nb, ((int)threadIdx.x & 63), 32 * nb + (((int)threadIdx.x & 63) & 31)); }
    }
    const int* pos = (const int*)kin(1); float* rope = (float*)(C.ws + WS_ROPE);
    for (int idx = C.bid * (NWAVES * 64) + (int)threadIdx.x; idx < M * 32; idx += C.G * NWAVES * 64) { const int m = idx >> 5, i = idx & 31;
        double rev = (double)pos[m] * kInvFreq[i] * 0.15915494309189535; rev -= floor(rev); const float rf = (float)rev;
        *(float2*)(rope + (size_t)idx * 2) = make_float2(__builtin_amdgcn_cosf(rf), __builtin_amdgcn_sinf(rf)); }
}
typedef _Float16 h8n __attribute__((ext_vector_type(8)));
template <int NG, bool B16IN>
__device__ __forceinline__ void norm_gate_phase(const Ctx& C, const void* Xv, const float* W, int ldw, int gcol0, const float* gain, const float* bias_a, const float* bias_b, bf16* XN, float* outA, float* outB, float* rstdo) {
    constexpr int TP = 1032;
    LAS unsigned short* thi = (LAS unsigned short*)(C.lds + RING_OFF); LAS unsigned short* tlo = thi + 16 * TP;
#pragma unroll 8
    for (int i = (int)threadIdx.x; i < 16 * 1024; i += NWAVES * 64) { const int c = i & 15, k = i >> 4; float w = 0.f; if (c < NG) w = W[(size_t)k * ldw + gcol0 + c] * gain[k];
        const _Float16 h = (_Float16)w; const _Float16 l = (_Float16)(w - (float)h); thi[c * TP + k] = __builtin_bit_cast(unsigned short, h); tlo[c * TP + k] = __builtin_bit_cast(unsigned short, l); }
    __syncthreads();
    const int ln = (int)threadIdx.x & 63, r16 = ln & 15, kg = ln >> 4;
    const int gw = C.bid * NWAVES + __builtin_amdgcn_readfirstlane((int)threadIdx.x >> 6), NGW = C.G * NWAVES;
    for (int grp = gw; grp < M / 16; grp += NGW) { const size_t row = (size_t)grp * 16 + r16;
        f32x4 acc = {0.f, 0.f, 0.f, 0.f}; float ss = 0.f;
#pragma unroll 4
        for (int s = 0; s < 32; ++s) { const int k0 = 32 * s + 8 * kg;
            const bf16x8 bh = *(const LAS bf16x8*)(thi + r16 * TP + k0), bl = *(const LAS bf16x8*)(tlo + r16 * TP + k0);
            if (B16IN) { const v4u a = *(const v4u*)((const bf16*)Xv + row * D + k0);
                ss += (h_lo(a.x) * h_lo(a.x) + h_hi(a.x) * h_hi(a.x)) + (h_lo(a.y) * h_lo(a.y) + h_hi(a.y) * h_hi(a.y)) + (h_lo(a.z) * h_lo(a.z) + h_hi(a.z) * h_hi(a.z)) + (h_lo(a.w) * h_lo(a.w) + h_hi(a.w) * h_hi(a.w));
                const h8n af = __builtin_bit_cast(h8n, a);
                acc = __builtin_amdgcn_mfma_f32_16x16x32_f16(af, __builtin_bit_cast(h8n, bh), acc, 0, 0, 0); acc = __builtin_amdgcn_mfma_f32_16x16x32_f16(af, __builtin_bit_cast(h8n, bl), acc, 0, 0, 0);
            } else { const f32x4 x0 = *(const f32x4*)((const float*)Xv + row * D + k0), x1 = *(const f32x4*)((const float*)Xv + row * D + k0 + 4);
                ss += (x0[0] * x0[0] + x0[1] * x0[1]) + (x0[2] * x0[2] + x0[3] * x0[3]) + (x1[0] * x1[0] + x1[1] * x1[1]) + (x1[2] * x1[2] + x1[3] * x1[3]);
                v4u o; o.x = pk2(x0[0], x0[1]); o.y = pk2(x0[2], x0[3]); o.z = pk2(x1[0], x1[1]); o.w = pk2(x1[2], x1[3]); *(v4u*)(XN + row * D + k0) = o;
                v4u ah, al;
                ah.x = pkh(x0[0], x0[1]); ah.y = pkh(x0[2], x0[3]); ah.z = pkh(x1[0], x1[1]); ah.w = pkh(x1[2], x1[3]);
                al.x = pkh(x0[0] - h_lo(ah.x), x0[1] - h_hi(ah.x)); al.y = pkh(x0[2] - h_lo(ah.y), x0[3] - h_hi(ah.y)); al.z = pkh(x1[0] - h_lo(ah.z), x1[1] - h_hi(ah.z)); al.w = pkh(x1[2] - h_lo(ah.w), x1[3] - h_hi(ah.w));
                const h8n afh = __builtin_bit_cast(h8n, ah), afl = __builtin_bit_cast(h8n, al);
                acc = __builtin_amdgcn_mfma_f32_16x16x32_f16(afh, __builtin_bit_cast(h8n, bh), acc, 0, 0, 0); acc = __builtin_amdgcn_mfma_f32_16x16x32_f16(afh, __builtin_bit_cast(h8n, bl), acc, 0, 0, 0);
                acc = __builtin_amdgcn_mfma_f32_16x16x32_f16(afl, __builtin_bit_cast(h8n, bh), acc, 0, 0, 0); } }
        ss += __shfl_xor(ss, 16); ss += __shfl_xor(ss, 32);
        const float rstd = 1.f / sqrtf(ss * (1.f / D) + RMS_EPS);
        if (kg == 0) rstdo[row] = rstd;
#pragma unroll
        for (int i = 0; i < 4; ++i) { const float rs = __shfl(rstd, 4 * kg + i); const float g = acc[i] * rs; const size_t m = (size_t)grp * 16 + 4 * kg + i;
            if (NG == 8) { if (r16 < 8) outA[m * 8 + r16] = log_sigmoid_f(g + bias_a[r16 & 7]); }
            else { if (r16 < 8) outA[m * 8 + r16] = g + bias_a[r16 & 7]; else outB[m * 8 + r16 - 8] = log_sigmoid_f(g + bias_b[r16 & 7]); } }
    }
}
__device__ __forceinline__ void cumsum_phase(const Ctx& C) {
    if (C.bid >= 16) return;
    const int bh = C.bid, b = bh >> 3, h = bh & 7, t = (int)threadIdx.x;
    const float* lp = (const float*)(C.ws + WS_LOGF) + ((size_t)b * SEQ + 32 * t) * 8 + h;
    float v[32]; float run = 0.f;
#pragma unroll
    for (int i = 0; i < 32; ++i) { run += lp[i * 8]; v[i] = run; }
    float x = run;
#pragma unroll
    for (int o = 1; o < 64; o <<= 1) { const float y = __shfl_up(x, o); if (((int)threadIdx.x & 63) >= o) x += y; }
    volatile LAS float* wt = (volatile LAS float*)(C.lds + LDSCTL_OFF);
    if (((int)threadIdx.x & 63) == 63) wt[__builtin_amdgcn_readfirstlane((int)threadIdx.x >> 6)] = x;
    __syncthreads();
    float off = x - run;
    for (int w = 0; w < __builtin_amdgcn_readfirstlane((int)threadIdx.x >> 6); ++w) off += wt[w];
    float* F2 = (float*)(C.ws + WS_F2) + (size_t)bh * SEQ + 32 * t;
    v4u* QE = (v4u*)(C.ws + WS_QE) + (size_t)bh * SEQ + 32 * t; v4u* KE = (v4u*)(C.ws + WS_KE) + (size_t)bh * SEQ + 32 * t;
#pragma unroll
    for (int i = 0; i < 32; ++i) { const float f = (off + v[i]) * LOG2E; F2[i] = f;
        const unsigned h0 = f2bf(f); const float r1 = f - __builtin_bit_cast(float, h0 << 16); const unsigned h1 = f2bf(r1); const float r2 = r1 - __builtin_bit_cast(float, h1 << 16); const unsigned h2 = f2bf(r2);
        v4u q; q.x = h0 | (h1 << 16); q.y = h2 | (0x3F80u << 16); q.z = 0x3F80u | (0x3F80u << 16); q.w = 0u; QE[i] = q;
        v4u k; k.x = 0x3F80u | (0x3F80u << 16); k.y = 0x3F80u | ((h0 ^ 0x8000u) << 16); k.z = (h1 ^ 0x8000u) | ((h2 ^ 0x8000u) << 16); k.w = 0u; KE[i] = k; }
    __syncthreads();
}
__device__ __forceinline__ void he_cols(int he, int& qc, int& kc, int& vc, int& oc) {
    if (he < 8) { qc = he * 64; kc = 512 + he * 64; vc = 1024 + he * 64; oc = he * 64; }
    else { const int j = he - 8, hd = j >> 2, c = (j >> 1) & 1, e = j & 1; qc = 1536 + (hd * 2 + c) * 64; kc = 2048 + (hd * 2 + c) * 64; vc = 2560 + hd * 128 + e * 64; oc = 512 + j * 64; }
}
__device__ __forceinline__ int fox_t0(const float* F2b, int qb, float qk2, int lane) {
    const int NTf = 4 * (qb + 1); const float fq = F2b[qb * 256]; int cnt = 0;
#pragma unroll
    for (int k = 0; k < 4; ++k) { const int t = lane + 64 * k; const bool skip = (t < NTf) && (qk2 + fq - F2b[64 * t + 63] < -150.f); cnt += __builtin_popcountll(__ballot(skip)); }
    int t0 = cnt; if (t0 > NTf - 4) t0 = NTf - 4; return __builtin_amdgcn_readfirstlane(t0);
}
__device__ __forceinline__ void attn_tuned_phase(const Ctx& C) {
    typedef attn_body::bf16 abf;
    const abf* P = (const abf*)(C.ws + WS_PROJ); abf* OB = (abf*)(C.ws + WS_OB); const float* F2 = (const float*)(C.ws + WS_F2); const abf* KE = (const abf*)(C.ws + WS_KE);
    const int vcu = (C.G % 8 == 0) ? (C.bid % 8) * (C.G / 8) + C.bid / 8 : C.bid;
    char* shm = C.ldsg + RING_OFF; gu32* ctl = (gu32*)(C.ws + WS_CTL);
    const int tid = threadIdx.x;
    volatile LAS unsigned* qslot = (volatile LAS unsigned*)(C.lds + LDSCTL_OFF + 64);
    bool fox_nomax, diff_nomax;
    { const int l = tid & 63; float bound = 0.f;
      if (l < 32) { const int dif = l >> 4, i = l & 15; const gu32* nq = ctl + CW_NRM + dif * 64 + i * 2; const gu32* nk = nq + 32;
          const float qn2 = __builtin_bit_cast(float, __hip_atomic_load(nq, RLX_AGENT)) + __builtin_bit_cast(float, __hip_atomic_load(nq + 1, RLX_AGENT));
          const float kn2 = __builtin_bit_cast(float, __hip_atomic_load(nk, RLX_AGENT)) + __builtin_bit_cast(float, __hip_atomic_load(nk + 1, RLX_AGENT));
          bound = 1.02f * sqrtf(qn2 * kn2); }
      const unsigned long long ok = __ballot(bound <= 100.f);
      fox_nomax = (ok & 0xffffull) == 0xffffull; diff_nomax = ((ok >> 16) & 0xffffull) == 0xffffull; }
#ifndef ATT_NO_DIFF
    float lam;
    { const int l = tid & 63; const float d1 = kin(5)[l] * kin(6)[l], d2 = kin(7)[l] * kin(8)[l]; lam = __expf(wave_sum(d1)) - __expf(wave_sum(d2)) + 0.2f; }
    float* subg = (float*)(C.ws + WS_SUBG);
    if (tid < 128) subg[tid] = kin(9)[tid] * 0.8f;
    abf* Yd = (abf*)(C.ws + WS_XN);
#define DIFF_LOOP(NM) _Pragma("nounroll") \
    for (int it = 0; it < 8 * 8 * 64; ++it) { const int p = vcu + (it >> 2) * C.G; if (p >= 8 * 32) break; \
        const int bh = p >> 5, s = p & 31, b = bh >> 2, hd = bh & 3, c = it & 1, qb = (it & 2) ? s : 63 - s;     \
        const abf* Pb = P + (size_t)b * SEQ * NPJ; abf* Osc = OB + (size_t)b * SEQ * 512 + hd * 128; \
        const abf* KTb = (const abf*)(C.ws + WS_OB + 32 * MiB) + (size_t)((b * 8 + hd * 2 + c) * 256) * 4096; const abf* VTb = (const abf*)(C.ws + WS_OB + 64 * MiB) + (size_t)((b * 4 + hd) * 256) * 8192; \
        attn256::unit<8, 4, false, NM>(c, qb, 0, Pb + 1536 + (hd * 2 + c) * 64, KTb, VTb, Osc, Pb + 3072 + 512 + hd * 128, Yd + (size_t)b * SEQ * 1024 + 512 + hd * 128, subg, lam, nullptr, nullptr, shm); }
    if (diff_nomax) { DIFF_LOOP(true) } else { DIFF_LOOP(false) }
#undef DIFF_LOOP
#endif
#ifndef ATT_NO_FOX
    if (tid == 0) *qslot = __hip_atomic_fetch_add(ctl + CW_FOXQ, 1u, RLX_AGENT);
    __syncthreads();
    unsigned u = __builtin_amdgcn_readfirstlane(*qslot);
#define FOX_LOOP(NM) _Pragma("nounroll") \
    while (u < 1024u) { \
        __syncthreads(); \
        if (tid == 0) *qslot = __hip_atomic_fetch_add(ctl + CW_FOXQ, 1u, RLX_AGENT); \
        const int qb = 63 - (int)(u >> 4), bh = (int)(u & 15u), b = bh >> 3, he = bh & 7; int qc, kc, vc, oc; he_cols(he, qc, kc, vc, oc); \
        const gu32* nq = ctl + CW_NRM + ((0 * 2 + b) * 8 + he) * 2; const gu32* nk = ctl + CW_NRM + ((1 * 2 + b) * 8 + he) * 2; \
        const float qn2 = __builtin_bit_cast(float, __hip_atomic_load(nq, RLX_AGENT)) + __builtin_bit_cast(float, __hip_atomic_load(nq + 1, RLX_AGENT)); \
        const float kn2 = __builtin_bit_cast(float, __hip_atomic_load(nk, RLX_AGENT)) + __builtin_bit_cast(float, __hip_atomic_load(nk + 1, RLX_AGENT)); \
        const float qk2 = 2.04f * sqrtf(qn2 * kn2); \
        const float* F2b = F2 + (size_t)bh * SEQ; \
        const int t0 = fox_t0(F2b, qb, qk2, tid & 63); \
        const abf* Pb = P + (size_t)b * SEQ * NPJ; \
        attn256::unit<8, 2, true, NM>(2, qb, t0, Pb + qc, Pb + kc, Pb + vc, nullptr, Pb + 3072 + oc, (abf*)(C.ws + WS_XN) + (size_t)b * SEQ * 1024 + oc, nullptr, 0.f, F2b, KE + (size_t)bh * SEQ * 8, shm); \
        u = __builtin_amdgcn_readfirstlane(*qslot); }
    if (fox_nomax) { FOX_LOOP(true) } else { FOX_LOOP(false) }
#undef FOX_LOOP
#endif
}
__device__ __forceinline__ void final_norm_phase(const Ctx& C, const bf16* X2) {
    const int lane = (int)threadIdx.x & 63, gw = C.bid * NWAVES + __builtin_amdgcn_readfirstlane((int)threadIdx.x >> 6), NGW = C.G * NWAVES; const float* g = kin(16);
    f32x4 gv[4];
#pragma unroll
    for (int j = 0; j < 4; ++j) gv[j] = ((const f32x4*)g)[lane + 64 * j];
    unsigned long long nh[4];
#define FN_LOAD(mm) do { const GAS unsigned long long* xb = (const GAS unsigned long long*)(X2 + (size_t)(mm) * D) + lane; _Pragma("unroll") for (int j = 0; j < 4; ++j) nh[j] = xb[64 * j]; } while (0)
    if (gw < M) FN_LOAD(gw);
    for (int m = gw; m < M; m += NGW) {
        f32x4 v[4]; float ss = 0.f;
#pragma unroll
        for (int j = 0; j < 4; ++j) { const unsigned long long w = nh[j]; const unsigned lo = (unsigned)w, hi = (unsigned)(w >> 32); v[j] = (f32x4){h_lo(lo), h_hi(lo), h_lo(hi), h_hi(hi)};
            ss += (v[j].x * v[j].x + v[j].y * v[j].y) + (v[j].z * v[j].z + v[j].w * v[j].w); }
        if (m + NGW < M) FN_LOAD(m + NGW);
        const float rstd = 1.f / sqrtf(wave_sum(ss) * (1.f / D) + RMS_EPS);
        GAS f32x4* xr = (GAS f32x4*)(C.out + (size_t)m * D) + lane;
#pragma unroll
        for (int j = 0; j < 4; ++j) xr[64 * j] = v[j] * rstd * gv[j];
    }
}
#undef FN_LOAD
typedef float f32x16m __attribute__((ext_vector_type(16)));
typedef _Float16 h8m __attribute__((ext_vector_type(8))); typedef _Float16 h2m __attribute__((ext_vector_type(2))); typedef float f2m __attribute__((ext_vector_type(2)));
__device__ __forceinline__ unsigned pkh2(float lo, float hi) { const f2m v = {lo, hi}; return __builtin_bit_cast(unsigned, __builtin_convertvector(v, h2m)); }
__device__ __forceinline__ float hlo(unsigned w) { return (float)__builtin_bit_cast(h2m, w)[0]; }
__device__ __forceinline__ float hhi(unsigned w) { return (float)__builtin_bit_cast(h2m, w)[1]; }
#define MFMA_H(a, b, c) __builtin_amdgcn_mfma_f32_32x32x16_f16(__builtin_bit_cast(h8m, (a)), __builtin_bit_cast(h8m, (b)), (c), 0, 0, 0)
typedef short s16x4m __attribute__((ext_vector_type(4)));
__device__ __forceinline__ int crow_m(int reg, int hh) { return (reg & 3) + 8 * (reg >> 2) + 4 * hh; }
__device__ __forceinline__ s16x4m tr4(const LAS unsigned char* p) { return __builtin_bit_cast(s16x4m, __builtin_amdgcn_ds_read_tr16_b64_v4i16((LAS s16x4m*)p)); }
__device__ __forceinline__ bf16x8 tr_frag(const LAS unsigned char* base, int stride, int row0, int col0, int lane, int hmul, int rstep) {
    const int hh = lane >> 5, blk = (lane >> 4) & 1, q = (lane & 15) >> 2, p = lane & 3;
    const LAS unsigned char* a = base + (row0 + hmul * hh + q) * stride + (col0 + 16 * blk + 4 * p) * 2;
    const s16x4m lo = tr4(a), hi = tr4(a + rstep * stride);
    return (bf16x8){lo[0], lo[1], lo[2], lo[3], hi[0], hi[1], hi[2], hi[3]};
}
__device__ __forceinline__ void mlstm_scan_phase(const Ctx& C) {
    const int lane = threadIdx.x & 63, gw = C.bid * NWAVES + __builtin_amdgcn_readfirstlane((int)threadIdx.x >> 6), NGW = C.G * NWAVES;
    const float* LI = (const float*)(C.ws + WS_LI); const float* LF = (const float*)(C.ws + WS_LF);
    float* GB = (float*)(C.ws + WS_GB); float* GE = (float*)(C.ws + WS_GE); float* GU = (float*)(C.ws + WS_GU); float* CHA = (float*)(C.ws + WS_CHA); float* CHE = (float*)(C.ws + WS_CHE);
    for (int id = gw; id < 2048; id += NGW) { const int bh = id >> 7, c = id & 127, b = bh >> 3, h = bh & 7; const size_t r0 = (size_t)b * SEQ + c * 128 + 2 * lane;
        const float lf0 = LF[r0 * 8 + h], lf1 = LF[(r0 + 1) * 8 + h], li0 = LI[r0 * 8 + h], li1 = LI[(r0 + 1) * 8 + h];
        const float ps = lf0 + lf1; float x = ps;
#pragma unroll
        for (int o = 1; o < 64; o <<= 1) { const float y = __shfl_up(x, o); if (lane >= o) x += y; }
        const float b0 = (x - ps) + lf0, b1 = x, e0 = li0 - b0, e1 = li1 - b1;
        float y = fmaxf(e0, e1);
#pragma unroll
        for (int o = 1; o < 64; o <<= 1) { const float z = __shfl_up(y, o); if (lane >= o) y = fmaxf(y, z); }
        float prev = __shfl_up(y, 1); if (lane == 0) prev = -INFINITY;
        const float u0 = fmaxf(prev, e0), u1 = fmaxf(u0, e1);
        const size_t o2 = (size_t)id * 128 + 2 * lane;
        *(float2*)(GB + o2) = make_float2(b0, b1); *(float2*)(GE + o2) = make_float2(e0, e1); *(float2*)(GU + o2) = make_float2(u0, u1);
        if (lane == 63) { CHA[id] = b1; CHE[id] = u1; }
    }
}
__device__ __forceinline__ void mlstm_dc_phase(const Ctx& C) {
    const int tid = threadIdx.x, lane = tid & 63, wave = __builtin_amdgcn_readfirstlane(tid >> 6);
    const bf16* P = (const bf16*)(C.ws + WS_PROJ); bf16* DC = (bf16*)(C.ws + WS_OB); float* DN = (float*)(C.ws + WS_DN);
    const float* GE = (const float*)(C.ws + WS_GE); const float* CHE = (const float*)(C.ws + WS_CHE);
    LAS unsigned char* Ks = C.lds; LAS unsigned char* Vs = C.lds + 18432; LAS float* wsm = (LAS float*)(C.lds + 53248);
    v4u pk[2], pv[4]; float pge = 0.f, pche = 0.f;
#define M3_LOAD(u_) do { const int bh_ = (u_) >> 7, c_ = (u_) & 127, b_ = bh_ >> 3, h_ = bh_ & 7; const size_t r0_ = (size_t)b_ * SEQ + c_ * 128; \
        _Pragma("unroll") for (int i = 0; i < 2; ++i) { const int idx = tid + 512 * i, r = idx >> 3, ch = idx & 7; pk[i] = *(const v4u*)(P + (size_t)16777216 + (size_t)(u_) * 8192 + r * 64 + ch * 8); } \
        _Pragma("unroll") for (int i = 0; i < 4; ++i) { const int idx = tid + 512 * i, r = idx >> 4, ch = idx & 15; pv[i] = *(const v4u*)(P + (size_t)33554432 + (size_t)(u_) * 16384 + r * 128 + ch * 8); } \
        pche = CHE[(u_)]; if (tid < 128) pge = GE[(size_t)(u_) * 128 + tid]; } while (0)
    int unit = C.bid; if (unit < 2048) M3_LOAD(unit);
    while (unit < 2048) {
        if (tid < 128) wsm[tid] = __expf(pge - pche);
#pragma unroll
        for (int i = 0; i < 2; ++i) { const int idx = tid + 512 * i, r = idx >> 3, ch = idx & 7; *(LAS v4u*)(Ks + r * 144 + ch * 16) = pk[i]; }
        __syncthreads();
#pragma unroll
        for (int i = 0; i < 4; ++i) { const int idx = tid + 512 * i, r = idx >> 4, ch = idx & 15; const v4u v = pv[i]; const float w = wsm[r]; v4u o;
            o.x = pkh2(hlo(v.x) * w, hhi(v.x) * w); o.y = pkh2(hlo(v.y) * w, hhi(v.y) * w); o.z = pkh2(hlo(v.z) * w, hhi(v.z) * w); o.w = pkh2(hlo(v.w) * w, hhi(v.w) * w);
            *(LAS v4u*)(Vs + r * 272 + ch * 16) = o; }
        __syncthreads();
        const int cur = unit; unit += C.G; if (unit < 2048) M3_LOAD(unit);
        { const int db = wave >> 2, eb = wave & 3, r = lane & 31, hh = lane >> 5; f32x16m acc = {};
#pragma unroll
          for (int ks = 0; ks < 8; ++ks) { const bf16x8 a = tr_frag(Ks, 144, 16 * ks, 32 * db, lane, 8, 4), bb = tr_frag(Vs, 272, 16 * ks, 32 * eb, lane, 8, 4);
              acc = MFMA_H(a, bb, acc); }
          bf16* o = DC + (size_t)cur * 8192 + (size_t)(32 * eb + r) * 64 + 32 * db + 4 * hh;
#pragma unroll
          for (int g = 0; g < 4; ++g) { unsigned long long w = (unsigned long long)pkh2(acc[4 * g], acc[4 * g + 1]) | ((unsigned long long)pkh2(acc[4 * g + 2], acc[4 * g + 3]) << 32); *(unsigned long long*)(o + 8 * g) = w; } }
        if (tid < 64) { float acc = 0.f; for (int s = 0; s < 128; ++s) acc += wsm[s] * (float)*(const LAS _Float16*)(Ks + s * 144 + tid * 2); DN[(size_t)cur * 64 + tid] = acc; }
        __syncthreads();
    }
#undef M3_LOAD
}
__device__ __forceinline__ void mlstm_state_phase(const Ctx& C) {
    const int tid = threadIdx.x;
    const bf16* DC = (const bf16*)(C.ws + WS_OB); bf16* CST = (bf16*)(C.ws + WS_OB + 64 * MiB); const float* DN = (const float*)(C.ws + WS_DN); float* NS = (float*)(C.ws + WS_NS);
    const float* CHA = (const float*)(C.ws + WS_CHA); const float* CHE = (const float*)(C.ws + WS_CHE); float* CHM = (float*)(C.ws + WS_CHM);
    LAS float* wold = (LAS float*)(C.lds); LAS float* scl = wold + 128; LAS float* aa = scl + 128; LAS float* ee = aa + 128;
    for (int vb = C.bid; vb < 256; vb += C.G) { const int bh = vb >> 4, part = vb & 15;
        if (tid < 128) { aa[tid] = CHA[bh * 128 + tid]; ee[tid] = CHE[bh * 128 + tid]; }
        __syncthreads();
        if (tid < 64) { const float a0 = aa[2 * tid], e0 = ee[2 * tid], a1 = aa[2 * tid + 1], e1 = ee[2 * tid + 1];
            float A = a0 + a1, B = fmaxf(e0 + a0 + a1, e1 + a1);
#pragma unroll
            for (int o = 1; o < 64; o <<= 1) { const float Ap = __shfl_up(A, o), Bp = __shfl_up(B, o); if (tid >= o) { B = fmaxf(Bp + A, B); A = Ap + A; } }
            float Ae = __shfl_up(A, 1), Be = __shfl_up(B, 1); if (tid == 0) { Ae = 0.f; Be = -INFINITY; }
            const float m0 = fmaxf(0.f + Ae, Be), mx0 = fmaxf(m0, e0), m1 = a0 + mx0, mx1 = fmaxf(m1, e1);
            wold[2 * tid] = __expf(m0 - mx0); scl[2 * tid] = __expf(e0 - mx0); wold[2 * tid + 1] = __expf(m1 - mx1); scl[2 * tid + 1] = __expf(e1 - mx1);
            if (part == 0) { CHM[bh * 128 + 2 * tid] = m0; CHM[bh * 128 + 2 * tid + 1] = m1; } }
        __syncthreads();
        { const size_t idx = (size_t)part * 512 + tid; const bf16* dc = DC + (size_t)bh * 128 * 8192 + idx; bf16* cs = CST + (size_t)bh * 128 * 8192 + idx; float cv = 0.f;
#pragma unroll 16
          for (int c = 0; c < 128; ++c) { const float d = (float)__builtin_bit_cast(_Float16, dc[(size_t)c * 8192]); cs[(size_t)c * 8192] = __builtin_bit_cast(unsigned short, (_Float16)fminf(fmaxf(cv, -60000.f), 60000.f)); cv = wold[c] * cv + scl[c] * d; } }
        if (part == 0 && tid < 64) { const float* dn = DN + (size_t)bh * 128 * 64 + tid; float* ns = NS + (size_t)bh * 128 * 64 + tid; float nv = 0.f;
#pragma unroll 8
          for (int c = 0; c < 128; ++c) { const float d = dn[c * 64]; ns[c * 64] = nv; nv = wold[c] * nv + scl[c] * d; } }
        __syncthreads();
    }
#undef M5_LOAD
}
__device__ __forceinline__ void mlstm_out_phase(const Ctx& C) {
    const int tid = threadIdx.x, lane = tid & 63, wave = __builtin_amdgcn_readfirstlane(tid >> 6);
    const bf16* P = (const bf16*)(C.ws + WS_PROJ); bf16* Y = (bf16*)(C.ws + WS_XN); const bf16* CST = (const bf16*)(C.ws + WS_OB + 64 * MiB); const float* NS = (const float*)(C.ws + WS_NS);
    const float* GB = (const float*)(C.ws + WS_GB); const float* GE = (const float*)(C.ws + WS_GE); const float* GU = (const float*)(C.ws + WS_GU); const float* CHM = (const float*)(C.ws + WS_CHM);
    LAS unsigned char* Qs = C.lds; LAS unsigned char* Ks = C.lds + 18432; LAS unsigned char* Vs = C.lds + 36864; LAS unsigned char* Cts = C.lds + 71680;
    LAS float* e2 = (LAS float*)(C.lds + 90112); LAS float* M2 = e2 + 128; LAS float* wint = M2 + 128; LAS float* flr = wint + 128; LAS float* nsl = flr + 128; LAS float* invw = nsl + 64 + wave * 32;
    LAS float* Hs = (LAS float*)(C.lds);
    v4u pq[2], pkk[2], pc[2], pv[4], pog[4]; float pe = 0.f, pu = 0.f, pb = 0.f, pns = 0.f, pmc = 0.f;
#define M5_LOAD(u_) do { const int bh_ = (u_) >> 7, c_ = (u_) & 127, b_ = bh_ >> 3, h_ = bh_ & 7; const size_t r0_ = (size_t)b_ * SEQ + c_ * 128; \
        _Pragma("unroll") for (int i = 0; i < 2; ++i) { const int idx = tid + 512 * i, r = idx >> 3, ch = idx & 7; const bf16* src = P + (size_t)(u_) * 8192 + r * 64 + ch * 8; \
            pq[i] = *(const v4u*)(src); pkk[i] = *(const v4u*)(src + 16777216); pc[i] = *(const v4u*)(CST + (size_t)(u_) * 8192 + r * 64 + ch * 8); } \
        _Pragma("unroll") for (int i = 0; i < 4; ++i) { const int idx = tid + 512 * i, r = idx >> 4, ch = idx & 15; pv[i] = *(const v4u*)(P + (size_t)33554432 + (size_t)(u_) * 16384 + r * 128 + ch * 8); } \
        pmc = CHM[(u_)]; if (tid < 128) { const size_t gi = (size_t)(u_) * 128 + tid; pe = GE[gi]; pu = GU[gi]; pb = GB[gi]; } else if (tid < 192) pns = NS[(size_t)(u_) * 64 + tid - 128]; } while (0)
    int unit = C.bid; if (unit < 2048) M5_LOAD(unit);
    while (unit < 2048) { const int bh = unit >> 7, c = unit & 127, b = bh >> 3, h = bh & 7; const size_t row0 = (size_t)b * SEQ + c * 128;
        { const float mc = pmc;
          if (tid < 128) { const float Mt = fmaxf(mc, pu); e2[tid] = pe * LOG2E; M2[tid] = Mt * LOG2E; wint[tid] = __expf(mc - Mt); flr[tid] = __expf(-(pb + Mt)); }
          else if (tid < 192) nsl[tid - 128] = pns; }
#pragma unroll
        for (int i = 0; i < 2; ++i) { const int idx = tid + 512 * i, r = idx >> 3, ch = idx & 7; *(LAS v4u*)(Qs + r * 144 + ch * 16) = pq[i]; *(LAS v4u*)(Ks + r * 144 + ch * 16) = pkk[i]; *(LAS v4u*)(Cts + r * 144 + ch * 16) = pc[i]; }
#pragma unroll
        for (int i = 0; i < 4; ++i) { const int idx = tid + 512 * i, r = idx >> 4, ch = idx & 15; *(LAS v4u*)(Vs + r * 272 + ch * 16) = pv[i]; }
        __syncthreads();
        { const int nxt = unit + C.G; if (nxt < 2048) M5_LOAD(nxt); }
        const int tb = wave & 3, eh = wave >> 2, r = lane & 31, hh = lane >> 5;
        f32x16m acc[2]; acc[0] = f32x16m{}; acc[1] = f32x16m{};
        bf16x8 qf[4];
#pragma unroll
        for (int kd = 0; kd < 4; ++kd) qf[kd] = *(const LAS bf16x8*)(Qs + (32 * tb + r) * 144 + (16 * kd + 8 * hh) * 2);
#pragma unroll
        for (int kd = 0; kd < 4; ++kd)
#pragma unroll
            for (int j = 0; j < 2; ++j) { const bf16x8 cf = *(const LAS bf16x8*)(Cts + (64 * eh + 32 * j + r) * 144 + (16 * kd + 8 * hh) * 2); acc[j] = MFMA_H(qf[kd], cf, acc[j]); }
#pragma unroll
        for (int g = 0; g < 4; ++g) { const f32x4 w4 = *(const LAS f32x4*)(wint + 32 * tb + 8 * g + 4 * hh);
#pragma unroll
            for (int i = 0; i < 4; ++i) { acc[0][4 * g + i] *= w4[i]; acc[1][4 * g + i] *= w4[i]; } }
        float qn = 0.f;
#pragma unroll
        for (int c4 = 0; c4 < 4; ++c4) { const v4u qv = *(const LAS v4u*)(Qs + (32 * tb + r) * 144 + (32 * hh + 8 * c4) * 2); const f32x4 n0 = *(const LAS f32x4*)(nsl + 32 * hh + 8 * c4), n1 = *(const LAS f32x4*)(nsl + 32 * hh + 8 * c4 + 4);
            qn += hlo(qv.x) * n0[0] + hhi(qv.x) * n0[1] + hlo(qv.y) * n0[2] + hhi(qv.y) * n0[3] + hlo(qv.z) * n1[0] + hhi(qv.z) * n1[1] + hlo(qv.w) * n1[2] + hhi(qv.w) * n1[3]; }
        float den = 0.f; const float M2t = M2[32 * tb + r];
        for (int sb = 0; sb <= tb; ++sb) {
            f32x16m X = {};
#pragma unroll
            for (int kd = 0; kd < 4; ++kd) { const bf16x8 kf = *(const LAS bf16x8*)(Ks + (32 * sb + r) * 144 + (16 * kd + 8 * hh) * 2); X = MFMA_H(kf, qf[kd], X); }
#pragma unroll
            for (int g = 0; g < 4; ++g) { const f32x4 e4 = *(const LAS f32x4*)(e2 + 32 * sb + 8 * g + 4 * hh);
#pragma unroll
                for (int i = 0; i < 4; ++i) { const bool valid = (sb < tb) || (8 * g + 4 * hh + i <= r); const float p = valid ? X[4 * g + i] * __builtin_amdgcn_exp2f(e4[i] - M2t) : 0.f; den += p; X[4 * g + i] = p; } }
#pragma unroll
            for (int ks2 = 0; ks2 < 2; ++ks2) { u32x4m pw; pw.x = pkh2(X[8 * ks2], X[8 * ks2 + 1]); pw.y = pkh2(X[8 * ks2 + 2], X[8 * ks2 + 3]); pw.z = pkh2(X[8 * ks2 + 4], X[8 * ks2 + 5]); pw.w = pkh2(X[8 * ks2 + 6], X[8 * ks2 + 7]);
                const bf16x8 pf = __builtin_bit_cast(bf16x8, pw);
#pragma unroll
                for (int j = 0; j < 2; ++j) { const bf16x8 vf = tr_frag(Vs, 272, 32 * sb + 16 * ks2, 64 * eh + 32 * j, lane, 4, 8); acc[j] = MFMA_H(pf, vf, acc[j]); } }
        }
        { const auto rr = __builtin_amdgcn_permlane32_swap(__float_as_uint(den), __float_as_uint(den), false, false); den = __uint_as_float(rr[0]) + __uint_as_float(rr[1]);
          const auto r2 = __builtin_amdgcn_permlane32_swap(__float_as_uint(qn), __float_as_uint(qn), false, false); qn = __uint_as_float(r2[0]) + __uint_as_float(r2[1]); }
        const float denT = wint[32 * tb + r] * qn + den, invv = 1.f / fmaxf(fabsf(denT), flr[32 * tb + r]);
        if (hh == 0) invw[r] = invv;
        LDS_WAIT();
#pragma unroll
        for (int g = 0; g < 4; ++g) { const f32x4 i4 = *(const LAS f32x4*)(invw + 8 * g + 4 * hh);
#pragma unroll
            for (int i = 0; i < 4; ++i) { acc[0][4 * g + i] *= i4[i]; acc[1][4 * g + i] *= i4[i]; } }
#pragma unroll
        for (int i = 0; i < 4; ++i) { const int idx = tid + 512 * i, t = idx >> 4, ch = idx & 15; pog[i] = *(const v4u*)(P + (size_t)67108864 + (size_t)unit * 16384 + t * 128 + ch * 8); }
        __syncthreads();
#pragma unroll
        for (int j = 0; j < 2; ++j)
#pragma unroll
            for (int reg = 0; reg < 16; ++reg) Hs[(32 * tb + crow_m(reg, hh)) * 132 + 64 * eh + 32 * j + r] = acc[j][reg];
        __syncthreads();
#pragma unroll
        for (int i = 0; i < 4; ++i) { const int idx = tid + 512 * i, t = idx >> 4, ch = idx & 15; const f32x4 h0 = *(const LAS f32x4*)(Hs + t * 132 + ch * 8), h1 = *(const LAS f32x4*)(Hs + t * 132 + ch * 8 + 4);
            const v4u gg = pog[i]; v4u o;
            o.x = pk2(bflo(gg.x) * h0[0], bfhi(gg.x) * h0[1]); o.y = pk2(bflo(gg.y) * h0[2], bfhi(gg.y) * h0[3]); o.z = pk2(bflo(gg.z) * h1[0], bfhi(gg.z) * h1[1]); o.w = pk2(bflo(gg.w) * h1[2], bfhi(gg.w) * h1[3]);
            *(v4u*)(Y + (row0 + t) * 1024 + h * 128 + ch * 8) = o; }
        unit += C.G;
        __syncthreads();
    }
#undef M5_LOAD
}
#ifndef WGM_PROJ
#define WGM_PROJ 2
#endif
#ifndef WGM_OUT
#define WGM_OUT 2
#endif
struct Args { const float* in[17]; float* out; unsigned char* ws; int ph_lo, ph_hi; };
__global__ void __launch_bounds__(NWAVES * 64, 2) fwd_kernel(Args args) {
    extern __shared__ __attribute__((aligned(16))) unsigned char lds[];
    Ctx C;
    C.lds = (LAS unsigned char*)lds; C.ldsg = (char*)lds; C.G = gridDim.x; C.bid = blockIdx.x;
    C.out = args.out; C.ws = args.ws;
    volatile LAS unsigned* MISC = (volatile LAS unsigned*)(C.lds + MISC_OFF);
    gu32* ctl = (gu32*)(C.ws + WS_CTL);
    for (int u = (int)threadIdx.x; u < (LDS_BYTES - LDSCTL_OFF) / 4; u += NWAVES * 64) ((LAS unsigned*)(C.lds + LDSCTL_OFF))[u] = 0u;
    __syncthreads();
    XcdBarrier bar; bar.bar = (unsigned*)(ctl + CW_BAR); bar.x = 0; bar.st = nullptr;
    if (MK_ONE_LAUNCH) bar = xcd_barrier_post((unsigned*)(ctl + CW_BAR), MISC + 8);
#define GRID_BAR() do { if (MK_ONE_LAUNCH) xcd_barrier(bar); } while (0)
    const int lo = args.ph_lo, hi = args.ph_hi;
#ifndef PH_MASK
#define PH_MASK 0xffff
#endif
#define IN(k) (((PH_MASK >> (k)) & 1) && lo <= (k) && (k) < hi)
#define BOTH(k) (IN(k) && IN((k) + 1))
    bf16* XN = (bf16*)(C.ws + WS_XN); bf16* PROJ = (bf16*)(C.ws + WS_PROJ);
    bf16* X1B = (bf16*)C.out;
    bf16* X2B = (bf16*)(C.ws + WS_OB);

    if (IN(0)) { prologue_weights(C); __syncthreads();
        norm_gate_phase<8, false>(C, kin(0), kin(3), ATTN_IN, 1536, kin(2), kin(4), nullptr, XN, (float*)(C.ws + WS_LOGF), nullptr, (float*)(C.ws + WS_RSTD));
        if (BOTH(0)) GRID_BAR(); }
    if (IN(1)) { cumsum_phase(C);
      {
        pg8::Gemm g{XN, (const bf16*)(C.ws + WS_WIN0), M, NPJ, D}; pg8::StaticOrder S; S.init(M, NPJ, C.G, C.bid, WGM_PROJ);
        pg8::EpiProj0 E{PROJ, (const float*)(C.ws + WS_ROPE), C2, (unsigned*)(ctl + CW_NRM), (bf16*)(C.ws + WS_OB + 32 * MiB), (bf16*)(C.ws + WS_OB + 64 * MiB), (const float*)(C.ws + WS_RSTD)};
        pg8::gemm_phase<pg8::EpiProj0, pg8::StaticOrder, true, true>(C.lds + RING_OFF, g, S, E);
        if (BOTH(1)) GRID_BAR(); } }
    if (IN(2)) { attn_tuned_phase(C);
        if (BOTH(2)) GRID_BAR(); }
    if (IN(4)) { pg8::Gemm g{XN, (const bf16*)(C.ws + WS_WOUT0), M, D, D}; pg8::StaticOrder S; S.init(M, D, C.G, C.bid, WGM_OUT);
        pg8::EpiResidF2B E{kin(0), X1B};
        pg8::gemm_phase<pg8::EpiResidF2B, pg8::StaticOrder, true, true>(C.lds + RING_OFF, g, S, E);
        if (BOTH(4)) GRID_BAR(); }
    if (IN(5)) { norm_gate_phase<16, true>(C, X1B, kin(12), ML_IN, 2048, kin(11), kin(13), kin(14), nullptr, (float*)(C.ws + WS_LI), (float*)(C.ws + WS_LF), (float*)(C.ws + WS_RSTD));
        if (BOTH(5)) GRID_BAR(); }
    if (IN(6)) { mlstm_scan_phase(C);
        pg8::Gemm g{X1B, (const bf16*)(C.ws + WS_WIN1), M, NPJ, D}; pg8::StaticOrder S; S.init(M, NPJ, C.G, C.bid, WGM_PROJ);
        pg8::EpiProj1 E{PROJ, (const float*)(C.ws + WS_RSTD)};
        pg8::gemm_phase<pg8::EpiProj1, pg8::StaticOrder, true, true, true>(C.lds + RING_OFF, g, S, E);
        if (BOTH(6)) GRID_BAR(); }
    {
    if (IN(7)) { mlstm_dc_phase(C); if (BOTH(7)) GRID_BAR(); }
    if (IN(8)) {
        mlstm_state_phase(C);
        if (BOTH(8)) GRID_BAR(); }
    if (IN(9)) {
        mlstm_out_phase(C);
        if (BOTH(9)) GRID_BAR(); }
    }
    if (IN(10)) { pg8::Gemm g{XN, (const bf16*)(C.ws + WS_WOUT1), M, D, D}; pg8::StaticOrder S; S.init(M, D, C.G, C.bid, WGM_OUT);
        pg8::EpiResidB2B E{X1B, X2B};
        pg8::gemm_phase<pg8::EpiResidB2B, pg8::StaticOrder, true, true>(C.lds + RING_OFF, g, S, E);
        if (BOTH(10)) GRID_BAR(); }
    if (IN(11)) { final_norm_phase(C, X2B); }
#undef IN
#undef BOTH
}

extern "C" void kernel_launch(void* const* d_in, const int* in_sizes, int n_in, void* d_out, int out_size, void* d_ws, size_t ws_size, hipStream_t stream) {
    static int grid = 0;
    if (grid == 0) {
        if (n_in != 17 || in_sizes[0] != M * D || out_size != M * D || ws_size < WS_END) { fprintf(stderr, "kernel_launch: unexpected shapes (n_in %d, in0 %d, out %d, ws %zu < %zu); nothing launched\n", n_in, n_in > 0 ? in_sizes[0] : -1, out_size, ws_size, (size_t)WS_END); grid = -1; return; }
        int dev = 0, cus = 0, per_cu = 0;
        if (hipGetDevice(&dev) != hipSuccess || hipDeviceGetAttribute(&cus, hipDeviceAttributeMultiprocessorCount, dev) != hipSuccess) { grid = -1; return; }
        if (hipFuncSetAttribute((const void*)fwd_kernel, hipFuncAttributeMaxDynamicSharedMemorySize, LDS_BYTES) != hipSuccess) { fprintf(stderr, "kernel_launch: hipFuncSetAttribute failed\n"); grid = -1; return; }
        if (hipOccupancyMaxActiveBlocksPerMultiprocessor(&per_cu, (const void*)fwd_kernel, NWAVES * 64, LDS_BYTES) != hipSuccess || per_cu < 1) fprintf(stderr, "kernel_launch: occupancy query reports %d\n", per_cu);
        (void)hipGetLastError();
        grid = cus;
    }
    if (grid < 0) return;
    if (hipMemsetAsync((char*)d_ws + WS_CTL, 0, CTL_ZERO_BYTES, stream) != hipSuccess) return;
    Args a{};
    for (int i = 0; i < 17; ++i) a.in[i] = (const float*)d_in[i];
    a.out = (float*)d_out; a.ws = (unsigned char*)d_ws;
    if (MK_ONE_LAUNCH) { a.ph_lo = 0; a.ph_hi = NPHASE; hipLaunchKernelGGL(fwd_kernel, dim3(grid), dim3(NWAVES * 64), LDS_BYTES, stream, a); }
    else for (int p = 0; p < NPHASE; ++p) { a.ph_lo = p; a.ph_hi = p + 1; hipLaunchKernelGGL(fwd_kernel, dim3(grid), dim3(NWAVES * 64), LDS_BYTES, stream, a); }
}
```

```cpp
#include <hip/hip_runtime.h>
#include <cstdio>
#include <cstdint>
namespace pg8 {
#define PG8_LAS __attribute__((address_space(3)))
typedef unsigned short bf16_t;
typedef short bf16x8 __attribute__((ext_vector_type(8)));
typedef float f32x4 __attribute__((ext_vector_type(4)));
typedef unsigned u32x4 __attribute__((ext_vector_type(4)));
constexpr int BM = 256, BK = 64, HALF = 128, HTB = HALF * BK * 2  , STAGE_BYTES = 8 * HTB, NXCD = 8, WGM = 2;

__host__ __device__ __forceinline__ int lds_byte(int r, int c) { const int st = (r >> 4) * 2 + (c >> 5), rr = r & 15, cc = c & 31, ob = rr * 64 + cc * 2; return st * 1024 + (ob ^ (((ob >> 9) & 1) << 5)); }
__host__ __device__ __forceinline__ void stage_rc(int b, int& R, int& C) { const int st = b / 1024, sb = b % 1024, swz = sb ^ (((sb >> 9) & 1) << 5); R = (st >> 1) * 16 + swz / 64; C = (st & 1) * 32 + (swz % 64) / 2; }
__host__ __device__ __forceinline__ int perm32(int rho) { const int n = rho >> 4, i = rho & 15; return 8 * (i >> 2) + 4 * n + (i & 3); }

struct Unit { int pm, pn; };
struct Gemm { const bf16_t* A; const bf16_t* Bt; int M, N, K; };

struct StaticOrder {
    int nM, nN, nwg, G, c, wgm;
    __host__ __device__ void init(int M, int N, int G_, int c_, int wgm_ = WGM) { nM = M / BM; nN = N / BM; nwg = nM * nN; G = G_; c = c_; wgm = wgm_; }
    __host__ __device__ bool next(int i, Unit& u) const {
        const long L = (long)i * G + c; if (L >= nwg) return false;
        int wgid = (int)L; { const int q = nwg / NXCD, r = nwg % NXCD, xcd = wgid % NXCD, off = wgid / NXCD; wgid = (xcd < r ? xcd * (q + 1) : r * (q + 1) + (xcd - r) * q) + off; }
        const int nig = wgm * nN, gid = wgid / nig, fm = gid * wgm, gsz = (nM - fm) < wgm ? (nM - fm) : wgm;
        u.pm = fm + ((wgid % nig) % gsz); u.pn = (wgid % nig) / gsz; return true;
    }
    __device__ __forceinline__ void a_ready(const Unit&) const {}
    __device__ __forceinline__ void done(const Unit&) const {}
};

__device__ __forceinline__ unsigned cvt_pk_bf16(float lo, float hi) { unsigned r; asm volatile("v_cvt_pk_bf16_f32 %0, %1, %2" : "=v"(r) : "v"(lo), "v"(hi)); return r; }
typedef float f32x2 __attribute__((ext_vector_type(2)));
__device__ __forceinline__ f32x2 gelu_pk(f32x2 v) {
    const f32x2 av = __builtin_elementwise_abs(v), d = av * 0.2316418882f + 1.0f;
    f32x2 t; t.x = __builtin_amdgcn_rcpf(d.x); t.y = __builtin_amdgcn_rcpf(d.y);
    f32x2 q = t * 0.5307027145f + (-0.7265760135f); q = q * t + 0.7107068705f; q = q * t + (-0.142248368f); q = q * t + 0.127414796f; q = q * t;
    const f32x2 s = (v * v) * (-0.72134752044f);
    f32x2 e; e.x = __builtin_amdgcn_exp2f(s.x); e.y = __builtin_amdgcn_exp2f(s.y);
    const f32x2 m = v * (q * e), r = v - m;
    f32x2 o; o.x = v.x < 0.f ? m.x : r.x; o.y = v.y < 0.f ? m.y : r.y; return o;
}

struct EpiProj0 {
    static constexpr bool PERM = true, AFTER_DRAIN = false;
    bf16_t* O; const float* rope; float c2; unsigned* nrm; bf16_t* KT; bf16_t* VT; const float* rstd;
    __device__ __forceinline__ void operator()(const f32x4 (&acc)[2][2][4][2], const Unit& u, int wr, int wc, int fr, int fq) const {
        const int row0 = u.pm * BM + wr * 64 + fr, col0 = u.pn * BM + wc * 32 + 8 * fq, pn = u.pn;
        const bool do_rope = (pn >= 6 && pn <= 9);
        const float sc = (pn <= 1 || pn == 6 || pn == 7) ? c2 : 1.f;
        const int i0 = 16 * (wc & 1) + 4 * fq;
        if (pn < 4 || (pn >= 6 && pn <= 9)) {
            float mx[2] = {0.f, 0.f};
#pragma unroll
            for (int ai = 0; ai < 2; ++ai)
#pragma unroll
                for (int m = 0; m < 4; ++m) { const float scr = sc * rstd[row0 + ai * HALF + m * 16];
#pragma unroll
                    for (int bj = 0; bj < 2; ++bj) { const f32x4 a = acc[ai][bj][m][0] * scr, b = acc[ai][bj][m][1] * scr;
                        float ss = (a[0] * a[0] + a[1] * a[1]) + (a[2] * a[2] + a[3] * a[3]) + (b[0] * b[0] + b[1] * b[1]) + (b[2] * b[2] + b[3] * b[3]);
                        ss += __shfl_xor(ss, 16); ss += __shfl_xor(ss, 32); mx[bj] = fmaxf(mx[bj], ss); } }
#pragma unroll
            for (int bj = 0; bj < 2; ++bj) { float v = mx[bj];
#pragma unroll
                for (int o = 1; o < 16; o <<= 1) v = fmaxf(v, __shfl_xor(v, o));
                if (fr == 0 && fq == 0) { const int dif = pn >= 6 ? 1 : 0, isk = (dif ? pn - 6 : pn) >> 1, b = u.pm >> 6, head = (pn & 1) * 4 + 2 * bj + (wc >> 1), half = wc & 1;
                    __hip_atomic_fetch_max(nrm + dif * 64 + ((isk * 2 + b) * 8 + head) * 2 + half, __builtin_bit_cast(unsigned, v), __ATOMIC_RELAXED, __HIP_MEMORY_SCOPE_AGENT); } }
        }
#pragma unroll
        for (int ai = 0; ai < 2; ++ai)
#pragma unroll
            for (int m = 0; m < 4; ++m) { const int row = row0 + ai * HALF + m * 16; const float scr = sc * rstd[row];
                f32x4 cs0 = {1.f, 0.f, 1.f, 0.f}, cs1 = {1.f, 0.f, 1.f, 0.f};
                if (do_rope) { const f32x4* rp = (const f32x4*)(rope + (size_t)row * 64 + 2 * i0); cs0 = rp[0]; cs1 = rp[1]; }
                const f32x4 c = {cs0[0], cs0[2], cs1[0], cs1[2]}, s = {cs0[1], cs0[3], cs1[1], cs1[3]};
#pragma unroll
                for (int bj = 0; bj < 2; ++bj) { f32x4 v0 = acc[ai][bj][m][0], v1 = acc[ai][bj][m][1];
                    if (do_rope) { const f32x4 o0 = v0 * c - v1 * s, o1 = v0 * s + v1 * c; v0 = o0; v1 = o1; }
                    v0 = v0 * scr; v1 = v1 * scr; u32x4 w; w.x = cvt_pk_bf16(v0[0], v0[1]); w.y = cvt_pk_bf16(v0[2], v0[3]); w.z = cvt_pk_bf16(v1[0], v1[1]); w.w = cvt_pk_bf16(v1[2], v1[3]);
                    if (pn >= 8 && pn <= 11) { const int col = col0 + bj * HALF, b = row >> 14, tile = (row & 16383) >> 6, rin = row & 63;
                        if (pn <= 9) { const int cl = col - 2048, grp = cl >> 6, chunk = (cl & 63) >> 3; *(u32x4*)(KT + ((size_t)((b * 8 + grp) * 256 + tile) * 4096 + chunk * 512 + rin * 8)) = w; }
                        else { const int cl = col - 2560, hd = cl >> 7, dblk = (cl & 127) >> 5, cw = cl & 31; *(u32x4*)(VT + ((size_t)((b * 4 + hd) * 256 + tile) * 8192 + dblk * 2048 + rin * 32 + cw)) = w; } }
                    else *(u32x4*)(O + (size_t)row * 4096 + col0 + bj * HALF) = w; } }
    }
};
typedef _Float16 h2e __attribute__((ext_vector_type(2)));
__device__ __forceinline__ float hf_lo(unsigned w) { return (float)__builtin_bit_cast(h2e, w)[0]; }
__device__ __forceinline__ float hf_hi(unsigned w) { return (float)__builtin_bit_cast(h2e, w)[1]; }
__device__ __forceinline__ unsigned cvt_pk_f16(float lo, float hi) { const f32x2 v = {lo, hi}; return __builtin_bit_cast(unsigned, __builtin_convertvector(v, h2e)); }
struct EpiProj1 {
    static constexpr bool PERM = true, AFTER_DRAIN = false;
    bf16_t* O; const float* rstd;
    __device__ __forceinline__ void operator()(const f32x4 (&acc)[2][2][4][2], const Unit& u, int wr, int wc, int fr, int fq) const {
        const int row0 = u.pm * BM + wr * 64 + fr, col0 = u.pn * BM + wc * 32 + 8 * fq, pn = u.pn;
        const float sc0 = (pn == 2 || pn == 3) ? 0.125f : 1.f;
#pragma unroll
        for (int ai = 0; ai < 2; ++ai)
#pragma unroll
            for (int m = 0; m < 4; ++m) { const int row = row0 + ai * HALF + m * 16; const float sc = sc0 * rstd[row];
                const int b = row >> 14, chunk = (row & 16383) >> 7, rin = row & 127;
#pragma unroll
                for (int bj = 0; bj < 2; ++bj) { const f32x4 v0 = acc[ai][bj][m][0] * sc, v1 = acc[ai][bj][m][1] * sc; const int col = col0 + bj * HALF;
                    if (pn < 8) { u32x4 w; w.x = cvt_pk_f16(v0[0], v0[1]); w.y = cvt_pk_f16(v0[2], v0[3]); w.z = cvt_pk_f16(v1[0], v1[1]); w.w = cvt_pk_f16(v1[2], v1[3]);
                        if (pn < 4) { const int cl = col & 511, head = cl >> 6, d = cl & 63; *(u32x4*)(O + (size_t)(pn >> 1) * 16777216 + ((size_t)((b * 8 + head) * 128 + chunk) * 128 + rin) * 64 + d) = w; }
                        else { const int cl = col - 1024, head = cl >> 7, ev = cl & 127; *(u32x4*)(O + (size_t)33554432 + ((size_t)((b * 8 + head) * 128 + chunk) * 128 + rin) * 128 + ev) = w; } }
                    else {
                        const float g0 = v0[1] * __builtin_amdgcn_rcpf((1.f + __expf(-v0[0])) * (1.f + __expf(-v0[1]))), g1 = v0[3] * __builtin_amdgcn_rcpf((1.f + __expf(-v0[2])) * (1.f + __expf(-v0[3])));
                        const float g2 = v1[1] * __builtin_amdgcn_rcpf((1.f + __expf(-v1[0])) * (1.f + __expf(-v1[1]))), g3 = v1[3] * __builtin_amdgcn_rcpf((1.f + __expf(-v1[2])) * (1.f + __expf(-v1[3])));
                        typedef unsigned u32x2e __attribute__((ext_vector_type(2))); u32x2e gw; gw.x = cvt_pk_bf16(g0, g1); gw.y = cvt_pk_bf16(g2, g3);
                        const int jg = (col - 2048) >> 1, head = jg >> 7, ev = jg & 127;
                        *(u32x2e*)(O + (size_t)67108864 + ((size_t)((b * 8 + head) * 128 + chunk) * 128 + rin) * 128 + ev) = gw; } } }
    }
};
struct EpiResidF2B {
    static constexpr bool PERM = true, AFTER_DRAIN = false;
    const float* base; bf16_t* out;
    __device__ __forceinline__ void operator()(const f32x4 (&acc)[2][2][4][2], const Unit& u, int wr, int wc, int fr, int fq) const {
        const int row0 = u.pm * BM + wr * 64 + fr, col0 = u.pn * BM + wc * 32 + 8 * fq;
#pragma unroll
        for (int ai = 0; ai < 2; ++ai)
#pragma unroll
            for (int m = 0; m < 4; ++m) { const size_t p = (size_t)(row0 + ai * HALF + m * 16) * 1024 + col0;
#pragma unroll
                for (int bj = 0; bj < 2; ++bj) { const f32x4 v0 = *(const f32x4*)(base + p + bj * HALF) + acc[ai][bj][m][0], v1 = *(const f32x4*)(base + p + bj * HALF + 4) + acc[ai][bj][m][1];
                    u32x4 w; w.x = cvt_pk_f16(v0[0], v0[1]); w.y = cvt_pk_f16(v0[2], v0[3]); w.z = cvt_pk_f16(v1[0], v1[1]); w.w = cvt_pk_f16(v1[2], v1[3]);
                    *(u32x4*)(out + p + bj * HALF) = w; } }
    }
};
struct EpiResidB2B {
    static constexpr bool PERM = true, AFTER_DRAIN = false;
    const bf16_t* base; bf16_t* out;
    __device__ __forceinline__ void operator()(const f32x4 (&acc)[2][2][4][2], const Unit& u, int wr, int wc, int fr, int fq) const {
        const int row0 = u.pm * BM + wr * 64 + fr, col0 = u.pn * BM + wc * 32 + 8 * fq;
#pragma unroll
        for (int ai = 0; ai < 2; ++ai)
#pragma unroll
            for (int m = 0; m < 4; ++m) { const size_t p = (size_t)(row0 + ai * HALF + m * 16) * 1024 + col0;
#pragma unroll
                for (int bj = 0; bj < 2; ++bj) { const u32x4 b = *(const u32x4*)(base + p + bj * HALF);
                    const f32x4 b0 = {hf_lo(b.x), hf_hi(b.x), hf_lo(b.y), hf_hi(b.y)}, b1 = {hf_lo(b.z), hf_hi(b.z), hf_lo(b.w), hf_hi(b.w)};
                    const f32x4 v0 = b0 + acc[ai][bj][m][0], v1 = b1 + acc[ai][bj][m][1];
                    u32x4 w; w.x = cvt_pk_f16(v0[0], v0[1]); w.y = cvt_pk_f16(v0[2], v0[3]); w.z = cvt_pk_f16(v1[0], v1[1]); w.w = cvt_pk_f16(v1[2], v1[3]);
                    *(u32x4*)(out + p + bj * HALF) = w; } }
    }
};

typedef _Float16 h8g __attribute__((ext_vector_type(8)));
template <class Epi, class Sched, bool ALIGN_EPI = false, bool SP2 = false, bool F16 = false>
__device__ __forceinline__ void gemm_phase(PG8_LAS unsigned char* lds, const Gemm g, const Sched& S, const Epi& E) {
    const int tid = threadIdx.x, wid = __builtin_amdgcn_readfirstlane(tid >> 6), lane = tid & 63, wr = wid >> 2, wc = wid & 3, fr = lane & 15, fq = lane >> 4;
    const int K = g.K, nt = K / BK;
    unsigned voffA[2], voffB[2];
#pragma unroll
    for (int i = 0; i < 2; ++i) { int R, C; stage_rc(tid * 16 + i * 8192, R, C); const int Rb = Epi::PERM ? ((R & ~31) + perm32(R & 31)) : R;
        voffA[i] = (unsigned)(R * K + C) * 2u; voffB[i] = (unsigned)(Rb * K + C) * 2u; }
    const size_t kstep = (size_t)(BK * 2);
    const size_t hstep = (size_t)HALF * K * 2;
    const size_t tstep = 2 * hstep;
    const unsigned ldsw = (unsigned)wid * 1024u;
    const int aoff = lds_byte(wr * 64 + fr, fq * 8), boff = lds_byte(wc * 32 + fr, fq * 8);
#define PG8_SA(b, h) (((b) * 2 + (h)) * HTB)
#define PG8_SB(b, h) ((4 + (b) * 2 + (h)) * HTB)
#define PG8_STAGE(bufoff, gbase, voff) do { _Pragma("unroll") for (int _i = 0; _i < 2; ++_i) \
        __builtin_amdgcn_global_load_lds((const unsigned*)((const char*)(gbase) + (voff)[_i]), (PG8_LAS unsigned*)(lds + (bufoff) + ldsw + _i * 8192), 16, 0, 0); } while (0)
#define PG8_LDA(dst, b, h) do { _Pragma("unroll") for (int m = 0; m < 4; ++m) _Pragma("unroll") for (int k = 0; k < 2; ++k) dst[m][k] = *(const PG8_LAS bf16x8*)(lds + PG8_SA(b, h) + aoff + m * 2048 + k * 1024); } while (0)
#define PG8_LDB(dst, b, h) do { _Pragma("unroll") for (int n = 0; n < 2; ++n) _Pragma("unroll") for (int k = 0; k < 2; ++k) dst[n][k] = *(const PG8_LAS bf16x8*)(lds + PG8_SB(b, h) + boff + n * 2048 + k * 1024); } while (0)
#define PG8_MMA(ai, bj, At, Bt) do { __builtin_amdgcn_s_setprio(1); _Pragma("unroll") for (int m = 0; m < 4; ++m) _Pragma("unroll") for (int n = 0; n < 2; ++n) _Pragma("unroll") for (int k = 0; k < 2; ++k) \
        acc[ai][bj][m][n] = F16 ? __builtin_amdgcn_mfma_f32_16x16x32_f16(__builtin_bit_cast(h8g, Bt[n][k]), __builtin_bit_cast(h8g, At[m][k]), acc[ai][bj][m][n], 0, 0, 0) : __builtin_amdgcn_mfma_f32_16x16x32_bf16(Bt[n][k], At[m][k], acc[ai][bj][m][n], 0, 0, 0); __builtin_amdgcn_s_setprio(0); } while (0)
#define PG8_WAIT_V(n) asm volatile("s_waitcnt vmcnt(" #n ")" ::: "memory")
#define PG8_WAIT_L(n) asm volatile("s_waitcnt lgkmcnt(" #n ")" ::: "memory")
#define PG8_BAR __builtin_amdgcn_s_barrier()
#define PG8_SCHED __builtin_amdgcn_sched_barrier(0)
    Unit cur, nxt; int ui = 0;
    if (!S.next(0, cur)) return;
    f32x4 acc[2][2][4][2];
#pragma unroll
    for (int a = 0; a < 2; ++a)
#pragma unroll
        for (int b = 0; b < 2; ++b)
#pragma unroll
            for (int m = 0; m < 4; ++m)
#pragma unroll
                for (int n = 0; n < 2; ++n) acc[a][b][m][n] = (f32x4){0.f, 0.f, 0.f, 0.f};
    bf16x8 At[4][2], B0[2][2], B1[2][2];
    const char* cA = (const char*)g.A + (size_t)cur.pm * tstep; const char* cB = (const char*)g.Bt + (size_t)cur.pn * tstep;
    S.a_ready(cur);
    if constexpr (SP2) {
        PG8_STAGE(PG8_SB(0, 0), cB, voffB); PG8_STAGE(PG8_SB(0, 1), cB + hstep, voffB); PG8_STAGE(PG8_SA(0, 0), cA, voffA); PG8_STAGE(PG8_SA(0, 1), cA + hstep, voffA);
        if (wr == 1) PG8_BAR;
        PG8_WAIT_V(2); PG8_BAR;
        PG8_STAGE(PG8_SB(1, 0), cB + kstep, voffB); PG8_STAGE(PG8_SA(1, 0), cA + kstep, voffA); PG8_STAGE(PG8_SB(1, 1), cB + hstep + kstep, voffB);
        PG8_WAIT_V(6); PG8_BAR;
    } else {
        PG8_STAGE(PG8_SB(0, 0), cB, voffB); PG8_STAGE(PG8_SA(0, 0), cA, voffA); PG8_STAGE(PG8_SB(0, 1), cB + hstep, voffB); PG8_STAGE(PG8_SA(0, 1), cA + hstep, voffA);
        if (wr == 1) PG8_BAR;
        PG8_WAIT_V(4); PG8_BAR;
        PG8_STAGE(PG8_SB(1, 0), cB + kstep, voffB); PG8_STAGE(PG8_SA(1, 0), cA + kstep, voffA); PG8_STAGE(PG8_SB(1, 1), cB + hstep + kstep, voffB);
        PG8_WAIT_V(6); PG8_BAR;
    }
    for (;;) {
        const bool has_next = S.next(ui + 1, nxt);
        const char* nA = has_next ? (const char*)g.A + (size_t)nxt.pm * tstep : cA; const char* nB = has_next ? (const char*)g.Bt + (size_t)nxt.pn * tstep : cB;
        for (int t = 0; t < nt; t += 2) {
            const bool last = (t == nt - 2);
            const char* a1 = cA + (size_t)(t + 1) * kstep;
            const char* a2 = last ? nA : cA + (size_t)(t + 2) * kstep; const char* b2 = last ? nB : cB + (size_t)(t + 2) * kstep;
            const char* a3 = a2 + kstep; const char* b3 = b2 + kstep;
            if (last && has_next) S.a_ready(nxt);
            if constexpr (SP2) {
            PG8_LDB(B0, 0, 0); PG8_LDB(B1, 0, 1); PG8_SCHED; PG8_LDA(At, 0, 0); PG8_STAGE(PG8_SA(1, 1), a1 + hstep, voffA);
            PG8_WAIT_V(8); PG8_WAIT_L(0); PG8_BAR; PG8_MMA(0, 0, At, B0); PG8_MMA(0, 1, At, B1); PG8_BAR; PG8_SCHED;
            PG8_LDA(At, 0, 1); PG8_STAGE(PG8_SB(0, 0), b2, voffB); PG8_STAGE(PG8_SB(0, 1), b2 + hstep, voffB); PG8_STAGE(PG8_SA(0, 0), a2, voffA);
            PG8_WAIT_V(8); PG8_WAIT_L(0); PG8_BAR; PG8_MMA(1, 0, At, B0); PG8_MMA(1, 1, At, B1); PG8_BAR; PG8_SCHED;
            PG8_LDB(B0, 1, 0); PG8_LDB(B1, 1, 1); PG8_SCHED; PG8_LDA(At, 1, 0); PG8_STAGE(PG8_SA(0, 1), a2 + hstep, voffA);
            PG8_WAIT_V(8); PG8_WAIT_L(0); PG8_BAR; PG8_MMA(0, 0, At, B0); PG8_MMA(0, 1, At, B1); PG8_BAR; PG8_SCHED;
            PG8_LDA(At, 1, 1); PG8_STAGE(PG8_SB(1, 0), b3, voffB); PG8_STAGE(PG8_SB(1, 1), b3 + hstep, voffB); PG8_STAGE(PG8_SA(1, 0), a3, voffA);
            PG8_WAIT_V(8); PG8_WAIT_L(0); PG8_BAR; PG8_MMA(1, 0, At, B0); PG8_MMA(1, 1, At, B1); PG8_BAR; PG8_SCHED;
            } else {
            PG8_LDB(B0, 0, 0); PG8_SCHED; PG8_LDA(At, 0, 0); PG8_STAGE(PG8_SA(1, 1), a1 + hstep, voffA);
            PG8_WAIT_L(8); PG8_BAR; PG8_WAIT_L(0); PG8_MMA(0, 0, At, B0); PG8_BAR; PG8_SCHED;
            PG8_LDB(B1, 0, 1); PG8_STAGE(PG8_SB(0, 0), b2, voffB);
            PG8_BAR; PG8_WAIT_L(0); PG8_MMA(0, 1, At, B1); PG8_BAR;
            PG8_LDA(At, 0, 1); PG8_STAGE(PG8_SA(0, 0), a2, voffA);
            PG8_BAR; PG8_WAIT_L(0); PG8_MMA(1, 0, At, B0); PG8_BAR; PG8_SCHED;
            PG8_STAGE(PG8_SB(0, 1), b2 + hstep, voffB);
            PG8_WAIT_V(6); PG8_BAR; PG8_MMA(1, 1, At, B1); PG8_BAR;
            PG8_LDB(B0, 1, 0); PG8_SCHED; PG8_LDA(At, 1, 0); PG8_STAGE(PG8_SA(0, 1), a2 + hstep, voffA);
            PG8_WAIT_L(8); PG8_BAR; PG8_WAIT_L(0); PG8_MMA(0, 0, At, B0); PG8_BAR; PG8_SCHED;
            PG8_LDB(B1, 1, 1); PG8_STAGE(PG8_SB(1, 0), b3, voffB);
            PG8_BAR; PG8_WAIT_L(0); PG8_MMA(0, 1, At, B1); PG8_BAR;
            PG8_LDA(At, 1, 1); PG8_STAGE(PG8_SA(1, 0), a3, voffA);
            PG8_BAR; PG8_WAIT_L(0); PG8_MMA(1, 0, At, B0); PG8_BAR; PG8_SCHED;
            PG8_STAGE(PG8_SB(1, 1), b3 + hstep, voffB);
            PG8_WAIT_V(6); PG8_BAR; PG8_MMA(1, 1, At, B1); PG8_BAR;
            }
        }
        if constexpr (ALIGN_EPI) { if (wr == 0) PG8_BAR; }
        if constexpr (!Epi::AFTER_DRAIN) { E(acc, cur, wr, wc, fr, fq); S.done(cur); }
        if (!has_next) break;
#pragma unroll
        for (int a = 0; a < 2; ++a)
#pragma unroll
            for (int b = 0; b < 2; ++b)
#pragma unroll
                for (int m = 0; m < 4; ++m)
#pragma unroll
                    for (int n = 0; n < 2; ++n) acc[a][b][m][n] = (f32x4){0.f, 0.f, 0.f, 0.f};
        cur = nxt; cA = nA; cB = nB; ++ui;
        if constexpr (ALIGN_EPI) { if (wr == 1) PG8_BAR; }
    }
    PG8_WAIT_V(0);
    if constexpr (!ALIGN_EPI) { if (wr == 0) PG8_BAR; }
    PG8_BAR;
    if constexpr (Epi::AFTER_DRAIN) { E.fused(acc, cur, wr, wc, fr, fq, lds, wid, lane); S.done(cur); }
#undef PG8_SA
#undef PG8_SB
#undef PG8_STAGE
#undef PG8_LDA
#undef PG8_LDB
#undef PG8_MMA
#undef PG8_WAIT_V
#undef PG8_WAIT_L
#undef PG8_BAR
#undef PG8_SCHED
}
}
#include <hip/hip_bf16.h>
#include <cmath>
namespace attn_body {
using bf16=__hip_bfloat16;
using bf16x8=__attribute__((ext_vector_type(8)))short;
using s16x4=__attribute__((ext_vector_type(4)))short;
using f32x16=__attribute__((ext_vector_type(16)))float;
using u32x4=__attribute__((ext_vector_type(4)))unsigned;
constexpr int SEQ=16384,D=64,DM=4096,OPITCH=1536;
constexpr int NW=8,QBLK=32,QB=QBLK*NW,KVBLK=64,NQB=SEQ/QB;
#define LAS3 __attribute__((address_space(3)))
__device__ __forceinline__ int crow(int r,int hi){return (r&3)+8*(r>>2)+4*hi;}
#define SBAR() __builtin_amdgcn_sched_barrier(0)
__device__ __forceinline__ void cmask(f32x16&p0,f32x16&p1,int jb,int qrel,int hi){
  const float NEG=-INFINITY; int kb=64*jb+4*hi;
  #pragma unroll
  for(int r=0;r<16;++r){int kv=kb+(r&3)+8*(r>>2); if(kv>qrel)p0[r]=NEG; if(kv+32>qrel)p1[r]=NEG;}
}

constexpr int NSLOT=3, SLOTB=8192;
constexpr int LDS_K=0, LDS_V=NSLOT*SLOTB, LDS_WS=2*NSLOT*SLOTB, LDS_OST=LDS_WS+NW*64*4, LDS_KE=LDS_OST+NW*4096, LDS_BYTES=LDS_KE+4*1024;
constexpr float C2=0.125f*1.4426950408889634f;
__device__ __forceinline__ void glds16(const void*gsrc,unsigned lds_dst){unsigned keep;
  asm volatile("s_mov_b32 %0, m0\n\ts_mov_b32 m0, %2\n\ts_nop 0\n\tglobal_load_lds_dwordx4 %1, off\n\ts_mov_b32 m0, %0":"=&s"(keep):"v"(gsrc),"s"(lds_dst):"memory");}
__device__ __forceinline__ float max3f(float a,float b,float c){float r;asm("v_max3_f32 %0, %1, %2, %3":"=v"(r):"v"(a),"v"(b),"v"(c));return r;}
__device__ __forceinline__ float max2f(float a,float b){float r;asm("v_max_f32_e32 %0, %1, %2":"=v"(r):"v"(a),"v"(b));return r;}
__device__ __forceinline__ float fadd_s(float a,float b){float r;asm("v_add_f32_e32 %0, %1, %2":"=v"(r):"v"(a),"v"(b));return r;}
__device__ __forceinline__ float fsub_s(float a,float b){float r;asm("v_sub_f32_e32 %0, %1, %2":"=v"(r):"v"(a),"v"(b));return r;}
typedef float f32x2_t __attribute__((ext_vector_type(2))); typedef __bf16 bf16x2_t __attribute__((ext_vector_type(2)));
__device__ __forceinline__ unsigned cvtpk_s(float lo,float hi){f32x2_t v={lo,hi};bf16x2_t b=__builtin_convertvector(v,bf16x2_t);return __builtin_bit_cast(unsigned,b);}
#define WAIT_BAR(N) asm volatile("s_waitcnt vmcnt(" #N ") lgkmcnt(0)\n\ts_barrier":::"memory")

__device__ __forceinline__ void qkt(f32x16&p0,f32x16&p1,const char*Kslot,const bf16x8*qr,const f32x16&negm,int r32,int hi){
  const char*kb=Kslot+hi*1024+r32*16;
  #pragma unroll
  for(int d0=0;d0<4;++d0){
    const bf16x8 b0=*reinterpret_cast<const bf16x8*>(kb+d0*2048);
    const bf16x8 b1=*reinterpret_cast<const bf16x8*>(kb+d0*2048+512);
    if(d0==0){p0=__builtin_amdgcn_mfma_f32_32x32x16_bf16(b0,qr[0],negm,0,0,0);p1=__builtin_amdgcn_mfma_f32_32x32x16_bf16(b1,qr[0],negm,0,0,0);}
    else{p0=__builtin_amdgcn_mfma_f32_32x32x16_bf16(b0,qr[d0],p0,0,0,0);p1=__builtin_amdgcn_mfma_f32_32x32x16_bf16(b1,qr[d0],p1,0,0,0);}}
}
typedef __attribute__((address_space(3))) const char* lds_cptr;
typedef short v4i16_t __attribute__((ext_vector_type(4)));
__device__ __forceinline__ void kload8(bf16x8*kf,lds_cptr kp){
  kf[0]=*(const __attribute__((address_space(3))) bf16x8*)(kp);      kf[1]=*(const __attribute__((address_space(3))) bf16x8*)(kp+512);
  kf[2]=*(const __attribute__((address_space(3))) bf16x8*)(kp+2048); kf[3]=*(const __attribute__((address_space(3))) bf16x8*)(kp+2560);
  kf[4]=*(const __attribute__((address_space(3))) bf16x8*)(kp+4096); kf[5]=*(const __attribute__((address_space(3))) bf16x8*)(kp+4608);
  kf[6]=*(const __attribute__((address_space(3))) bf16x8*)(kp+6144); kf[7]=*(const __attribute__((address_space(3))) bf16x8*)(kp+6656);
}
__device__ __forceinline__ void kload2(bf16x8*kf,lds_cptr kp,int j){ kf[2*j]=*(const __attribute__((address_space(3))) bf16x8*)(kp+j*2048); kf[2*j+1]=*(const __attribute__((address_space(3))) bf16x8*)(kp+j*2048+512); }
__device__ __forceinline__ s16x4 vtr(lds_cptr p){ return __builtin_bit_cast(s16x4,__builtin_amdgcn_ds_read_tr16_b64_v4i16((__attribute__((address_space(3))) v4i16_t*)p)); }
__device__ __forceinline__ float rowmax(const f32x16&p0,const f32x16&p1){
  float a=max3f(p0[0],p0[1],p1[0]),b=max3f(p0[2],p0[3],p1[1]);a=max3f(a,p1[2],p1[3]);
  #pragma unroll
  for(int r=4;r<16;r+=4){a=max3f(a,p0[r],p0[r+1]);b=max3f(b,p0[r+2],p0[r+3]);a=max3f(a,p1[r],p1[r+1]);b=max3f(b,p1[r+2],p1[r+3]);}
  const float m=max2f(a,b);
  auto rr=__builtin_amdgcn_permlane32_swap(__float_as_uint(m),__float_as_uint(m),false,false);
  return max2f(__uint_as_float(rr[0]),__uint_as_float(rr[1]));
}
__device__ __forceinline__ void pv(f32x16*o,int vb,bf16x8 pa0,bf16x8 pa1,bf16x8 pa2,bf16x8 pa3){
  #pragma unroll
  for(int d0=0;d0<2;++d0){s16x4 lo[4],hi[4];
    #pragma unroll
    for(int ks=0;ks<4;++ks){
      asm volatile("ds_read_b64_tr_b16 %0,%1 offset:%c2":"=&v"(lo[ks]):"v"(vb),"i"(d0*4096+ks*1024):"memory");
      asm volatile("ds_read_b64_tr_b16 %0,%1 offset:%c2":"=&v"(hi[ks]):"v"(vb),"i"(d0*4096+ks*1024+512):"memory");}
    asm volatile("s_waitcnt lgkmcnt(0)":::"memory");SBAR();
    #define PK(k) (bf16x8){lo[k][0],lo[k][1],lo[k][2],lo[k][3],hi[k][0],hi[k][1],hi[k][2],hi[k][3]}
    o[d0]=__builtin_amdgcn_mfma_f32_32x32x16_bf16(pa0,PK(0),o[d0],0,0,0);
    o[d0]=__builtin_amdgcn_mfma_f32_32x32x16_bf16(pa1,PK(1),o[d0],0,0,0);
    o[d0]=__builtin_amdgcn_mfma_f32_32x32x16_bf16(pa2,PK(2),o[d0],0,0,0);
    o[d0]=__builtin_amdgcn_mfma_f32_32x32x16_bf16(pa3,PK(3),o[d0],0,0,0);
    #undef PK
  }
}

__device__ __forceinline__ unsigned bf_rne(float f){ unsigned u=__float_as_uint(f); return (u+0x7fffu+((u>>16)&1u))>>16; }
__device__ __forceinline__ bf16x8 make_qre(float a,int hi){
  const unsigned h0=bf_rne(a); const float r1=a-__uint_as_float(h0<<16); const unsigned h1=bf_rne(r1); const float r2=r1-__uint_as_float(h1<<16); const unsigned h2=bf_rne(r2);
  u32x4 w; w.x=hi?0u:(h0|(h1<<16)); w.y=hi?0u:(h2|(0x3F80u<<16)); w.z=hi?0u:(0x3F80u|(0x3F80u<<16)); w.w=0u; return __builtin_bit_cast(bf16x8,w); }
constexpr int ATTN_LDS_BYTES=LDS_BYTES;
#undef SBAR
#undef WAIT_BAR
}
namespace attn256 {
using attn_body::bf16; using attn_body::bf16x8; using attn_body::s16x4; using attn_body::f32x16; using attn_body::u32x4; using attn_body::lds_cptr;
using attn_body::glds16; using attn_body::fadd_s; using attn_body::fsub_s; using attn_body::cvtpk_s; using attn_body::vtr; using attn_body::crow; using attn_body::max3f; using attn_body::max2f;
constexpr int SEQ=16384,DM=4096,OPITCH=512,QBU=256,KVBLK=64;
constexpr int KSLOT=8192,VSLOT=16384;
constexpr int LDS_K=0,LDS_V=4*KSLOT,LDS_WS=LDS_V+4*VSLOT,LDS_KE=LDS_WS+2048,LDS_BYTES=LDS_KE+4096;
#define SBAR() __builtin_amdgcn_sched_barrier(0)
#define WAIT_BAR(N) asm volatile("s_waitcnt vmcnt(" #N ") lgkmcnt(0)\n\ts_barrier":::"memory")
#define LAS3 __attribute__((address_space(3)))
__device__ __forceinline__ void wait_bar_n(int n){ if(n<=0){WAIT_BAR(0);} else if(n==1){WAIT_BAR(1);} else if(n==2){WAIT_BAR(2);} else if(n==3){WAIT_BAR(3);} else {WAIT_BAR(4);} }
template<int THRL,int DVB,bool FOX,bool NOMAX> __device__ __forceinline__ void unit(int MODE,int qb,int t0,const bf16*Qb,const bf16*__restrict__ Kb,const bf16*__restrict__ Vb,bf16*Ob,const bf16*__restrict__ Zb,bf16*Yb,const float*__restrict__ subg,float lam,const float*__restrict__ F2b,const bf16*__restrict__ KEb,char*shm){
  constexpr int NV=DVB/2;
  const int tid=threadIdx.x,lane=tid&63,r32=lane&31,hi=lane>>5; const int wid=__builtin_amdgcn_readfirstlane(tid>>6);
  const int q0=qb*QBU;
  const bf16*Qw=Qb+(long)(q0+wid*32)*DM;
  const unsigned lds0=(unsigned)(uintptr_t)shm;
  float*wsf=(float*)(shm+LDS_WS)+wid*64;
  constexpr bool TILED=(DVB==4)&&!FOX; constexpr long KSTR=TILED?4096:(long)KVBLK*DM, VSTR=TILED?8192:(long)KVBLK*DM, V2=TILED?4096:64;
  const bf16*ksrc=TILED?Kb+(long)t0*KSTR+wid*512+lane*8:Kb+((long)t0*KVBLK+lane)*DM+wid*8;
  const bf16*vsrc=TILED?Vb+(long)t0*VSTR+(wid>>2)*2048+(wid&3)*512+lane*8:Vb+((long)t0*KVBLK+16*(wid&3)+(lane>>2))*DM+(wid>>2)*32+(lane&3)*8;
  const bf16*kesrc=KEb+((long)t0*KVBLK+lane)*8; const unsigned kedst=lds0+LDS_KE; const int xw=(FOX&&wid==0)?1:0;
  const unsigned kdst=lds0+LDS_K+wid*1024, vdst=lds0+LDS_V+(wid>>2)*4096+(wid&3)*1024;
  #define KOFF(t) ((((unsigned)(t))&3u)<<13)
  #define VOFF(t) ((((unsigned)(t))&3u)<<(DVB==4?14:13))
  #define DMA_K(t) glds16(ksrc+(long)(t)*KSTR,(unsigned)__builtin_amdgcn_readfirstlane(kdst+KOFF(t)))
  #define DMA_V(t) do{ glds16(vsrc+(long)(t)*VSTR,(unsigned)__builtin_amdgcn_readfirstlane(vdst+VOFF(t))); if(DVB==4){glds16(vsrc+(long)(t)*VSTR+V2,(unsigned)__builtin_amdgcn_readfirstlane(vdst+VOFF(t)+8192));} }while(0)
  #define DMA_KE(t) do{ if(FOX&&wid==0) glds16(kesrc+(long)(t)*KVBLK*8,(unsigned)__builtin_amdgcn_readfirstlane(kedst+((((unsigned)(t))&3u)<<10))); }while(0)
  const lds_cptr shm3=(lds_cptr)shm;
  const lds_cptr kp0=shm3+LDS_K+hi*1024+r32*16;
  const lds_cptr vp0=shm3+LDS_V+((lane>>4)&1)*32+(lane&3)*8+(4*hi+((lane&15)>>2))*64;
  const lds_cptr kep0=shm3+LDS_KE+r32*16;
  const int NT=(q0+QBU)/KVBLK-t0;
  DMA_KE(0);DMA_KE(1);DMA_KE(2);
  DMA_K(0);DMA_V(0);DMA_K(1);DMA_K(2);DMA_V(1);
  bf16x8 qr[4];
  #pragma unroll
  for(int d0=0;d0<4;++d0)qr[d0]=*reinterpret_cast<const bf16x8*>(&Qw[(long)r32*DM+d0*16+hi*8]);
  float mhat=0.f,l_reg=0.f;f32x16 o[DVB];
  #pragma unroll
  for(int d_=0;d_<DVB;++d_)o[d_]=f32x16{};
  f32x16 negm=f32x16{}; if(!FOX&&!NOMAX){asm volatile("":"+v"(negm));}
  bf16x8 qre=bf16x8{},kef=bf16x8{}; float fq2=0.f;
  if(FOX){ fq2=F2b[q0+wid*32+r32]; qre=attn_body::make_qre(fq2,hi); }
  #define SETREF() do{ if(FOX){ qre=attn_body::make_qre(fq2-mhat,hi); } else { _Pragma("unroll") for(int r=0;r<16;++r)negm[r]=-mhat; asm volatile("":"+v"(negm)); } }while(0)
  const int qrel=wid*32+r32;
  #define CMASK(Px,t,h) do{int jb_=(t)-(NT-4); if(jb_>=0){ const int kb_=64*jb_+32*(h)+4*hi; _Pragma("unroll") for(int r=0;r<16;++r){ if(kb_+(r&3)+8*(r>>2)>qrel)Px[r]=-INFINITY; } } }while(0)
  bool resc=false;
  #define RESC() do{ if(resc){ asm volatile("s_waitcnt lgkmcnt(0)":::"memory"); \
      _Pragma("unroll") for(int d_=0;d_<DVB;++d_) _Pragma("unroll") for(int r=0;r<16;++r)o[d_][r]*=wsf[crow(r,hi)]; } }while(0)
  f32x16 pA,pB; bf16x8 kf[4];
  constexpr bool RESP=false;
  constexpr bool LMFMA=false; f32x16 ol=f32x16{}; const bf16x8 ones=(bf16x8){0x3F80,0x3F80,0x3F80,0x3F80,0x3F80,0x3F80,0x3F80,0x3F80};
  WAIT_BAR(0);
  if(3<NT){DMA_K(3);DMA_KE(3);}
  DMA_V(2);
  { const char*kb=shm+LDS_K+hi*1024+r32*16;
    if(FOX){ kef=*(const LAS3 bf16x8*)(kep0); pA=__builtin_amdgcn_mfma_f32_32x32x16_bf16(kef,qre,f32x16{},0,0,0); pA=__builtin_amdgcn_mfma_f32_32x32x16_bf16(*reinterpret_cast<const bf16x8*>(kb),qr[0],pA,0,0,0); }
    else pA=__builtin_amdgcn_mfma_f32_32x32x16_bf16(*reinterpret_cast<const bf16x8*>(kb),qr[0],(NOMAX?f32x16{}:negm),0,0,0);
    #pragma unroll
    for(int d0=1;d0<4;++d0)pA=__builtin_amdgcn_mfma_f32_32x32x16_bf16(*reinterpret_cast<const bf16x8*>(kb+d0*2048),qr[d0],pA,0,0,0); }
  #pragma unroll
  for(int d0=0;d0<4;++d0)kf[d0]=*(const LAS3 bf16x8*)(kp0+d0*2048+512);
  if(FOX)kef=*(const LAS3 bf16x8*)(kep0+512);
  asm volatile("s_nop 15\n\ts_nop 7":"+v"(pA));CMASK(pA,0,0);
  { if constexpr(!NOMAX){ float a=max3f(pA[0],pA[1],pA[2]),b=max3f(pA[3],pA[4],pA[5]);a=max3f(a,pA[6],pA[7]);b=max3f(b,pA[8],pA[9]);a=max3f(a,pA[10],pA[11]);b=max3f(b,pA[12],pA[13]);a=max3f(a,pA[14],pA[15]);
    float rm=max2f(a,b); auto rr=__builtin_amdgcn_permlane32_swap(__float_as_uint(rm),__float_as_uint(rm),false,false); rm=max2f(__uint_as_float(rr[0]),__uint_as_float(rr[1]));
    mhat=fadd_s(mhat,rm);
    #pragma unroll
    for(int r=0;r<16;++r)pA[r]=fsub_s(pA[r],rm);
    SETREF(); }
    #pragma unroll
    for(int r=0;r<16;++r)pA[r]=__builtin_amdgcn_exp2f(pA[r]); }
  s16x4 vlo[2*DVB],vhi[2*DVB]; u32x4 pw0,pw1;
  #define PKW(P,B) cvtpk_s(P[B],P[B+1])
  #define PAF(k) __builtin_bit_cast(bf16x8,pw##k)
  #define VFR(i) (bf16x8){vlo[i][0],vlo[i][1],vlo[i][2],vlo[i][3],vhi[i][0],vhi[i][1],vhi[i][2],vhi[i][3]}
  #define PIN(x) asm volatile("":"+v"(x))
  #define MX3(a,b,c) __builtin_fmaxf(__builtin_fmaxf((a),(b)),(c))
  #define GAPA(MF,A0,A1,A2,A3,W0,W1,PW) do{ MF; if constexpr(!LMFMA){ sacc+=A0; sacc+=A1; sacc+=A2; sacc+=A3; PIN(sacc); } W0; W1; PIN(PW); SBAR(); }while(0)
  #define EX(v) __builtin_amdgcn_exp2f(v)
  #define GAPB(MF,X,B) do{ MF; X[B]=EX(X[B]); X[B+1]=EX(X[B+1]); PIN(X); SBAR(); }while(0)
  #define GAPB3(MF,X,B) do{ MF; X[B]=EX(X[B]); X[B+1]=EX(X[B+1]); X[B+2]=EX(X[B+2]); PIN(X); SBAR(); }while(0)
  #define GAPA0(MF) do{ MF; SBAR(); }while(0)
  #define GAPB4(MF,X,B) do{ MF; X[B]=EX(X[B]); X[B+1]=EX(X[B+1]); X[B+2]=EX(X[B+2]); X[B+3]=EX(X[B+3]); PIN(X); SBAR(); }while(0)
  #define VRD(i) do{ vlo[i]=vtr(vp_+(((i)%DVB)*4096+((i)/DVB)*1024)); vhi[i]=vtr(vp_+(((i)%DVB)*4096+((i)/DVB)*1024+512)); SBAR(); }while(0)
  #define KERD(G) do{ if(FOX&&(G)){ kef=*(const LAS3 bf16x8*)(ken_); SBAR(); } }while(0)
  #define CIN0(Cx) (FOX?(Cx):(NOMAX?f32x16{}:negm))
  #define KRD(G,j) do{ if(G){ kf[j]=*(const LAS3 bf16x8*)(kn_+(j)*2048); SBAR(); } }while(0)
  #define SUB(Cx,Px,t,h,VP,KN,KEN,GL,ISSUE) do{ SBAR(); \
    const lds_cptr vp_=(VP); const lds_cptr kn_=(KN); const lds_cptr ken_=(KEN); \
    if(FOX){ Cx=__builtin_amdgcn_mfma_f32_32x32x16_bf16(kef,qre,f32x16{},0,0,0); SBAR(); } \
    VRD(0); float sacc=0.f; \
    GAPA(Cx=__builtin_amdgcn_mfma_f32_32x32x16_bf16(kf[0],qr[0],CIN0(Cx),0,0,0), Px[0],Px[1],Px[2],Px[3],     pw0[0]=PKW(Px,0), pw0[1]=PKW(Px,2), pw0); \
    VRD(1); GAPA(Cx=__builtin_amdgcn_mfma_f32_32x32x16_bf16(kf[1],qr[1],Cx,0,0,0), Px[4],Px[5],Px[6],Px[7],     pw0[2]=PKW(Px,4), pw0[3]=PKW(Px,6), pw0); \
    if constexpr(RESP){ VRD(2); GAPA0(Cx=__builtin_amdgcn_mfma_f32_32x32x16_bf16(kf[2],qr[2],Cx,0,0,0)); VRD(3); GAPA0(Cx=__builtin_amdgcn_mfma_f32_32x32x16_bf16(kf[3],qr[3],Cx,0,0,0)); } else { \
    if(DVB==4){VRD(2);} GAPA(Cx=__builtin_amdgcn_mfma_f32_32x32x16_bf16(kf[2],qr[2],Cx,0,0,0), Px[8],Px[9],Px[10],Px[11],   pw1[0]=PKW(Px,8), pw1[1]=PKW(Px,10), pw1); \
    if(DVB==4){VRD(3);} GAPA(Cx=__builtin_amdgcn_mfma_f32_32x32x16_bf16(kf[3],qr[3],Cx,0,0,0), Px[12],Px[13],Px[14],Px[15], pw1[2]=PKW(Px,12), pw1[3]=PKW(Px,14), pw1); \
    l_reg+=sacc; } \
    ISSUE; \
    CMASK(Cx,t,h); \
    if constexpr(!NOMAX) \
    { float a=MX3(Cx[0],Cx[1],Cx[2]),b=MX3(Cx[3],Cx[4],Cx[5]); a=MX3(a,Cx[6],Cx[7]); b=MX3(b,Cx[8],Cx[9]); a=MX3(a,Cx[10],Cx[11]); b=MX3(b,Cx[12],Cx[13]); a=MX3(a,Cx[14],Cx[15]); \
      float rm=__builtin_fmaxf(a,b); { auto rr=__builtin_amdgcn_permlane32_swap(__float_as_uint(rm),__float_as_uint(rm),false,false); rm=__builtin_fmaxf(__uint_as_float(rr[0]),__uint_as_float(rr[1])); } \
      resc=false; \
      if(__builtin_expect(__any(rm>(float)THRL),0)){ const float dl=__builtin_fmaxf(rm,0.f); mhat+=dl; \
        _Pragma("unroll") for(int r=0;r<16;++r){Cx[r]-=dl;} \
        SETREF(); \
        const float f=__builtin_amdgcn_exp2f(-dl); l_reg*=f; if(hi==0)wsf[r32]=f; resc=true; } } \
    SBAR(); \
    if constexpr(RESP){ \
    VRD(4); GAPA(o[0]=__builtin_amdgcn_mfma_f32_32x32x16_bf16(PAF(0),VFR(0),o[0],0,0,0), Px[8],Px[9],Px[10],Px[11],   pw1[0]=PKW(Px,8), pw1[1]=PKW(Px,10), pw1); \
    VRD(5); GAPA(o[1]=__builtin_amdgcn_mfma_f32_32x32x16_bf16(PAF(0),VFR(1),o[1],0,0,0), Px[12],Px[13],Px[14],Px[15], pw1[2]=PKW(Px,12), pw1[3]=PKW(Px,14), pw1); \
    l_reg+=sacc; \
    VRD(6); GAPB3(o[2]=__builtin_amdgcn_mfma_f32_32x32x16_bf16(PAF(0),VFR(2),o[2],0,0,0), Cx,0); \
    VRD(7); GAPB3(o[3]=__builtin_amdgcn_mfma_f32_32x32x16_bf16(PAF(0),VFR(3),o[3],0,0,0), Cx,3); \
    KRD(GL,0); GAPB3(o[0]=__builtin_amdgcn_mfma_f32_32x32x16_bf16(PAF(1),VFR(4),o[0],0,0,0), Cx,6); \
    KRD(GL,1); GAPB3(o[1]=__builtin_amdgcn_mfma_f32_32x32x16_bf16(PAF(1),VFR(5),o[1],0,0,0), Cx,9); \
    KRD(GL,2); GAPB(o[2]=__builtin_amdgcn_mfma_f32_32x32x16_bf16(PAF(1),VFR(6),o[2],0,0,0), Cx,12); \
    KRD(GL,3); KERD(GL); GAPB(o[3]=__builtin_amdgcn_mfma_f32_32x32x16_bf16(PAF(1),VFR(7),o[3],0,0,0), Cx,14); \
    } else if constexpr(DVB==4){ \
    VRD(4); GAPB(o[0]=__builtin_amdgcn_mfma_f32_32x32x16_bf16(PAF(0),VFR(0),o[0],0,0,0), Cx,0); \
    VRD(5); GAPB(o[1]=__builtin_amdgcn_mfma_f32_32x32x16_bf16(PAF(0),VFR(1),o[1],0,0,0), Cx,2); \
    VRD(6); GAPB(o[2]=__builtin_amdgcn_mfma_f32_32x32x16_bf16(PAF(0),VFR(2),o[2],0,0,0), Cx,4); \
    VRD(7); GAPB(o[3]=__builtin_amdgcn_mfma_f32_32x32x16_bf16(PAF(0),VFR(3),o[3],0,0,0), Cx,6); \
    KRD(GL,0); GAPB(o[0]=__builtin_amdgcn_mfma_f32_32x32x16_bf16(PAF(1),VFR(4),o[0],0,0,0), Cx,8); \
    KRD(GL,1); GAPB(o[1]=__builtin_amdgcn_mfma_f32_32x32x16_bf16(PAF(1),VFR(5),o[1],0,0,0), Cx,10); \
    KRD(GL,2); GAPB(o[2]=__builtin_amdgcn_mfma_f32_32x32x16_bf16(PAF(1),VFR(6),o[2],0,0,0), Cx,12); \
    KRD(GL,3); KERD(GL); GAPB(o[3]=__builtin_amdgcn_mfma_f32_32x32x16_bf16(PAF(1),VFR(7),o[3],0,0,0), Cx,14); \
    if constexpr(LMFMA){ ol=__builtin_amdgcn_mfma_f32_32x32x16_bf16(PAF(0),ones,ol,0,0,0); ol=__builtin_amdgcn_mfma_f32_32x32x16_bf16(PAF(1),ones,ol,0,0,0); SBAR(); } \
    } else { \
    VRD(2); GAPB4(o[0]=__builtin_amdgcn_mfma_f32_32x32x16_bf16(PAF(0),VFR(0),o[0],0,0,0), Cx,0); \
    VRD(3); GAPB4(o[1]=__builtin_amdgcn_mfma_f32_32x32x16_bf16(PAF(0),VFR(1),o[1],0,0,0), Cx,4); \
    KRD(GL,0); KRD(GL,1); GAPB4(o[0]=__builtin_amdgcn_mfma_f32_32x32x16_bf16(PAF(1),VFR(2),o[0],0,0,0), Cx,8); \
    KRD(GL,2); KRD(GL,3); KERD(GL); GAPB4(o[1]=__builtin_amdgcn_mfma_f32_32x32x16_bf16(PAF(1),VFR(3),o[1],0,0,0), Cx,12); \
    } \
    RESC(); \
    }while(0)
  SUB(pB,pA,0,1,vp0+VOFF(0),kp0+KOFF(1),kep0+1024,true,(void)0);
  wait_bar_n(NV+1+xw);
  int t=1;
  #undef CMASK
  #define CMASK(Px,t,h) do{}while(0)
  for(;t+4<NT;++t){
    SUB(pA,pB,t,0,vp0+VOFF(t-1)+2048,kp0+KOFF(t)+512,kep0+((((unsigned)(t))&3u)<<10)+512,true,do{DMA_K(t+3);DMA_KE(t+3);DMA_V(t+2);}while(0));
    SUB(pB,pA,t,1,vp0+VOFF(t),kp0+KOFF(t+1),kep0+((((unsigned)(t+1))&3u)<<10),true,(void)0);
    wait_bar_n(NV+1+xw);
  }
  #undef CMASK
  #define CMASK(Px,t,h) do{int jb_=(t)-(NT-4); if(jb_>=0){ const int kb_=64*jb_+32*(h)+4*hi; _Pragma("unroll") for(int r=0;r<16;++r){ if(kb_+(r&3)+8*(r>>2)>qrel)Px[r]=-INFINITY; } } }while(0)
  for(;t<NT;++t){
    SUB(pA,pB,t,0,vp0+VOFF(t-1)+2048,kp0+KOFF(t)+512,kep0+((((unsigned)(t))&3u)<<10)+512,true,do{ if(t+3<NT){DMA_K(t+3);DMA_KE(t+3);} if(t+2<NT)DMA_V(t+2); }while(0));
    SUB(pB,pA,t,1,vp0+VOFF(t),kp0+KOFF(t+1),kep0+((((unsigned)(t+1))&3u)<<10),(t+1<NT),(void)0);
    if(t+3<NT){wait_bar_n(NV+1+xw);} else if(t+2<NT){wait_bar_n(NV);} else {WAIT_BAR(0);}
  }
  { if constexpr(!LMFMA){ float sacc=0.f; _Pragma("unroll") for(int r=0;r<16;++r)sacc+=pB[r]; l_reg+=sacc; }
    pw0=(u32x4){PKW(pB,0),PKW(pB,2),PKW(pB,4),PKW(pB,6)};pw1=(u32x4){PKW(pB,8),PKW(pB,10),PKW(pB,12),PKW(pB,14)};
    const lds_cptr vp_=vp0+VOFF(NT-1)+2048;
    #pragma unroll
    for(int i=0;i<2*DVB;++i){ vlo[i]=vtr(vp_+((i%DVB)*4096+(i/DVB)*1024)); vhi[i]=vtr(vp_+((i%DVB)*4096+(i/DVB)*1024+512)); }
    #pragma unroll
    for(int d_=0;d_<DVB;++d_)o[d_]=__builtin_amdgcn_mfma_f32_32x32x16_bf16(PAF(0),VFR(d_),o[d_],0,0,0);
    #pragma unroll
    for(int d_=0;d_<DVB;++d_)o[d_]=__builtin_amdgcn_mfma_f32_32x32x16_bf16(PAF(1),VFR(DVB+d_),o[d_],0,0,0);
    if constexpr(LMFMA){ ol=__builtin_amdgcn_mfma_f32_32x32x16_bf16(PAF(0),ones,ol,0,0,0); ol=__builtin_amdgcn_mfma_f32_32x32x16_bf16(PAF(1),ones,ol,0,0,0); } }
  #undef PKW
  #undef PAF
  #undef VFR
  #undef PIN
  #undef MX3
  #undef GAPA
  #undef GAPB
  #undef GAPB4
  #undef GAPB3
  #undef GAPA0
  #undef KERD
  #undef CIN0
  #undef EX
  #undef VRD
  #undef KRD
  #undef SUB
  {auto rr=__builtin_amdgcn_permlane32_swap(__float_as_uint(l_reg),__float_as_uint(l_reg),false,false);l_reg=__uint_as_float(rr[0])+__uint_as_float(rr[1]);}
  if(hi==0)wsf[32+r32]=l_reg;
  asm volatile("s_waitcnt lgkmcnt(0)\n\ts_barrier":::"memory");
  { float rli[16];
    #pragma unroll
    for(int r=0;r<16;++r)rli[r]=__builtin_amdgcn_rcpf(LMFMA?ol[r]:wsf[32+crow(r,hi)]);
    constexpr int OC=32*DVB, CPR=OC/8, RPI=64/CPR;
    bf16*stg=(bf16*)(shm)+wid*4096;
    #pragma unroll
    for(int r=0;r<16;++r){const int orow=crow(r,hi);
      #pragma unroll
      for(int d_=0;d_<DVB;++d_)stg[orow*OC+d_*32+r32]=__float2bfloat16(o[d_][r]*rli[r]);}
    asm volatile("s_waitcnt lgkmcnt(0)":::"memory");
    bf16*Ow=Ob+(long)(q0+wid*32)*OPITCH;
    if constexpr(DVB==2){
    #pragma unroll
    for(int i=0;i<32/RPI;++i){const int row=i*RPI+lane/CPR,ch=lane%CPR; const long grow=q0+wid*32+row; u32x4 v=*(const u32x4*)(stg+row*OC+ch*8); const u32x4 zz=*(const u32x4*)(Zb+grow*DM+ch*8);
      #pragma unroll
      for(int k=0;k<4;++k){ const float z0=__uint_as_float(zz[k]<<16),z1=__uint_as_float(zz[k]&0xffff0000u); v[k]=cvtpk_s(__uint_as_float(v[k]<<16)*(z0*__builtin_amdgcn_rcpf(1.f+__expf(-z0))),__uint_as_float(v[k]&0xffff0000u)*(z1*__builtin_amdgcn_rcpf(1.f+__expf(-z1)))); }
      *(u32x4*)(Yb+grow*1024+ch*8)=v; }
    } else
    if(MODE==0){
    #pragma unroll
    for(int i=0;i<8;++i){const int row=i*4+(lane>>4),ch=lane&15; const u32x4 v=*(const u32x4*)(stg+row*128+ch*8); *(u32x4*)(Ow+(long)row*OPITCH+ch*8)=v;}
    } else {
    const int ch=lane&15; float gg[8];
    #pragma unroll
    for(int k=0;k<8;++k)gg[k]=subg[ch*8+k];
    #pragma unroll
    for(int i=0;i<8;++i){const int row=i*4+(lane>>4); const long grow=q0+wid*32+row;
      const u32x4 v1=*(const u32x4*)(stg+row*128+ch*8), v0=*(const u32x4*)(Ow+(long)row*OPITCH+ch*8), zz=*(const u32x4*)(Zb+grow*DM+ch*8);
      float d[8];
      #pragma unroll
      for(int k=0;k<4;++k){ d[2*k]=__uint_as_float(v0[k]<<16)-lam*__uint_as_float(v1[k]<<16); d[2*k+1]=__uint_as_float(v0[k]&0xffff0000u)-lam*__uint_as_float(v1[k]&0xffff0000u); }
      float ss=0.f;
      #pragma unroll
      for(int k=0;k<8;++k)ss+=d[k]*d[k];
      #pragma unroll
      for(int o_=1;o_<16;o_<<=1)ss+=__shfl_xor(ss,o_);
      const float rs=__builtin_amdgcn_rsqf(ss*(1.f/128.f)+1e-6f); u32x4 w;
      #pragma unroll
      for(int k=0;k<4;++k){ const float z0=__uint_as_float(zz[k]<<16),z1=__uint_as_float(zz[k]&0xffff0000u);
        const float y0=d[2*k]*rs*gg[2*k]*(z0*__builtin_amdgcn_rcpf(1.f+__expf(-z0))), y1=d[2*k+1]*rs*gg[2*k+1]*(z1*__builtin_amdgcn_rcpf(1.f+__expf(-z1))); w[k]=cvtpk_s(y0,y1); }
      *(u32x4*)(Yb+grow*1024+ch*8)=w; }
    } }
  asm volatile("s_waitcnt lgkmcnt(0)\n\ts_barrier":::"memory");
  #undef DMA_K
  #undef DMA_V
  #undef DMA_KE
  #undef SETREF
  #undef KOFF
  #undef VOFF
  #undef CMASK
  #undef RESC
}
#undef SBAR
#undef WAIT_BAR
#undef LAS3
}
constexpr int NWAVES = 8;
#ifndef MK_ONE_LAUNCH
#define MK_ONE_LAUNCH 1
#endif
constexpr int BATCH = 2, SEQ = 16384, D = 1024, M = BATCH * SEQ, NPJ = 4096;
constexpr int ATTN_IN = 4104, ML_IN = 4112;
constexpr float RMS_EPS = 1e-6f, LOG2E = 1.4426950408889634f, C2 = 0.125f * 1.4426950408889634f;
constexpr int NPHASE = 12;
constexpr size_t MiB = 1u << 20;
constexpr size_t WS_CTL = 0, CTL_ZERO_BYTES = 1 * MiB;
constexpr size_t WS_LOGF = 1 * MiB, WS_F2 = 2 * MiB, WS_QE = 3 * MiB, WS_KE = 7 * MiB, WS_LI = 11 * MiB, WS_LF = 12 * MiB;
constexpr size_t WS_GB = 13 * MiB, WS_GE = 14 * MiB, WS_GU = 15 * MiB, WS_CHA = 16 * MiB, WS_CHE = 16 * MiB + 65536, WS_CHM = 16 * MiB + 131072;
constexpr size_t WS_DN = 17 * MiB, WS_NS = 17 * MiB + 524288, WS_SUBG = 16 * MiB + 262144, WS_RSTD = 16 * MiB + 524288;
constexpr size_t WS_ROPE = 18 * MiB, WS_WIN0 = 26 * MiB, WS_WOUT0 = 34 * MiB, WS_WIN1 = 36 * MiB, WS_WOUT1 = 44 * MiB;
constexpr size_t WS_XN = 48 * MiB;
constexpr size_t WS_PROJ = 112 * MiB;
constexpr size_t WS_OB = 368 * MiB;
constexpr size_t WS_END = 464 * MiB;
constexpr int CW_TMO = 0, CW_CODE = 1, CW_BAR = 4096, CW_NRM = 8192, CW_FOXQ = 8192 + 256;
constexpr int RING_OFF = 0, RING_BYTES = 131072;
constexpr int LDSCTL_OFF = RING_BYTES, MISC_OFF = LDSCTL_OFF + 320;
constexpr int LDS_BYTES = 147456;
static_assert(MISC_OFF + 128 <= LDS_BYTES, "LDS map");
#define GAS __attribute__((address_space(1)))
#define LAS __attribute__((address_space(3)))
typedef unsigned short bf16;
typedef unsigned v4u __attribute__((ext_vector_type(4)));
typedef float f32x4 __attribute__((ext_vector_type(4)));
typedef short bf16x8 __attribute__((ext_vector_type(8)));
typedef GAS unsigned gu32;
typedef GAS unsigned long long gu64;
#define RLX_AGENT __ATOMIC_RELAXED, __HIP_MEMORY_SCOPE_AGENT
#define LDS_WAIT() asm volatile("s_waitcnt lgkmcnt(0)" ::: "memory")
#define VM_WAIT() asm volatile("s_waitcnt vmcnt(0)" ::: "memory")
__device__ __forceinline__ unsigned long long rt() { return __builtin_amdgcn_s_memrealtime(); }
__device__ __forceinline__ unsigned f2bf(float f) { unsigned u = __builtin_bit_cast(unsigned, f); return (u + 0x7fffu + ((u >> 16) & 1u)) >> 16; }
__device__ __forceinline__ unsigned pk2(float lo, float hi) { return f2bf(lo) | (f2bf(hi) << 16); }
#define XB_TMO      128
#define XB_XCNT(j)  (256  + 64 * (j))
#define XB_XSUB(j)  (1280 + 64 * (j))
#define XB_XGEN(j)  (2304 + 64 * (j))
#define XB_TOP      3328
#define XB_TOPGEN   3392
#define XCD_BAR_WORDS 3456
#define XB_SPIN_CAP (1u << 18)

__device__ __forceinline__ unsigned xb_ld(unsigned* p)              { return __hip_atomic_load(p, __ATOMIC_RELAXED, __HIP_MEMORY_SCOPE_AGENT); }
__device__ __forceinline__ unsigned xb_add(unsigned* p, unsigned v) { return __hip_atomic_fetch_add(p, v, __ATOMIC_RELAXED, __HIP_MEMORY_SCOPE_AGENT); }
__device__ __forceinline__ unsigned xb_xcc_id() { return (unsigned)__builtin_amdgcn_s_getreg((3 << 11) | 20) & 0xFu; }
#define XB_SPIN(cond, bar) do { unsigned _sp = 0; while (cond) { __builtin_amdgcn_s_sleep(1); \
    if ((++_sp & 255u) == 0u) { if (xb_ld(&(bar)[XB_TMO])) break; if (_sp > XB_SPIN_CAP) { atomicAdd(&(bar)[XB_TMO], 1u); break; } } } } while (0)

struct XcdBarrier {
    unsigned* bar; unsigned x;
    volatile LAS unsigned* st;
};

__device__ __forceinline__ XcdBarrier xcd_barrier_post(unsigned* bar, volatile LAS unsigned* st) {
    XcdBarrier b; b.bar = bar; b.x = xb_xcc_id(); b.st = st;
    if (threadIdx.x == 0) (void)xb_add(&bar[XB_XCNT(b.x)], 1u);
    return b;
}
__device__ __forceinline__ void xcd_barrier_complete(unsigned* bar, unsigned x, unsigned& nloc, unsigned& nx) {
    const unsigned G = gridDim.x * gridDim.y * gridDim.z;
    unsigned sum, cnt, mine, sp = 0u;
    for (;;) {
        sum = 0u; cnt = 0u; mine = 0u;
#pragma unroll
        for (unsigned j = 0; j < 16; ++j) { const unsigned c = xb_ld(&bar[XB_XCNT(j)]); sum += c; cnt += (c > 0u) ? 1u : 0u; mine = (j == x) ? c : mine; }
        if (sum == G) break;
        __builtin_amdgcn_s_sleep(1);
        if ((++sp & 255u) == 0u) { if (xb_ld(&bar[XB_TMO])) break; if (sp > XB_SPIN_CAP) { atomicAdd(&bar[XB_TMO], 1u); break; } }
    }
    nloc = mine > 0u ? mine : 1u; nx = cnt > 0u ? cnt : 1u;
}

__device__ __forceinline__ void xcd_barrier(const XcdBarrier& b) {
    asm volatile("s_waitcnt vmcnt(0)" ::: "memory");
    __syncthreads();
    if (threadIdx.x == 0) {
        unsigned* bar = b.bar;
        __builtin_amdgcn_s_waitcnt(0);
        unsigned nloc = b.st[0], nx = b.st[1];
        if (nloc == 0u) { xcd_barrier_complete(bar, b.x, nloc, nx); b.st[0] = nloc; b.st[1] = nx; }
        const unsigned old = xb_add(&bar[XB_XSUB(b.x)], 1u);
        const unsigned gen = old / nloc;
        if (old + 1u == (gen + 1u) * nloc) {
            __builtin_amdgcn_fence(__ATOMIC_RELEASE, "agent");
            asm volatile("s_waitcnt vmcnt(0)" ::: "memory");
            const unsigned og = xb_add(&bar[XB_TOP], 1u);
            const unsigned tg = og / nx;
            if (og + 1u == (tg + 1u) * nx) xb_add(&bar[XB_TOPGEN], 1u);
            else XB_SPIN(xb_ld(&bar[XB_TOPGEN]) == tg, bar);
            __builtin_amdgcn_fence(__ATOMIC_ACQUIRE, "agent");
            xb_add(&bar[XB_XGEN(b.x)], 1u);
            asm volatile("s_waitcnt vmcnt(0)" ::: "memory");
        } else {
            XB_SPIN(xb_ld(&bar[XB_XGEN(b.x)]) == gen, bar);
            __builtin_amdgcn_fence(__ATOMIC_ACQUIRE, "agent");
            asm volatile("s_waitcnt vmcnt(0)" ::: "memory");
        }
    }
    __syncthreads();
}
__device__ __forceinline__ float wave_sum(float v) {
#pragma unroll
    for (int o = 1; o < 64; o <<= 1) v += __shfl_xor(v, o);
    return v;
}
__device__ __forceinline__ float bf2f(unsigned short b) { return __builtin_bit_cast(float, (unsigned)b << 16); }
__device__ __forceinline__ float bflo(unsigned w) { return __builtin_bit_cast(float, w << 16); }
__device__ __forceinline__ float bfhi(unsigned w) { return __builtin_bit_cast(float, w & 0xffff0000u); }
typedef _Float16 h2p __attribute__((ext_vector_type(2))); typedef float f2p __attribute__((ext_vector_type(2)));
__device__ __forceinline__ unsigned pkh(float lo, float hi) { const f2p v = {lo, hi}; return __builtin_bit_cast(unsigned, __builtin_convertvector(v, h2p)); }
__device__ __forceinline__ float h_lo(unsigned w) { return (float)__builtin_bit_cast(h2p, w)[0]; }
__device__ __forceinline__ float h_hi(unsigned w) { return (float)__builtin_bit_cast(h2p, w)[1]; }
__device__ __forceinline__ float log_sigmoid_f(float x) { return fminf(x, 0.f) - log1pf(__expf(-fabsf(x))); }
__device__ __forceinline__ float sigmoid_f(float x) { return 1.f / (1.f + __expf(-x)); }
__device__ __forceinline__ float silu_f(float x) { return x / (1.f + __expf(-x)); }

typedef unsigned u32x4m __attribute__((ext_vector_type(4)));
struct Ctx {
    LAS unsigned char* lds; char* ldsg; int G, bid;
    float* out; unsigned char* ws;
};
__device__ __forceinline__ const float* kin(int i) { unsigned long long r; const unsigned long long kp = (unsigned long long)__builtin_amdgcn_kernarg_segment_ptr();
    asm volatile("s_load_dwordx2 %0, %1, %2\n\ts_waitcnt lgkmcnt(0)" : "=s"(r) : "s"(kp), "n"(i * 8)); return (const float*)r; }
__device__ __forceinline__ int src_col0(int P) {
    if (P < 1536) return P;
    if (P < 2560) { const int q = P - 1536, grp = q >> 6, p = q & 63; return 1544 + grp * 64 + 16 * (p >> 5) + 4 * ((p >> 3) & 3) + (p & 3) + 32 * ((p >> 2) & 1); }
    return P + 8;
}
__device__ __forceinline__ int src_col1(int P) { if (P < 2048) return P; const int j = (P - 2048) >> 1; return (P & 1) ? 3088 + j : 2064 + j; }
template <bool F16>
__device__ __forceinline__ void transpose_item(const float* W, int ldw, const float* gain, bf16* WT, LAS float* scr, int kb, int nb, int lane, int srcc) {
    const int k0 = 64 * kb, n0 = 32 * nb;
    float wv[32], gv[32];
#pragma unroll
    for (int i = 0; i < 32; ++i) { const int kk = 2 * i + (lane >> 5); gv[i] = gain ? gain[k0 + kk] : 1.f; wv[i] = W[(size_t)(k0 + kk) * ldw + srcc]; }
#pragma unroll
    for (int i = 0; i < 32; ++i) { const int kk = 2 * i + (lane >> 5); scr[kk * 33 + (lane & 31)] = wv[i] * gv[i]; }
    LDS_WAIT(); asm volatile("" ::: "memory");
    const int c = lane & 7;
#pragma unroll
    for (int j = 0; j < 4; ++j) { const int n = (lane >> 3) + 8 * j; const LAS float* s = scr + (8 * c) * 33 + n;
        v4u o; if (F16) { o.x = pkh(s[0 * 33], s[1 * 33]); o.y = pkh(s[2 * 33], s[3 * 33]); o.z = pkh(s[4 * 33], s[5 * 33]); o.w = pkh(s[6 * 33], s[7 * 33]); }
        else { o.x = pk2(s[0 * 33], s[1 * 33]); o.y = pk2(s[2 * 33], s[3 * 33]); o.z = pk2(s[4 * 33], s[5 * 33]); o.w = pk2(s[6 * 33], s[7 * 33]); }
        *(GAS v4u*)(WT + (size_t)(n0 + n) * 1024 + k0 + 8 * c) = o; }
    LDS_WAIT(); asm volatile("" ::: "memory");
}
__device__ __constant__ const double kInvFreq[32] = {1.0, 0.7498942093324559, 0.5623413251903491, 0.4216965034285822, 0.31622776601683794, 0.23713737056616552, 0.1778279410038923, 0.1333521432163324, 0.1, 0.07498942093324558,
    0.05623413251903491, 0.042169650342858224, 0.03162277660168379, 0.023713737056616554, 0.01778279410038923, 0.01333521432163324, 0.01, 0.007498942093324558, 0.005623413251903491, 0.004216965034285823, 0.0031622776601683794,
    0.0023713737056616554, 0.0017782794100389228, 0.001333521432163324, 0.001, 0.0007498942093324559, 0.0005623413251903491, 0.00042169650342858224, 0.00031622776601683794, 0.00023713737056616554, 0.00017782794100389227, 0.0001333521432163324};

__device__ __forceinline__ void prologue_weights(const Ctx& C) {
    LAS float* scr = (LAS float*)(C.lds + RING_OFF + __builtin_amdgcn_readfirstlane((int)threadIdx.x >> 6) * 16384);
    const int gw = C.bid * NWAVES + __builtin_amdgcn_readfirstlane((int)threadIdx.x >> 6), NGW = C.G * NWAVES;
    bf16* Win0 = (bf16*)(C.ws + WS_WIN0); bf16* Wout0 = (bf16*)(C.ws + WS_WOUT0); bf16* Win1 = (bf16*)(C.ws + WS_WIN1); bf16* Wout1 = (bf16*)(C.ws + WS_WOUT1);
    constexpr int I_IN = 16 * 128, I_OUT = 16 * 32, NITEMS = 2 * I_IN + 2 * I_OUT;
    for (int it = gw; it < NITEMS; it += NGW) {
        int r = it;
        if (r < I_IN) { const int kb = r / 128, nb = r % 128; transpose_item<false>(kin(3), ATTN_IN, kin(2), Win0, scr, kb, nb, ((int)threadIdx.x & 63), src_col0(32 * nb + (((int)threadIdx.x & 63) & 31))); continue; } r -= I_IN;
        if (r < I_IN) { const int kb = r / 128, nb = r % 128; transpose_item<true>(kin(12), ML_IN, kin(11), Win1, scr, kb, nb, ((int)threadIdx.x & 63), src_col1(32 * nb + (((int)threadIdx.x & 63) & 31))); continue; } r -= I_IN;
        if (r < I_OUT) { const int kb = r / 32, nb = r % 32; transpose_item<false>(kin(10), 1024, nullptr, Wout0, scr, kb, nb, ((int)threadIdx.x & 63), 32 * nb + (((int)threadIdx.x & 63) & 31)); continue; } r -= I_OUT;
        { const int kb = r / 32, nb = r % 32; transpose_item<false>(kin(15), 1024, nullptr, Wout1, scr, kb, nb, ((int)threadIdx.x & 63), 32 * nb + (((int)threadIdx.x & 63) & 31)); }
    }
    const int* pos = (const int*)kin(1); float* rope = (float*)(C.ws + WS_ROPE);
    for (int idx = C.bid * (NWAVES * 64) + (int)threadIdx.x; idx < M * 32; idx += C.G * NWAVES * 64) { const int m = idx >> 5, i = idx & 31;
        double rev = (double)pos[m] * kInvFreq[i] * 0.15915494309189535; rev -= floor(rev); const float rf = (float)rev;
        *(float2*)(rope + (size_t)idx * 2) = make_float2(__builtin_amdgcn_cosf(rf), __builtin_amdgcn_sinf(rf)); }
}
typedef _Float16 h8n __attribute__((ext_vector_type(8)));
template <int NG, bool B16IN>
__device__ __forceinline__ void norm_gate_phase(const Ctx& C, const void* Xv, const float* W, int ldw, int gcol0, const float* gain, const float* bias_a, const float* bias_b, bf16* XN, float* outA, float* outB, float* rstdo) {
    constexpr int TP = 1032;
    LAS unsigned short* thi = (LAS unsigned short*)(C.lds + RING_OFF); LAS unsigned short* tlo = thi + 16 * TP;
#pragma unroll 8
    for (int i = (int)threadIdx.x; i < 16 * 1024; i += NWAVES * 64) { const int c = i & 15, k = i >> 4; float w = 0.f; if (c < NG) w = W[(size_t)k * ldw + gcol0 + c] * gain[k];
        const _Float16 h = (_Float16)w; const _Float16 l = (_Float16)(w - (float)h); thi[c * TP + k] = __builtin_bit_cast(unsigned short, h); tlo[c * TP + k] = __builtin_bit_cast(unsigned short, l); }
    __syncthreads();
    const int ln = (int)threadIdx.x & 63, r16 = ln & 15, kg = ln >> 4;
    const int gw = C.bid * NWAVES + __builtin_amdgcn_readfirstlane((int)threadIdx.x >> 6), NGW = C.G * NWAVES;
    for (int grp = gw; grp < M / 16; grp += NGW) { const size_t row = (size_t)grp * 16 + r16;
        f32x4 acc = {0.f, 0.f, 0.f, 0.f}; float ss = 0.f;
#pragma unroll 4
        for (int s = 0; s < 32; ++s) { const int k0 = 32 * s + 8 * kg;
            const bf16x8 bh = *(const LAS bf16x8*)(thi + r16 * TP + k0), bl = *(const LAS bf16x8*)(tlo + r16 * TP + k0);
            if (B16IN) { const v4u a = *(const v4u*)((const bf16*)Xv + row * D + k0);
                ss += (h_lo(a.x) * h_lo(a.x) + h_hi(a.x) * h_hi(a.x)) + (h_lo(a.y) * h_lo(a.y) + h_hi(a.y) * h_hi(a.y)) + (h_lo(a.z) * h_lo(a.z) + h_hi(a.z) * h_hi(a.z)) + (h_lo(a.w) * h_lo(a.w) + h_hi(a.w) * h_hi(a.w));
                const h8n af = __builtin_bit_cast(h8n, a);
                acc = __builtin_amdgcn_mfma_f32_16x16x32_f16(af, __builtin_bit_cast(h8n, bh), acc, 0, 0, 0); acc = __builtin_amdgcn_mfma_f32_16x16x32_f16(af, __builtin_bit_cast(h8n, bl), acc, 0, 0, 0);
            } else { const f32x4 x0 = *(const f32x4*)((const float*)Xv + row * D + k0), x1 = *(const f32x4*)((const float*)Xv + row * D + k0 + 4);
                ss += (x0[0] * x0[0] + x0[1] * x0[1]) + (x0[2] * x0[2] + x0[3] * x0[3]) + (x1[0] * x1[0] + x1[1] * x1[1]) + (x1[2] * x1[2] + x1[3] * x1[3]);
                v4u o; o.x = pk2(x0[0], x0[1]); o.y = pk2(x0[2], x0[3]); o.z = pk2(x1[0], x1[1]); o.w = pk2(x1[2], x1[3]); *(v4u*)(XN + row * D + k0) = o;
                v4u ah, al;
                ah.x = pkh(x0[0], x0[1]); ah.y = pkh(x0[2], x0[3]); ah.z = pkh(x1[0], x1[1]); ah.w = pkh(x1[2], x1[3]);
                al.x = pkh(x0[0] - h_lo(ah.x), x0[1] - h_hi(ah.x)); al.y = pkh(x0[2] - h_lo(ah.y), x0[3] - h_hi(ah.y)); al.z = pkh(x1[0] - h_lo(ah.z), x1[1] - h_hi(ah.z)); al.w = pkh(x1[2] - h_lo(ah.w), x1[3] - h_hi(ah.w));
                const h8n afh = __builtin_bit_cast(h8n, ah), afl = __builtin_bit_cast(h8n, al);
                acc = __builtin_amdgcn_mfma_f32_16x16x32_f16(afh, __builtin_bit_cast(h8n, bh), acc, 0, 0, 0); acc = __builtin_amdgcn_mfma_f32_16x16x32_f16(afh, __builtin_bit_cast(h8n, bl), acc, 0, 0, 0);
                acc = __builtin_amdgcn_mfma_f32_16x16x32_f16(afl, __builtin_bit_cast(h8n, bh), acc, 0, 0, 0); } }
        ss += __shfl_xor(ss, 16); ss += __shfl_xor(ss, 32);
        const float rstd = 1.f / sqrtf(ss * (1.f / D) + RMS_EPS);
        if (kg == 0) rstdo[row] = rstd;
#pragma unroll
        for (int i = 0; i < 4; ++i) { const float rs = __shfl(rstd, 4 * kg + i); const float g = acc[i] * rs; const size_t m = (size_t)grp * 16 + 4 * kg + i;
            if (NG == 8) { if (r16 < 8) outA[m * 8 + r16] = log_sigmoid_f(g + bias_a[r16 & 7]); }
            else { if (r16 < 8) outA[m * 8 + r16] = g + bias_a[r16 & 7]; else outB[m * 8 + r16 - 8] = log_sigmoid_f(g + bias_b[r16 & 7]); } }
    }
}
__device__ __forceinline__ void cumsum_phase(const Ctx& C) {
    if (C.bid >= 16) return;
    const int bh = C.bid, b = bh >> 3, h = bh & 7, t = (int)threadIdx.x;
    const float* lp = (const float*)(C.ws + WS_LOGF) + ((size_t)b * SEQ + 32 * t) * 8 + h;
    float v[32]; float run = 0.f;
#pragma unroll
    for (int i = 0; i < 32; ++i) { run += lp[i * 8]; v[i] = run; }
    float x = run;
#pragma unroll
    for (int o = 1; o < 64; o <<= 1) { const float y = __shfl_up(x, o); if (((int)threadIdx.x & 63) >= o) x += y; }
    volatile LAS float* wt = (volatile LAS float*)(C.lds + LDSCTL_OFF);
    if (((int)threadIdx.x & 63) == 63) wt[__builtin_amdgcn_readfirstlane((int)threadIdx.x >> 6)] = x;
    __syncthreads();
    float off = x - run;
    for (int w = 0; w < __builtin_amdgcn_readfirstlane((int)threadIdx.x >> 6); ++w) off += wt[w];
    float* F2 = (float*)(C.ws + WS_F2) + (size_t)bh * SEQ + 32 * t;
    v4u* QE = (v4u*)(C.ws + WS_QE) + (size_t)bh * SEQ + 32 * t; v4u* KE = (v4u*)(C.ws + WS_KE) + (size_t)bh * SEQ + 32 * t;
#pragma unroll
    for (int i = 0; i < 32; ++i) { const float f = (off + v[i]) * LOG2E; F2[i] = f;
        const unsigned h0 = f2bf(f); const float r1 = f - __builtin_bit_cast(float, h0 << 16); const unsigned h1 = f2bf(r1); const float r2 = r1 - __builtin_bit_cast(float, h1 << 16); const unsigned h2 = f2bf(r2);
        v4u q; q.x = h0 | (h1 << 16); q.y = h2 | (0x3F80u << 16); q.z = 0x3F80u | (0x3F80u << 16); q.w = 0u; QE[i] = q;
        v4u k; k.x = 0x3F80u | (0x3F80u << 16); k.y = 0x3F80u | ((h0 ^ 0x8000u) << 16); k.z = (h1 ^ 0x8000u) | ((h2 ^ 0x8000u) << 16); k.w = 0u; KE[i] = k; }
    __syncthreads();
}
__device__ __forceinline__ void he_cols(int he, int& qc, int& kc, int& vc, int& oc) {
    if (he < 8) { qc = he * 64; kc = 512 + he * 64; vc = 1024 + he * 64; oc = he * 64; }
    else { const int j = he - 8, hd = j >> 2, c = (j >> 1) & 1, e = j & 1; qc = 1536 + (hd * 2 + c) * 64; kc = 2048 + (hd * 2 + c) * 64; vc = 2560 + hd * 128 + e * 64; oc = 512 + j * 64; }
}
__device__ __forceinline__ int fox_t0(const float* F2b, int qb, float qk2, int lane) {
    const int NTf = 4 * (qb + 1); const float fq = F2b[qb * 256]; int cnt = 0;
#pragma unroll
    for (int k = 0; k < 4; ++k) { const int t = lane + 64 * k; const bool skip = (t < NTf) && (qk2 + fq - F2b[64 * t + 63] < -150.f); cnt += __builtin_popcountll(__ballot(skip)); }
    int t0 = cnt; if (t0 > NTf - 4) t0 = NTf - 4; return __builtin_amdgcn_readfirstlane(t0);
}
__device__ __forceinline__ void attn_tuned_phase(const Ctx& C) {
    typedef attn_body::bf16 abf;
    const abf* P = (const abf*)(C.ws + WS_PROJ); abf* OB = (abf*)(C.ws + WS_OB); const float* F2 = (const float*)(C.ws + WS_F2); const abf* KE = (const abf*)(C.ws + WS_KE);
    const int vcu = (C.G % 8 == 0) ? (C.bid % 8) * (C.G / 8) + C.bid / 8 : C.bid;
    char* shm = C.ldsg + RING_OFF; gu32* ctl = (gu32*)(C.ws + WS_CTL);
    const int tid = threadIdx.x;
    volatile LAS unsigned* qslot = (volatile LAS unsigned*)(C.lds + LDSCTL_OFF + 64);
    bool fox_nomax, diff_nomax;
    { const int l = tid & 63; float bound = 0.f;
      if (l < 32) { const int dif = l >> 4, i = l & 15; const gu32* nq = ctl + CW_NRM + dif * 64 + i * 2; const gu32* nk = nq + 32;
          const float qn2 = __builtin_bit_cast(float, __hip_atomic_load(nq, RLX_AGENT)) + __builtin_bit_cast(float, __hip_atomic_load(nq + 1, RLX_AGENT));
          const float kn2 = __builtin_bit_cast(float, __hip_atomic_load(nk, RLX_AGENT)) + __builtin_bit_cast(float, __hip_atomic_load(nk + 1, RLX_AGENT));
          bound = 1.02f * sqrtf(qn2 * kn2); }
      const unsigned long long ok = __ballot(bound <= 100.f);
      fox_nomax = (ok & 0xffffull) == 0xffffull; diff_nomax = ((ok >> 16) & 0xffffull) == 0xffffull; }
#ifndef ATT_NO_DIFF
    float lam;
    { const int l = tid & 63; const float d1 = kin(5)[l] * kin(6)[l], d2 = kin(7)[l] * kin(8)[l]; lam = __expf(wave_sum(d1)) - __expf(wave_sum(d2)) + 0.2f; }
    float* subg = (float*)(C.ws + WS_SUBG);
    if (tid < 128) subg[tid] = kin(9)[tid] * 0.8f;
    abf* Yd = (abf*)(C.ws + WS_XN);
#define DIFF_LOOP(NM) _Pragma("nounroll") \
    for (int it = 0; it < 8 * 8 * 64; ++it) { const int p = vcu + (it >> 2) * C.G; if (p >= 8 * 32) break; \
        const int bh = p >> 5, s = p & 31, b = bh >> 2, hd = bh & 3, c = it & 1, qb = (it & 2) ? s : 63 - s;     \
        const abf* Pb = P + (size_t)b * SEQ * NPJ; abf* Osc = OB + (size_t)b * SEQ * 512 + hd * 128; \
        const abf* KTb = (const abf*)(C.ws + WS_OB + 32 * MiB) + (size_t)((b * 8 + hd * 2 + c) * 256) * 4096; const abf* VTb = (const abf*)(C.ws + WS_OB + 64 * MiB) + (size_t)((b * 4 + hd) * 256) * 8192; \
        attn256::unit<8, 4, false, NM>(c, qb, 0, Pb + 1536 + (hd * 2 + c) * 64, KTb, VTb, Osc, Pb + 3072 + 512 + hd * 128, Yd + (size_t)b * SEQ * 1024 + 512 + hd * 128, subg, lam, nullptr, nullptr, shm); }
    if (diff_nomax) { DIFF_LOOP(true) } else { DIFF_LOOP(false) }
#undef DIFF_LOOP
#endif
#ifndef ATT_NO_FOX
    if (tid == 0) *qslot = __hip_atomic_fetch_add(ctl + CW_FOXQ, 1u, RLX_AGENT);
    __syncthreads();
    unsigned u = __builtin_amdgcn_readfirstlane(*qslot);
#define FOX_LOOP(NM) _Pragma("nounroll") \
    while (u < 1024u) { \
        __syncthreads(); \
        if (tid == 0) *qslot = __hip_atomic_fetch_add(ctl + CW_FOXQ, 1u, RLX_AGENT); \
        const int qb = 63 - (int)(u >> 4), bh = (int)(u & 15u), b = bh >> 3, he = bh & 7; int qc, kc, vc, oc; he_cols(he, qc, kc, vc, oc); \
        const gu32* nq = ctl + CW_NRM + ((0 * 2 + b) * 8 + he) * 2; const gu32* nk = ctl + CW_NRM + ((1 * 2 + b) * 8 + he) * 2; \
        const float qn2 = __builtin_bit_cast(float, __hip_atomic_load(nq, RLX_AGENT)) + __builtin_bit_cast(float, __hip_atomic_load(nq + 1, RLX_AGENT)); \
        const float kn2 = __builtin_bit_cast(float, __hip_atomic_load(nk, RLX_AGENT)) + __builtin_bit_cast(float, __hip_atomic_load(nk + 1, RLX_AGENT)); \
        const float qk2 = 2.04f * sqrtf(qn2 * kn2); \
        const float* F2b = F2 + (size_t)bh * SEQ; \
        const int t0 = fox_t0(F2b, qb, qk2, tid & 63); \
        const abf* Pb = P + (size_t)b * SEQ * NPJ; \
        attn256::unit<8, 2, true, NM>(2, qb, t0, Pb + qc, Pb + kc, Pb + vc, nullptr, Pb + 3072 + oc, (abf*)(C.ws + WS_XN) + (size_t)b * SEQ * 1024 + oc, nullptr, 0.f, F2b, KE + (size_t)bh * SEQ * 8, shm); \
        u = __builtin_amdgcn_readfirstlane(*qslot); }
    if (fox_nomax) { FOX_LOOP(true) } else { FOX_LOOP(false) }
#undef FOX_LOOP
#endif
}
__device__ __forceinline__ void final_norm_phase(const Ctx& C, const bf16* X2) {
    const int lane = (int)threadIdx.x & 63, gw = C.bid * NWAVES + __builtin_amdgcn_readfirstlane((int)threadIdx.x >> 6), NGW = C.G * NWAVES; const float* g = kin(16);
    f32x4 gv[4];
#pragma unroll
    for (int j = 0; j < 4; ++j) gv[j] = ((const f32x4*)g)[lane + 64 * j];
    unsigned long long nh[4];
#define FN_LOAD(mm) do { const GAS unsigned long long* xb = (const GAS unsigned long long*)(X2 + (size_t)(mm) * D) + lane; _Pragma("unroll") for (int j = 0; j < 4; ++j) nh[j] = xb[64 * j]; } while (0)
    if (gw < M) FN_LOAD(gw);
    for (int m = gw; m < M; m += NGW) {
        f32x4 v[4]; float ss = 0.f;
#pragma unroll
        for (int j = 0; j < 4; ++j) { const unsigned long long w = nh[j]; const unsigned lo = (unsigned)w, hi = (unsigned)(w >> 32); v[j] = (f32x4){h_lo(lo), h_hi(lo), h_lo(hi), h_hi(hi)};
            ss += (v[j].x * v[j].x + v[j].y * v[j].y) + (v[j].z * v[j].z + v[j].w * v[j].w); }
        if (m + NGW < M) FN_LOAD(m + NGW);
        const float rstd = 1.f / sqrtf(wave_sum(ss) * (1.f / D) + RMS_EPS);
        GAS f32x4* xr = (GAS f32x4*)(C.out + (size_t)m * D) + lane;
#pragma unroll
        for (int j = 0; j < 4; ++j) xr[64 * j] = v[j] * rstd * gv[j];
    }
}
#undef FN_LOAD
typedef float f32x16m __attribute__((ext_vector_type(16)));
typedef _Float16 h8m __attribute__((ext_vector_type(8))); typedef _Float16 h2m __attribute__((ext_vector_type(2))); typedef float f2m __attribute__((ext_vector_type(2)));
__device__ __forceinline__ unsigned pkh2(float lo, float hi) { const f2m v = {lo, hi}; return __builtin_bit_cast(unsigned, __builtin_convertvector(v, h2m)); }
__device__ __forceinline__ float hlo(unsigned w) { return (float)__builtin_bit_cast(h2m, w)[0]; }
__device__ __forceinline__ float hhi(unsigned w) { return (float)__builtin_bit_cast(h2m, w)[1]; }
#define MFMA_H(a, b, c) __builtin_amdgcn_mfma_f32_32x32x16_f16(__builtin_bit_cast(h8m, (a)), __builtin_bit_cast(h8m, (b)), (c), 0, 0, 0)
typedef short s16x4m __attribute__((ext_vector_type(4)));
__device__ __forceinline__ int crow_m(int reg, int hh) { return (reg & 3) + 8 * (reg >> 2) + 4 * hh; }
__device__ __forceinline__ s16x4m tr4(const LAS unsigned char* p) { return __builtin_bit_cast(s16x4m, __builtin_amdgcn_ds_read_tr16_b64_v4i16((LAS s16x4m*)p)); }
__device__ __forceinline__ bf16x8 tr_frag(const LAS unsigned char* base, int stride, int row0, int col0, int lane, int hmul, int rstep) {
    const int hh = lane >> 5, blk = (lane >> 4) & 1, q = (lane & 15) >> 2, p = lane & 3;
    const LAS unsigned char* a = base + (row0 + hmul * hh + q) * stride + (col0 + 16 * blk + 4 * p) * 2;
    const s16x4m lo = tr4(a), hi = tr4(a + rstep * stride);
    return (bf16x8){lo[0], lo[1], lo[2], lo[3], hi[0], hi[1], hi[2], hi[3]};
}
__device__ __forceinline__ void mlstm_scan_phase(const Ctx& C) {
    const int lane = threadIdx.x & 63, gw = C.bid * NWAVES + __builtin_amdgcn_readfirstlane((int)threadIdx.x >> 6), NGW = C.G * NWAVES;
    const float* LI = (const float*)(C.ws + WS_LI); const float* LF = (const float*)(C.ws + WS_LF);
    float* GB = (float*)(C.ws + WS_GB); float* GE = (float*)(C.ws + WS_GE); float* GU = (float*)(C.ws + WS_GU); float* CHA = (float*)(C.ws + WS_CHA); float* CHE = (float*)(C.ws + WS_CHE);
    for (int id = gw; id < 2048; id += NGW) { const int bh = id >> 7, c = id & 127, b = bh >> 3, h = bh & 7; const size_t r0 = (size_t)b * SEQ + c * 128 + 2 * lane;
        const float lf0 = LF[r0 * 8 + h], lf1 = LF[(r0 + 1) * 8 + h], li0 = LI[r0 * 8 + h], li1 = LI[(r0 + 1) * 8 + h];
        const float ps = lf0 + lf1; float x = ps;
#pragma unroll
        for (int o = 1; o < 64; o <<= 1) { const float y = __shfl_up(x, o); if (lane >= o) x += y; }
        const float b0 = (x - ps) + lf0, b1 = x, e0 = li0 - b0, e1 = li1 - b1;
        float y = fmaxf(e0, e1);
#pragma unroll
        for (int o = 1; o < 64; o <<= 1) { const float z = __shfl_up(y, o); if (lane >= o) y = fmaxf(y, z); }
        float prev = __shfl_up(y, 1); if (lane == 0) prev = -INFINITY;
        const float u0 = fmaxf(prev, e0), u1 = fmaxf(u0, e1);
        const size_t o2 = (size_t)id * 128 + 2 * lane;
        *(float2*)(GB + o2) = make_float2(b0, b1); *(float2*)(GE + o2) = make_float2(e0, e1); *(float2*)(GU + o2) = make_float2(u0, u1);
        if (lane == 63) { CHA[id] = b1; CHE[id] = u1; }
    }
}
__device__ __forceinline__ void mlstm_dc_phase(const Ctx& C) {
    const int tid = threadIdx.x, lane = tid & 63, wave = __builtin_amdgcn_readfirstlane(tid >> 6);
    const bf16* P = (const bf16*)(C.ws + WS_PROJ); bf16* DC = (bf16*)(C.ws + WS_OB); float* DN = (float*)(C.ws + WS_DN);
    const float* GE = (const float*)(C.ws + WS_GE); const float* CHE = (const float*)(C.ws + WS_CHE);
    LAS unsigned char* Ks = C.lds; LAS unsigned char* Vs = C.lds + 18432; LAS float* wsm = (LAS float*)(C.lds + 53248);
    v4u pk[2], pv[4]; float pge = 0.f, pche = 0.f;
#define M3_LOAD(u_) do { const int bh_ = (u_) >> 7, c_ = (u_) & 127, b_ = bh_ >> 3, h_ = bh_ & 7; const size_t r0_ = (size_t)b_ * SEQ + c_ * 128; \
        _Pragma("unroll") for (int i = 0; i < 2; ++i) { const int idx = tid + 512 * i, r = idx >> 3, ch = idx & 7; pk[i] = *(const v4u*)(P + (size_t)16777216 + (size_t)(u_) * 8192 + r * 64 + ch * 8); } \
        _Pragma("unroll") for (int i = 0; i < 4; ++i) { const int idx = tid + 512 * i, r = idx >> 4, ch = idx & 15; pv[i] = *(const v4u*)(P + (size_t)33554432 + (size_t)(u_) * 16384 + r * 128 + ch * 8); } \
        pche = CHE[(u_)]; if (tid < 128) pge = GE[(size_t)(u_) * 128 + tid]; } while (0)
    int unit = C.bid; if (unit < 2048) M3_LOAD(unit);
    while (unit < 2048) {
        if (tid < 128) wsm[tid] = __expf(pge - pche);
#pragma unroll
        for (int i = 0; i < 2; ++i) { const int idx = tid + 512 * i, r = idx >> 3, ch = idx & 7; *(LAS v4u*)(Ks + r * 144 + ch * 16) = pk[i]; }
        __syncthreads();
#pragma unroll
        for (int i = 0; i < 4; ++i) { const int idx = tid + 512 * i, r = idx >> 4, ch = idx & 15; const v4u v = pv[i]; const float w = wsm[r]; v4u o;
            o.x = pkh2(hlo(v.x) * w, hhi(v.x) * w); o.y = pkh2(hlo(v.y) * w, hhi(v.y) * w); o.z = pkh2(hlo(v.z) * w, hhi(v.z) * w); o.w = pkh2(hlo(v.w) * w, hhi(v.w) * w);
            *(LAS v4u*)(Vs + r * 272 + ch * 16) = o; }
        __syncthreads();
        const int cur = unit; unit += C.G; if (unit < 2048) M3_LOAD(unit);
        { const int db = wave >> 2, eb = wave & 3, r = lane & 31, hh = lane >> 5; f32x16m acc = {};
#pragma unroll
          for (int ks = 0; ks < 8; ++ks) { const bf16x8 a = tr_frag(Ks, 144, 16 * ks, 32 * db, lane, 8, 4), bb = tr_frag(Vs, 272, 16 * ks, 32 * eb, lane, 8, 4);
              acc = MFMA_H(a, bb, acc); }
          bf16* o = DC + (size_t)cur * 8192 + (size_t)(32 * eb + r) * 64 + 32 * db + 4 * hh;
#pragma unroll
          for (int g = 0; g < 4; ++g) { unsigned long long w = (unsigned long long)pkh2(acc[4 * g], acc[4 * g + 1]) | ((unsigned long long)pkh2(acc[4 * g + 2], acc[4 * g + 3]) << 32); *(unsigned long long*)(o + 8 * g) = w; } }
        if (tid < 64) { float acc = 0.f; for (int s = 0; s < 128; ++s) acc += wsm[s] * (float)*(const LAS _Float16*)(Ks + s * 144 + tid * 2); DN[(size_t)cur * 64 + tid] = acc; }
        __syncthreads();
    }
#undef M3_LOAD
}
__device__ __forceinline__ void mlstm_state_phase(const Ctx& C) {
    const int tid = threadIdx.x;
    const bf16* DC = (const bf16*)(C.ws + WS_OB); bf16* CST = (bf16*)(C.ws + WS_OB + 64 * MiB); const float* DN = (const float*)(C.ws + WS_DN); float* NS = (float*)(C.ws + WS_NS);
    const float* CHA = (const float*)(C.ws + WS_CHA); const float* CHE = (const float*)(C.ws + WS_CHE); float* CHM = (float*)(C.ws + WS_CHM);
    LAS float* wold = (LAS float*)(C.lds); LAS float* scl = wold + 128; LAS float* aa = scl + 128; LAS float* ee = aa + 128;
    for (int vb = C.bid; vb < 256; vb += C.G) { const int bh = vb >> 4, part = vb & 15;
        if (tid < 128) { aa[tid] = CHA[bh * 128 + tid]; ee[tid] = CHE[bh * 128 + tid]; }
        __syncthreads();
        if (tid < 64) { const float a0 = aa[2 * tid], e0 = ee[2 * tid], a1 = aa[2 * tid + 1], e1 = ee[2 * tid + 1];
            float A = a0 + a1, B = fmaxf(e0 + a0 + a1, e1 + a1);
#pragma unroll
            for (int o = 1; o < 64; o <<= 1) { const float Ap = __shfl_up(A, o), Bp = __shfl_up(B, o); if (tid >= o) { B = fmaxf(Bp + A, B); A = Ap + A; } }
            float Ae = __shfl_up(A, 1), Be = __shfl_up(B, 1); if (tid == 0) { Ae = 0.f; Be = -INFINITY; }
            const float m0 = fmaxf(0.f + Ae, Be), mx0 = fmaxf(m0, e0), m1 = a0 + mx0, mx1 = fmaxf(m1, e1);
            wold[2 * tid] = __expf(m0 - mx0); scl[2 * tid] = __expf(e0 - mx0); wold[2 * tid + 1] = __expf(m1 - mx1); scl[2 * tid + 1] = __expf(e1 - mx1);
            if (part == 0) { CHM[bh * 128 + 2 * tid] = m0; CHM[bh * 128 + 2 * tid + 1] = m1; } }
        __syncthreads();
        { const size_t idx = (size_t)part * 512 + tid; const bf16* dc = DC + (size_t)bh * 128 * 8192 + idx; bf16* cs = CST + (size_t)bh * 128 * 8192 + idx; float cv = 0.f;
#pragma unroll 16
          for (int c = 0; c < 128; ++c) { const float d = (float)__builtin_bit_cast(_Float16, dc[(size_t)c * 8192]); cs[(size_t)c * 8192] = __builtin_bit_cast(unsigned short, (_Float16)fminf(fmaxf(cv, -60000.f), 60000.f)); cv = wold[c] * cv + scl[c] * d; } }
        if (part == 0 && tid < 64) { const float* dn = DN + (size_t)bh * 128 * 64 + tid; float* ns = NS + (size_t)bh * 128 * 64 + tid; float nv = 0.f;
#pragma unroll 8
          for (int c = 0; c < 128; ++c) { const float d = dn[c * 64]; ns[c * 64] = nv; nv = wold[c] * nv + scl[c] * d; } }
        __syncthreads();
    }
#undef M5_LOAD
}
__device__ __forceinline__ void mlstm_out_phase(const Ctx& C) {
    const int tid = threadIdx.x, lane = tid & 63, wave = __builtin_amdgcn_readfirstlane(tid >> 6);
    const bf16* P = (const bf16*)(C.ws + WS_PROJ); bf16* Y = (bf16*)(C.ws + WS_XN); const bf16* CST = (const bf16*)(C.ws + WS_OB + 64 * MiB); const float* NS = (const float*)(C.ws + WS_NS);
    const float* GB = (const float*)(C.ws + WS_GB); const float* GE = (const float*)(C.ws + WS_GE); const float* GU = (const float*)(C.ws + WS_GU); const float* CHM = (const float*)(C.ws + WS_CHM);
    LAS unsigned char* Qs = C.lds; LAS unsigned char* Ks = C.lds + 18432; LAS unsigned char* Vs = C.lds + 36864; LAS unsigned char* Cts = C.lds + 71680;
    LAS float* e2 = (LAS float*)(C.lds + 90112); LAS float* M2 = e2 + 128; LAS float* wint = M2 + 128; LAS float* flr = wint + 128; LAS float* nsl = flr + 128; LAS float* invw = nsl + 64 + wave * 32;
    LAS float* Hs = (LAS float*)(C.lds);
    v4u pq[2], pkk[2], pc[2], pv[4], pog[4]; float pe = 0.f, pu = 0.f, pb = 0.f, pns = 0.f, pmc = 0.f;
#define M5_LOAD(u_) do { const int bh_ = (u_) >> 7, c_ = (u_) & 127, b_ = bh_ >> 3, h_ = bh_ & 7; const size_t r0_ = (size_t)b_ * SEQ + c_ * 128; \
        _Pragma("unroll") for (int i = 0; i < 2; ++i) { const int idx = tid + 512 * i, r = idx >> 3, ch = idx & 7; const bf16* src = P + (size_t)(u_) * 8192 + r * 64 + ch * 8; \
            pq[i] = *(const v4u*)(src); pkk[i] = *(const v4u*)(src + 16777216); pc[i] = *(const v4u*)(CST + (size_t)(u_) * 8192 + r * 64 + ch * 8); } \
        _Pragma("unroll") for (int i = 0; i < 4; ++i) { const int idx = tid + 512 * i, r = idx >> 4, ch = idx & 15; pv[i] = *(const v4u*)(P + (size_t)33554432 + (size_t)(u_) * 16384 + r * 128 + ch * 8); } \
        pmc = CHM[(u_)]; if (tid < 128) { const size_t gi = (size_t)(u_) * 128 + tid; pe = GE[gi]; pu = GU[gi]; pb = GB[gi]; } else if (tid < 192) pns = NS[(size_t)(u_) * 64 + tid - 128]; } while (0)
    int unit = C.bid; if (unit < 2048) M5_LOAD(unit);
    while (unit < 2048) { const int bh = unit >> 7, c = unit & 127, b = bh >> 3, h = bh & 7; const size_t row0 = (size_t)b * SEQ + c * 128;
        { const float mc = pmc;
          if (tid < 128) { const float Mt = fmaxf(mc, pu); e2[tid] = pe * LOG2E; M2[tid] = Mt * LOG2E; wint[tid] = __expf(mc - Mt); flr[tid] = __expf(-(pb + Mt)); }
          else if (tid < 192) nsl[tid - 128] = pns; }
#pragma unroll
        for (int i = 0; i < 2; ++i) { const int idx = tid + 512 * i, r = idx >> 3, ch = idx & 7; *(LAS v4u*)(Qs + r * 144 + ch * 16) = pq[i]; *(LAS v4u*)(Ks + r * 144 + ch * 16) = pkk[i]; *(LAS v4u*)(Cts + r * 144 + ch * 16) = pc[i]; }
#pragma unroll
        for (int i = 0; i < 4; ++i) { const int idx = tid + 512 * i, r = idx >> 4, ch = idx & 15; *(LAS v4u*)(Vs + r * 272 + ch * 16) = pv[i]; }
        __syncthreads();
        { const int nxt = unit + C.G; if (nxt < 2048) M5_LOAD(nxt); }
        const int tb = wave & 3, eh = wave >> 2, r = lane & 31, hh = lane >> 5;
        f32x16m acc[2]; acc[0] = f32x16m{}; acc[1] = f32x16m{};
        bf16x8 qf[4];
#pragma unroll
        for (int kd = 0; kd < 4; ++kd) qf[kd] = *(const LAS bf16x8*)(Qs + (32 * tb + r) * 144 + (16 * kd + 8 * hh) * 2);
#pragma unroll
        for (int kd = 0; kd < 4; ++kd)
#pragma unroll
            for (int j = 0; j < 2; ++j) { const bf16x8 cf = *(const LAS bf16x8*)(Cts + (64 * eh + 32 * j + r) * 144 + (16 * kd + 8 * hh) * 2); acc[j] = MFMA_H(qf[kd], cf, acc[j]); }
#pragma unroll
        for (int g = 0; g < 4; ++g) { const f32x4 w4 = *(const LAS f32x4*)(wint + 32 * tb + 8 * g + 4 * hh);
#pragma unroll
            for (int i = 0; i < 4; ++i) { acc[0][4 * g + i] *= w4[i]; acc[1][4 * g + i] *= w4[i]; } }
        float qn = 0.f;
#pragma unroll
        for (int c4 = 0; c4 < 4; ++c4) { const v4u qv = *(const LAS v4u*)(Qs + (32 * tb + r) * 144 + (32 * hh + 8 * c4) * 2); const f32x4 n0 = *(const LAS f32x4*)(nsl + 32 * hh + 8 * c4), n1 = *(const LAS f32x4*)(nsl + 32 * hh + 8 * c4 + 4);
            qn += hlo(qv.x) * n0[0] + hhi(qv.x) * n0[1] + hlo(qv.y) * n0[2] + hhi(qv.y) * n0[3] + hlo(qv.z) * n1[0] + hhi(qv.z) * n1[1] + hlo(qv.w) * n1[2] + hhi(qv.w) * n1[3]; }
        float den = 0.f; const float M2t = M2[32 * tb + r];
        for (int sb = 0; sb <= tb; ++sb) {
            f32x16m X = {};
#pragma unroll
            for (int kd = 0; kd < 4; ++kd) { const bf16x8 kf = *(const LAS bf16x8*)(Ks + (32 * sb + r) * 144 + (16 * kd + 8 * hh) * 2); X = MFMA_H(kf, qf[kd], X); }
#pragma unroll
            for (int g = 0; g < 4; ++g) { const f32x4 e4 = *(const LAS f32x4*)(e2 + 32 * sb + 8 * g + 4 * hh);
#pragma unroll
                for (int i = 0; i < 4; ++i) { const bool valid = (sb < tb) || (8 * g + 4 * hh + i <= r); const float p = valid ? X[4 * g + i] * __builtin_amdgcn_exp2f(e4[i] - M2t) : 0.f; den += p; X[4 * g + i] = p; } }
#pragma unroll
            for (int ks2 = 0; ks2 < 2; ++ks2) { u32x4m pw; pw.x = pkh2(X[8 * ks2], X[8 * ks2 + 1]); pw.y = pkh2(X[8 * ks2 + 2], X[8 * ks2 + 3]); pw.z = pkh2(X[8 * ks2 + 4], X[8 * ks2 + 5]); pw.w = pkh2(X[8 * ks2 + 6], X[8 * ks2 + 7]);
                const bf16x8 pf = __builtin_bit_cast(bf16x8, pw);
#pragma unroll
                for (int j = 0; j < 2; ++j) { const bf16x8 vf = tr_frag(Vs, 272, 32 * sb + 16 * ks2, 64 * eh + 32 * j, lane, 4, 8); acc[j] = MFMA_H(pf, vf, acc[j]); } }
        }
        { const auto rr = __builtin_amdgcn_permlane32_swap(__float_as_uint(den), __float_as_uint(den), false, false); den = __uint_as_float(rr[0]) + __uint_as_float(rr[1]);
          const auto r2 = __builtin_amdgcn_permlane32_swap(__float_as_uint(qn), __float_as_uint(qn), false, false); qn = __uint_as_float(r2[0]) + __uint_as_float(r2[1]); }
        const float denT = wint[32 * tb + r] * qn + den, invv = 1.f / fmaxf(fabsf(denT), flr[32 * tb + r]);
        if (hh == 0) invw[r] = invv;
        LDS_WAIT();
#pragma unroll
        for (int g = 0; g < 4; ++g) { const f32x4 i4 = *(const LAS f32x4*)(invw + 8 * g + 4 * hh);
#pragma unroll
            for (int i = 0; i < 4; ++i) { acc[0][4 * g + i] *= i4[i]; acc[1][4 * g + i] *= i4[i]; } }
#pragma unroll
        for (int i = 0; i < 4; ++i) { const int idx = tid + 512 * i, t = idx >> 4, ch = idx & 15; pog[i] = *(const v4u*)(P + (size_t)67108864 + (size_t)unit * 16384 + t * 128 + ch * 8); }
        __syncthreads();
#pragma unroll
        for (int j = 0; j < 2; ++j)
#pragma unroll
            for (int reg = 0; reg < 16; ++reg) Hs[(32 * tb + crow_m(reg, hh)) * 132 + 64 * eh + 32 * j + r] = acc[j][reg];
        __syncthreads();
#pragma unroll
        for (int i = 0; i < 4; ++i) { const int idx = tid + 512 * i, t = idx >> 4, ch = idx & 15; const f32x4 h0 = *(const LAS f32x4*)(Hs + t * 132 + ch * 8), h1 = *(const LAS f32x4*)(Hs + t * 132 + ch * 8 + 4);
            const v4u gg = pog[i]; v4u o;
            o.x = pk2(bflo(gg.x) * h0[0], bfhi(gg.x) * h0[1]); o.y = pk2(bflo(gg.y) * h0[2], bfhi(gg.y) * h0[3]); o.z = pk2(bflo(gg.z) * h1[0], bfhi(gg.z) * h1[1]); o.w = pk2(bflo(gg.w) * h1[2], bfhi(gg.w) * h1[3]);
            *(v4u*)(Y + (row0 + t) * 1024 + h * 128 + ch * 8) = o; }
        unit += C.G;
        __syncthreads();
    }
#undef M5_LOAD
}
#ifndef WGM_PROJ
#define WGM_PROJ 2
#endif
#ifndef WGM_OUT
#define WGM_OUT 2
#endif
struct Args { const float* in[17]; float* out; unsigned char* ws; int ph_lo, ph_hi; };
__global__ void __launch_bounds__(NWAVES * 64, 2) fwd_kernel(Args args) {
    extern __shared__ __attribute__((aligned(16))) unsigned char lds[];
    Ctx C;
    C.lds = (LAS unsigned char*)lds; C.ldsg = (char*)lds; C.G = gridDim.x; C.bid = blockIdx.x;
    C.out = args.out; C.ws = args.ws;
    volatile LAS unsigned* MISC = (volatile LAS unsigned*)(C.lds + MISC_OFF);
    gu32* ctl = (gu32*)(C.ws + WS_CTL);
    for (int u = (int)threadIdx.x; u < (LDS_BYTES - LDSCTL_OFF) / 4; u += NWAVES * 64) ((LAS unsigned*)(C.lds + LDSCTL_OFF))[u] = 0u;
    __syncthreads();
    XcdBarrier bar; bar.bar = (unsigned*)(ctl + CW_BAR); bar.x = 0; bar.st = nullptr;
    if (MK_ONE_LAUNCH) bar = xcd_barrier_post((unsigned*)(ctl + CW_BAR), MISC + 8);
#define GRID_BAR() do { if (MK_ONE_LAUNCH) xcd_barrier(bar); } while (0)
    const int lo = args.ph_lo, hi = args.ph_hi;
#ifndef PH_MASK
#define PH_MASK 0xffff
#endif
#define IN(k) (((PH_MASK >> (k)) & 1) && lo <= (k) && (k) < hi)
#define BOTH(k) (IN(k) && IN((k) + 1))
    bf16* XN = (bf16*)(C.ws + WS_XN); bf16* PROJ = (bf16*)(C.ws + WS_PROJ);
    bf16* X1B = (bf16*)C.out;
    bf16* X2B = (bf16*)(C.ws + WS_OB);

    if (IN(0)) { prologue_weights(C); __syncthreads();
        norm_gate_phase<8, false>(C, kin(0), kin(3), ATTN_IN, 1536, kin(2), kin(4), nullptr, XN, (float*)(C.ws + WS_LOGF), nullptr, (float*)(C.ws + WS_RSTD));
        if (BOTH(0)) GRID_BAR(); }
    if (IN(1)) { cumsum_phase(C);
      {
        pg8::Gemm g{XN, (const bf16*)(C.ws + WS_WIN0), M, NPJ, D}; pg8::StaticOrder S; S.init(M, NPJ, C.G, C.bid, WGM_PROJ);
        pg8::EpiProj0 E{PROJ, (const float*)(C.ws + WS_ROPE), C2, (unsigned*)(ctl + CW_NRM), (bf16*)(C.ws + WS_OB + 32 * MiB), (bf16*)(C.ws + WS_OB + 64 * MiB), (const float*)(C.ws + WS_RSTD)};
        pg8::gemm_phase<pg8::EpiProj0, pg8::StaticOrder, true, true>(C.lds + RING_OFF, g, S, E);
        if (BOTH(1)) GRID_BAR(); } }
    if (IN(2)) { attn_tuned_phase(C);
        if (BOTH(2)) GRID_BAR(); }
    if (IN(4)) { pg8::Gemm g{XN, (const bf16*)(C.ws + WS_WOUT0), M, D, D}; pg8::StaticOrder S; S.init(M, D, C.G, C.bid, WGM_OUT);
        pg8::EpiResidF2B E{kin(0), X1B};
        pg8::gemm_phase<pg8::EpiResidF2B, pg8::StaticOrder, true, true>(C.lds + RING_OFF, g, S, E);
        if (BOTH(4)) GRID_BAR(); }
    if (IN(5)) { norm_gate_phase<16, true>(C, X1B, kin(12), ML_IN, 2048, kin(11), kin(13), kin(14), nullptr, (float*)(C.ws + WS_LI), (float*)(C.ws + WS_LF), (float*)(C.ws + WS_RSTD));
        if (BOTH(5)) GRID_BAR(); }
    if (IN(6)) { mlstm_scan_phase(C);
        pg8::Gemm g{X1B, (const bf16*)(C.ws + WS_WIN1), M, NPJ, D}; pg8::StaticOrder S; S.init(M, NPJ, C.G, C.bid, WGM_PROJ);
        pg8::EpiProj1 E{PROJ, (const float*)(C.ws + WS_RSTD)};
        pg8::gemm_phase<pg8::EpiProj1, pg8::StaticOrder, true, true, true>(C.lds + RING_OFF, g, S, E);
        if (BOTH(6)) GRID_BAR(); }
    {
    if (IN(7)) { mlstm_dc_phase(C); if (BOTH(7)) GRID_BAR(); }
    if (IN(8)) {
        mlstm_state_phase(C);
        if (BOTH(8)) GRID_BAR(); }
    if (IN(9)) {
        mlstm_out_phase(C);
        if (BOTH(9)) GRID_BAR(); }
    }
    if (IN(10)) { pg8::Gemm g{XN, (const bf16*)(C.ws + WS_WOUT1), M, D, D}; pg8::StaticOrder S; S.init(M, D, C.G, C.bid, WGM_OUT);
        pg8::EpiResidB2B E{X1B, X2B};
        pg8::gemm_phase<pg8::EpiResidB2B, pg8::StaticOrder, true, true>(C.lds + RING_OFF, g, S, E);
        if (BOTH(10)) GRID_BAR(); }
    if (IN(11)) { final_norm_phase(C, X2B); }
#undef IN
#undef BOTH
}

extern "C" void kernel_launch(void* const* d_in, const int* in_sizes, int n_in, void* d_out, int out_size, void* d_ws, size_t ws_size, hipStream_t stream) {
    static int grid = 0;
    if (grid == 0) {
        if (n_in != 17 || in_sizes[0] != M * D || out_size != M * D || ws_size < WS_END) { fprintf(stderr, "kernel_launch: unexpected shapes (n_in %d, in0 %d, out %d, ws %zu < %zu); nothing launched\n", n_in, n_in > 0 ? in_sizes[0] : -1, out_size, ws_size, (size_t)WS_END); grid = -1; return; }
        int dev = 0, cus = 0, per_cu = 0;
        if (hipGetDevice(&dev) != hipSuccess || hipDeviceGetAttribute(&cus, hipDeviceAttributeMultiprocessorCount, dev) != hipSuccess) { grid = -1; return; }
        if (hipFuncSetAttribute((const void*)fwd_kernel, hipFuncAttributeMaxDynamicSharedMemorySize, LDS_BYTES) != hipSuccess) { fprintf(stderr, "kernel_launch: hipFuncSetAttribute failed\n"); grid = -1; return; }
        if (hipOccupancyMaxActiveBlocksPerMultiprocessor(&per_cu, (const void*)fwd_kernel, NWAVES * 64, LDS_BYTES) != hipSuccess || per_cu < 1) fprintf(stderr, "kernel_launch: occupancy query reports %d\n", per_cu);
        (void)hipGetLastError();
        grid = cus;
    }
    if (grid < 0) return;
    if (hipMemsetAsync((char*)d_ws + WS_CTL, 0, CTL_ZERO_BYTES, stream) != hipSuccess) return;
    Args a{};
    for (int i = 0; i < 17; ++i) a.in[i] = (const float*)d_in[i];
    a.out = (float*)d_out; a.ws = (unsigned char*)d_ws;
    if (MK_ONE_LAUNCH) { a.ph_lo = 0; a.ph_hi = NPHASE; hipLaunchKernelGGL(fwd_kernel, dim3(grid), dim3(NWAVES * 64), LDS_BYTES, stream, a); }
    else for (int p = 0; p < NPHASE; ++p) { a.ph_lo = p; a.ph_hi = p + 1; hipLaunchKernelGGL(fwd_kernel, dim3(grid), dim3(NWAVES * 64), LDS_BYTES, stream, a); }
}
```

```cpp
#include <hip/hip_runtime.h>
#include <cstdio>
#include <cstdint>
namespace pg8 {
#define PG8_LAS __attribute__((address_space(3)))
typedef unsigned short bf16_t;
typedef short bf16x8 __attribute__((ext_vector_type(8)));
typedef float f32x4 __attribute__((ext_vector_type(4)));
typedef unsigned u32x4 __attribute__((ext_vector_type(4)));
constexpr int BM = 256, BK = 64, HALF = 128, HTB = HALF * BK * 2  , STAGE_BYTES = 8 * HTB, NXCD = 8, WGM = 2;

__host__ __device__ __forceinline__ int lds_byte(int r, int c) { const int st = (r >> 4) * 2 + (c >> 5), rr = r & 15, cc = c & 31, ob = rr * 64 + cc * 2; return st * 1024 + (ob ^ (((ob >> 9) & 1) << 5)); }
__host__ __device__ __forceinline__ void stage_rc(int b, int& R, int& C) { const int st = b / 1024, sb = b % 1024, swz = sb ^ (((sb >> 9) & 1) << 5); R = (st >> 1) * 16 + swz / 64; C = (st & 1) * 32 + (swz % 64) / 2; }
__host__ __device__ __forceinline__ int perm32(int rho) { const int n = rho >> 4, i = rho & 15; return 8 * (i >> 2) + 4 * n + (i & 3); }

struct Unit { int pm, pn; };
struct Gemm { const bf16_t* A; const bf16_t* Bt; int M, N, K; };

struct StaticOrder {
    int nM, nN, nwg, G, c, wgm;
    __host__ __device__ void init(int M, int N, int G_, int c_, int wgm_ = WGM) { nM = M / BM; nN = N / BM; nwg = nM * nN; G = G_; c = c_; wgm = wgm_; }
    __host__ __device__ bool next(int i, Unit& u) const {
        const long L = (long)i * G + c; if (L >= nwg) return false;
        int wgid = (int)L; { const int q = nwg / NXCD, r = nwg % NXCD, xcd = wgid % NXCD, off = wgid / NXCD; wgid = (xcd < r ? xcd * (q + 1) : r * (q + 1) + (xcd - r) * q) + off; }
        const int nig = wgm * nN, gid = wgid / nig, fm = gid * wgm, gsz = (nM - fm) < wgm ? (nM - fm) : wgm;
        u.pm = fm + ((wgid % nig) % gsz); u.pn = (wgid % nig) / gsz; return true;
    }
    __device__ __forceinline__ void a_ready(const Unit&) const {}
    __device__ __forceinline__ void done(const Unit&) const {}
};

__device__ __forceinline__ unsigned cvt_pk_bf16(float lo, float hi) { unsigned r; asm volatile("v_cvt_pk_bf16_f32 %0, %1, %2" : "=v"(r) : "v"(lo), "v"(hi)); return r; }
typedef float f32x2 __attribute__((ext_vector_type(2)));
__device__ __forceinline__ f32x2 gelu_pk(f32x2 v) {
    const f32x2 av = __builtin_elementwise_abs(v), d = av * 0.2316418882f + 1.0f;
    f32x2 t; t.x = __builtin_amdgcn_rcpf(d.x); t.y = __builtin_amdgcn_rcpf(d.y);
    f32x2 q = t * 0.5307027145f + (-0.7265760135f); q = q * t + 0.7107068705f; q = q * t + (-0.142248368f); q = q * t + 0.127414796f; q = q * t;
    const f32x2 s = (v * v) * (-0.72134752044f);
    f32x2 e; e.x = __builtin_amdgcn_exp2f(s.x); e.y = __builtin_amdgcn_exp2f(s.y);
    const f32x2 m = v * (q * e), r = v - m;
    f32x2 o; o.x = v.x < 0.f ? m.x : r.x; o.y = v.y < 0.f ? m.y : r.y; return o;
}

struct EpiProj0 {
    static constexpr bool PERM = true, AFTER_DRAIN = false;
    bf16_t* O; const float* rope; float c2; unsigned* nrm; bf16_t* KT; bf16_t* VT; const float* rstd;
    __device__ __forceinline__ void operator()(const f32x4 (&acc)[2][2][4][2], const Unit& u, int wr, int wc, int fr, int fq) const {
        const int row0 = u.pm * BM + wr * 64 + fr, col0 = u.pn * BM + wc * 32 + 8 * fq, pn = u.pn;
        const bool do_rope = (pn >= 6 && pn <= 9);
        const float sc = (pn <= 1 || pn == 6 || pn == 7) ? c2 : 1.f;
        const int i0 = 16 * (wc & 1) + 4 * fq;
        if (pn < 4 || (pn >= 6 && pn <= 9)) {
            float mx[2] = {0.f, 0.f};
#pragma unroll
            for (int ai = 0; ai < 2; ++ai)
#pragma unroll
                for (int m = 0; m < 4; ++m) { const float scr = sc * rstd[row0 + ai * HALF + m * 16];
#pragma unroll
                    for (int bj = 0; bj < 2; ++bj) { const f32x4 a = acc[ai][bj][m][0] * scr, b = acc[ai][bj][m][1] * scr;
                        float ss = (a[0] * a[0] + a[1] * a[1]) + (a[2] * a[2] + a[3] * a[3]) + (b[0] * b[0] + b[1] * b[1]) + (b[2] * b[2] + b[3] * b[3]);
                        ss += __shfl_xor(ss, 16); ss += __shfl_xor(ss, 32); mx[bj] = fmaxf(mx[bj], ss); } }
#pragma unroll
            for (int bj = 0; bj < 2; ++bj) { float v = mx[bj];
#pragma unroll
                for (int o = 1; o < 16; o <<= 1) v = fmaxf(v, __shfl_xor(v, o));
                if (fr == 0 && fq == 0) { const int dif = pn >= 6 ? 1 : 0, isk = (dif ? pn - 6 : pn) >> 1, b = u.pm >> 6, head = (pn & 1) * 4 + 2 * bj + (wc >> 1), half = wc & 1;
                    __hip_atomic_fetch_max(nrm + dif * 64 + ((isk * 2 + b) * 8 + head) * 2 + half, __builtin_bit_cast(unsigned, v), __ATOMIC_RELAXED, __HIP_MEMORY_SCOPE_AGENT); } }
        }
#pragma unroll
        for (int ai = 0; ai < 2; ++ai)
#pragma unroll
            for (int m = 0; m < 4; ++m) { const int row = row0 + ai * HALF + m * 16; const float scr = sc * rstd[row];
                f32x4 cs0 = {1.f, 0.f, 1.f, 0.f}, cs1 = {1.f, 0.f, 1.f, 0.f};
                if (do_rope) { const f32x4* rp = (const f32x4*)(rope + (size_t)row * 64 + 2 * i0); cs0 = rp[0]; cs1 = rp[1]; }
                const f32x4 c = {cs0[0], cs0[2], cs1[0], cs1[2]}, s = {cs0[1], cs0[3], cs1[1], cs1[3]};
#pragma unroll
                for (int bj = 0; bj < 2; ++bj) { f32x4 v0 = acc[ai][bj][m][0], v1 = acc[ai][bj][m][1];
                    if (do_rope) { const f32x4 o0 = v0 * c - v1 * s, o1 = v0 * s + v1 * c; v0 = o0; v1 = o1; }
                    v0 = v0 * scr; v1 = v1 * scr; u32x4 w; w.x = cvt_pk_bf16(v0[0], v0[1]); w.y = cvt_pk_bf16(v0[2], v0[3]); w.z = cvt_pk_bf16(v1[0], v1[1]); w.w = cvt_pk_bf16(v1[2], v1[3]);
                    if (pn >= 8 && pn <= 11) { const int col = col0 + bj * HALF, b = row >> 14, tile = (row & 16383) >> 6, rin = row & 63;
                        if (pn <= 9) { const int cl = col - 2048, grp = cl >> 6, chunk = (cl & 63) >> 3; *(u32x4*)(KT + ((size_t)((b * 8 + grp) * 256 + tile) * 4096 + chunk * 512 + rin * 8)) = w; }
                        else { const int cl = col - 2560, hd = cl >> 7, dblk = (cl & 127) >> 5, cw = cl & 31; *(u32x4*)(VT + ((size_t)((b * 4 + hd) * 256 + tile) * 8192 + dblk * 2048 + rin * 32 + cw)) = w; } }
                    else *(u32x4*)(O + (size_t)row * 4096 + col0 + bj * HALF) = w; } }
    }
};
typedef _Float16 h2e __attribute__((ext_vector_type(2)));
__device__ __forceinline__ float hf_lo(unsigned w) { return (float)__builtin_bit_cast(h2e, w)[0]; }
__device__ __forceinline__ float hf_hi(unsigned w) { return (float)__builtin_bit_cast(h2e, w)[1]; }
__device__ __forceinline__ unsigned cvt_pk_f16(float lo, float hi) { const f32x2 v = {lo, hi}; return __builtin_bit_cast(unsigned, __builtin_convertvector(v, h2e)); }
struct EpiProj1 {
    static constexpr bool PERM = true, AFTER_DRAIN = false;
    bf16_t* O; const float* rstd;
    __device__ __forceinline__ void operator()(const f32x4 (&acc)[2][2][4][2], const Unit& u, int wr, int wc, int fr, int fq) const {
        const int row0 = u.pm * BM + wr * 64 + fr, col0 = u.pn * BM + wc * 32 + 8 * fq, pn = u.pn;
        const float sc0 = (pn == 2 || pn == 3) ? 0.125f : 1.f;
#pragma unroll
        for (int ai = 0; ai < 2; ++ai)
#pragma unroll
            for (int m = 0; m < 4; ++m) { const int row = row0 + ai * HALF + m * 16; const float sc = sc0 * rstd[row];
                const int b = row >> 14, chunk = (row & 16383) >> 7, rin = row & 127;
#pragma unroll
                for (int bj = 0; bj < 2; ++bj) { const f32x4 v0 = acc[ai][bj][m][0] * sc, v1 = acc[ai][bj][m][1] * sc; const int col = col0 + bj * HALF;
                    if (pn < 8) { u32x4 w; w.x = cvt_pk_f16(v0[0], v0[1]); w.y = cvt_pk_f16(v0[2], v0[3]); w.z = cvt_pk_f16(v1[0], v1[1]); w.w = cvt_pk_f16(v1[2], v1[3]);
                        if (pn < 4) { const int cl = col & 511, head = cl >> 6, d = cl & 63; *(u32x4*)(O + (size_t)(pn >> 1) * 16777216 + ((size_t)((b * 8 + head) * 128 + chunk) * 128 + rin) * 64 + d) = w; }
                        else { const int cl = col - 1024, head = cl >> 7, ev = cl & 127; *(u32x4*)(O + (size_t)33554432 + ((size_t)((b * 8 + head) * 128 + chunk) * 128 + rin) * 128 + ev) = w; } }
                    else {
                        const float g0 = v0[1] * __builtin_amdgcn_rcpf((1.f + __expf(-v0[0])) * (1.f + __expf(-v0[1]))), g1 = v0[3] * __builtin_amdgcn_rcpf((1.f + __expf(-v0[2])) * (1.f + __expf(-v0[3])));
                        const float g2 = v1[1] * __builtin_amdgcn_rcpf((1.f + __expf(-v1[0])) * (1.f + __expf(-v1[1]))), g3 = v1[3] * __builtin_amdgcn_rcpf((1.f + __expf(-v1[2])) * (1.f + __expf(-v1[3])));
                        typedef unsigned u32x2e __attribute__((ext_vector_type(2))); u32x2e gw; gw.x = cvt_pk_bf16(g0, g1); gw.y = cvt_pk_bf16(g2, g3);
                        const int jg = (col - 2048) >> 1, head = jg >> 7, ev = jg & 127;
                        *(u32x2e*)(O + (size_t)67108864 + ((size_t)((b * 8 + head) * 128 + chunk) * 128 + rin) * 128 + ev) = gw; } } }
    }
};
struct EpiResidF2B {
    static constexpr bool PERM = true, AFTER_DRAIN = false;
    const float* base; bf16_t* out;
    __device__ __forceinline__ void operator()(const f32x4 (&acc)[2][2][4][2], const Unit& u, int wr, int wc, int fr, int fq) const {
        const int row0 = u.pm * BM + wr * 64 + fr, col0 = u.pn * BM + wc * 32 + 8 * fq;
#pragma unroll
        for (int ai = 0; ai < 2; ++ai)
#pragma unroll
            for (int m = 0; m < 4; ++m) { const size_t p = (size_t)(row0 + ai * HALF + m * 16) * 1024 + col0;
#pragma unroll
                for (int bj = 0; bj < 2; ++bj) { const f32x4 v0 = *(const f32x4*)(base + p + bj * HALF) + acc[ai][bj][m][0], v1 = *(const f32x4*)(base + p + bj * HALF + 4) + acc[ai][bj][m][1];
                    u32x4 w; w.x = cvt_pk_f16(v0[0], v0[1]); w.y = cvt_pk_f16(v0[2], v0[3]); w.z = cvt_pk_f16(v1[0], v1[1]); w.w = cvt_pk_f16(v1[2], v1[3]);
                    *(u32x4*)(out + p + bj * HALF) = w; } }
    }
};
struct EpiResidB2B {
    static constexpr bool PERM = true, AFTER_DRAIN = false;
    const bf16_t* base; bf16_t* out;
    __device__ __forceinline__ void operator()(const f32x4 (&acc)[2][2][4][2], const Unit& u, int wr, int wc, int fr, int fq) const {
        const int row0 = u.pm * BM + wr * 64 + fr, col0 = u.pn * BM + wc * 32 + 8 * fq;
#pragma unroll
        for (int ai = 0; ai < 2; ++ai)
#pragma unroll
            for (int m = 0; m < 4; ++m) { const size_t p = (size_t)(row0 + ai * HALF + m * 16) * 1024 + col0;
#pragma unroll
                for (int bj = 0; bj < 2; ++bj) { const u32x4 b = *(const u32x4*)(base + p + bj * HALF);
                    const f32x4 b0 = {hf_lo(b.x), hf_hi(b.x), hf_lo(b.y), hf_hi(b.y)}, b1 = {hf_lo(b.z), hf_hi(b.z), hf_lo(b.w), hf_hi(b.w)};
                    const f32x4 v0 = b0 + acc[ai][bj][m][0], v1 = b1 + acc[ai][bj][m][1];
                    u32x4 w; w.x = cvt_pk_f16(v0[0], v0[1]); w.y = cvt_pk_f16(v0[2], v0[3]); w.z = cvt_pk_f16(v1[0], v1[1]); w.w = cvt_pk_f16(v1[2], v1[3]);
                    *(u32x4*)(out + p + bj * HALF) = w; } }
    }
};

typedef _Float16 h8g __attribute__((ext_vector_type(8)));
template <class Epi, class Sched, bool ALIGN_EPI = false, bool SP2 = false, bool F16 = false>
__device__ __forceinline__ void gemm_phase(PG8_LAS unsigned char* lds, const Gemm g, const Sched& S, const Epi& E) {
    const int tid = threadIdx.x, wid = __builtin_amdgcn_readfirstlane(tid >> 6), lane = tid & 63, wr = wid >> 2, wc = wid & 3, fr = lane & 15, fq = lane >> 4;
    const int K = g.K, nt = K / BK;
    unsigned voffA[2], voffB[2];
#pragma unroll
    for (int i = 0; i < 2; ++i) { int R, C; stage_rc(tid * 16 + i * 8192, R, C); const int Rb = Epi::PERM ? ((R & ~31) + perm32(R & 31)) : R;
        voffA[i] = (unsigned)(R * K + C) * 2u; voffB[i] = (unsigned)(Rb * K + C) * 2u; }
    const size_t kstep = (size_t)(BK * 2);
    const size_t hstep = (size_t)HALF * K * 2;
    const size_t tstep = 2 * hstep;
    const unsigned ldsw = (unsigned)wid * 1024u;
    const int aoff = lds_byte(wr * 64 + fr, fq * 8), boff = lds_byte(wc * 32 + fr, fq * 8);
#define PG8_SA(b, h) (((b) * 2 + (h)) * HTB)
#define PG8_SB(b, h) ((4 + (b) * 2 + (h)) * HTB)
#define PG8_STAGE(bufoff, gbase, voff) do { _Pragma("unroll") for (int _i = 0; _i < 2; ++_i) \
        __builtin_amdgcn_global_load_lds((const unsigned*)((const char*)(gbase) + (voff)[_i]), (PG8_LAS unsigned*)(lds + (bufoff) + ldsw + _i * 8192), 16, 0, 0); } while (0)
#define PG8_LDA(dst, b, h) do { _Pragma("unroll") for (int m = 0; m < 4; ++m) _Pragma("unroll") for (int k = 0; k < 2; ++k) dst[m][k] = *(const PG8_LAS bf16x8*)(lds + PG8_SA(b, h) + aoff + m * 2048 + k * 1024); } while (0)
#define PG8_LDB(dst, b, h) do { _Pragma("unroll") for (int n = 0; n < 2; ++n) _Pragma("unroll") for (int k = 0; k < 2; ++k) dst[n][k] = *(const PG8_LAS bf16x8*)(lds + PG8_SB(b, h) + boff + n * 2048 + k * 1024); } while (0)
#define PG8_MMA(ai, bj, At, Bt) do { __builtin_amdgcn_s_setprio(1); _Pragma("unroll") for (int m = 0; m < 4; ++m) _Pragma("unroll") for (int n = 0; n < 2; ++n) _Pragma("unroll") for (int k = 0; k < 2; ++k) \
        acc[ai][bj][m][n] = F16 ? __builtin_amdgcn_mfma_f32_16x16x32_f16(__builtin_bit_cast(h8g, Bt[n][k]), __builtin_bit_cast(h8g, At[m][k]), acc[ai][bj][m][n], 0, 0, 0) : __builtin_amdgcn_mfma_f32_16x16x32_bf16(Bt[n][k], At[m][k], acc[ai][bj][m][n], 0, 0, 0); __builtin_amdgcn_s_setprio(0); } while (0)
#define PG8_WAIT_V(n) asm volatile("s_waitcnt vmcnt(" #n ")" ::: "memory")
#define PG8_WAIT_L(n) asm volatile("s_waitcnt lgkmcnt(" #n ")" ::: "memory")
#define PG8_BAR __builtin_amdgcn_s_barrier()
#define PG8_SCHED __builtin_amdgcn_sched_barrier(0)
    Unit cur, nxt; int ui = 0;
    if (!S.next(0, cur)) return;
    f32x4 acc[2][2][4][2];
#pragma unroll
    for (int a = 0; a < 2; ++a)
#pragma unroll
        for (int b = 0; b < 2; ++b)
#pragma unroll
            for (int m = 0; m < 4; ++m)
#pragma unroll
                for (int n = 0; n < 2; ++n) acc[a][b][m][n] = (f32x4){0.f, 0.f, 0.f, 0.f};
    bf16x8 At[4][2], B0[2][2], B1[2][2];
    const char* cA = (const char*)g.A + (size_t)cur.pm * tstep; const char* cB = (const char*)g.Bt + (size_t)cur.pn * tstep;
    S.a_ready(cur);
    if constexpr (SP2) {
        PG8_STAGE(PG8_SB(0, 0), cB, voffB); PG8_STAGE(PG8_SB(0, 1), cB + hstep, voffB); PG8_STAGE(PG8_SA(0, 0), cA, voffA); PG8_STAGE(PG8_SA(0, 1), cA + hstep, voffA);
        if (wr == 1) PG8_BAR;
        PG8_WAIT_V(2); PG8_BAR;
        PG8_STAGE(PG8_SB(1, 0), cB + kstep, voffB); PG8_STAGE(PG8_SA(1, 0), cA + kstep, voffA); PG8_STAGE(PG8_SB(1, 1), cB + hstep + kstep, voffB);
        PG8_WAIT_V(6); PG8_BAR;
    } else {
        PG8_STAGE(PG8_SB(0, 0), cB, voffB); PG8_STAGE(PG8_SA(0, 0), cA, voffA); PG8_STAGE(PG8_SB(0, 1), cB + hstep, voffB); PG8_STAGE(PG8_SA(0, 1), cA + hstep, voffA);
        if (wr == 1) PG8_BAR;
        PG8_WAIT_V(4); PG8_BAR;
        PG8_STAGE(PG8_SB(1, 0), cB + kstep, voffB); PG8_STAGE(PG8_SA(1, 0), cA + kstep, voffA); PG8_STAGE(PG8_SB(1, 1), cB + hstep + kstep, voffB);
        PG8_WAIT_V(6); PG8_BAR;
    }
    for (;;) {
        const bool has_next = S.next(ui + 1, nxt);
        const char* nA = has_next ? (const char*)g.A + (size_t)nxt.pm * tstep : cA; const char* nB = has_next ? (const char*)g.Bt + (size_t)nxt.pn * tstep : cB;
        for (int t = 0; t < nt; t += 2) {
            const bool last = (t == nt - 2);
            const char* a1 = cA + (size_t)(t + 1) * kstep;
            const char* a2 = last ? nA : cA + (size_t)(t + 2) * kstep; const char* b2 = last ? nB : cB + (size_t)(t + 2) * kstep;
            const char* a3 = a2 + kstep; const char* b3 = b2 + kstep;
            if (last && has_next) S.a_ready(nxt);
            if constexpr (SP2) {
            PG8_LDB(B0, 0, 0); PG8_LDB(B1, 0, 1); PG8_SCHED; PG8_LDA(At, 0, 0); PG8_STAGE(PG8_SA(1, 1), a1 + hstep, voffA);
            PG8_WAIT_V(8); PG8_WAIT_L(0); PG8_BAR; PG8_MMA(0, 0, At, B0); PG8_MMA(0, 1, At, B1); PG8_BAR; PG8_SCHED;
            PG8_LDA(At, 0, 1); PG8_STAGE(PG8_SB(0, 0), b2, voffB); PG8_STAGE(PG8_SB(0, 1), b2 + hstep, voffB); PG8_STAGE(PG8_SA(0, 0), a2, voffA);
            PG8_WAIT_V(8); PG8_WAIT_L(0); PG8_BAR; PG8_MMA(1, 0, At, B0); PG8_MMA(1, 1, At, B1); PG8_BAR; PG8_SCHED;
            PG8_LDB(B0, 1, 0); PG8_LDB(B1, 1, 1); PG8_SCHED; PG8_LDA(At, 1, 0); PG8_STAGE(PG8_SA(0, 1), a2 + hstep, voffA);
            PG8_WAIT_V(8); PG8_WAIT_L(0); PG8_BAR; PG8_MMA(0, 0, At, B0); PG8_MMA(0, 1, At, B1); PG8_BAR; PG8_SCHED;
            PG8_LDA(At, 1, 1); PG8_STAGE(PG8_SB(1, 0), b3, voffB); PG8_STAGE(PG8_SB(1, 1), b3 + hstep, voffB); PG8_STAGE(PG8_SA(1, 0), a3, voffA);
            PG8_WAIT_V(8); PG8_WAIT_L(0); PG8_BAR; PG8_MMA(1, 0, At, B0); PG8_MMA(1, 1, At, B1); PG8_BAR; PG8_SCHED;
            } else {
            PG8_LDB(B0, 0, 0); PG8_SCHED; PG8_LDA(At, 0, 0); PG8_STAGE(PG8_SA(1, 1), a1 + hstep, voffA);
            PG8_WAIT_L(8); PG8_BAR; PG8_WAIT_L(0); PG8_MMA(0, 0, At, B0); PG8_BAR; PG8_SCHED;
            PG8_LDB(B1, 0, 1); PG8_STAGE(PG8_SB(0, 0), b2, voffB);
            PG8_BAR; PG8_WAIT_L(0); PG8_MMA(0, 1, At, B1); PG8_BAR;
            PG8_LDA(At, 0, 1); PG8_STAGE(PG8_SA(0, 0), a2, voffA);
            PG8_BAR; PG8_WAIT_L(0); PG8_MMA(1, 0, At, B0); PG8_BAR; PG8_SCHED;
            PG8_STAGE(PG8_SB(0, 1), b2 + hstep, voffB);
            PG8_WAIT_V(6); PG8_BAR; PG8_MMA(1, 1, At, B1); PG8_BAR;
            PG8_LDB(B0, 1, 0); PG8_SCHED; PG8_LDA(At, 1, 0); PG8_STAGE(PG8_SA(0, 1), a2 + hstep, voffA);
            PG8_WAIT_L(8); PG8_BAR; PG8_WAIT_L(0); PG8_MMA(0, 0, At, B0); PG8_BAR; PG8_SCHED;
            PG8_LDB(B1, 1, 1); PG8_STAGE(PG8_SB(1, 0), b3, voffB);
            PG8_BAR; PG8_WAIT_L(0); PG8_MMA(0, 1, At, B1); PG8_BAR;
            PG8_LDA(At, 1, 1); PG8_STAGE(PG8_SA(1, 0), a3, voffA);
            PG8_BAR; PG8_WAIT_L(0); PG8_MMA(1, 0, At, B0); PG8_BAR; PG8_SCHED;
            PG8_STAGE(PG8_SB(1, 1), b3 + hstep, voffB);
            PG8_WAIT_V(6); PG8_BAR; PG8_MMA(1, 1, At, B1); PG8_BAR;
            }
        }
        if constexpr (ALIGN_EPI) { if (wr == 0) PG8_BAR; }
        if constexpr (!Epi::AFTER_DRAIN) { E(acc, cur, wr, wc, fr, fq); S.done(cur); }
        if (!has_next) break;
#pragma unroll
        for (int a = 0; a < 2; ++a)
#pragma unroll
            for (int b = 0; b < 2; ++b)
#pragma unroll
                for (int m = 0; m < 4; ++m)
#pragma unroll
                    for (int n = 0; n < 2; ++n) acc[a][b][m][n] = (f32x4){0.f, 0.f, 0.f, 0.f};
        cur = nxt; cA = nA; cB = nB; ++ui;
        if constexpr (ALIGN_EPI) { if (wr == 1) PG8_BAR; }
    }
    PG8_WAIT_V(0);
    if constexpr (!ALIGN_EPI) { if (wr == 0) PG8_BAR; }
    PG8_BAR;
    if constexpr (Epi::AFTER_DRAIN) { E.fused(acc, cur, wr, wc, fr, fq, lds, wid, lane); S.done(cur); }
#undef PG8_SA
#undef PG8_SB
#undef PG8_STAGE
#undef PG8_LDA
#undef PG8_LDB
#undef PG8_MMA
#undef PG8_WAIT_V
#undef PG8_WAIT_L
#undef PG8_BAR
#undef PG8_SCHED
}
}
#include <hip/hip_bf16.h>
#include <cmath>
namespace attn_body {
using bf16=__hip_bfloat16;
using bf16x8=__attribute__((ext_vector_type(8)))short;
using s16x4=__attribute__((ext_vector_type(4)))short;
using f32x16=__attribute__((ext_vector_type(16)))float;
using u32x4=__attribute__((ext_vector_type(4)))unsigned;
constexpr int SEQ=16384,D=64,DM=4096,OPITCH=1536;
constexpr int NW=8,QBLK=32,QB=QBLK*NW,KVBLK=64,NQB=SEQ/QB;
#define LAS3 __attribute__((address_space(3)))
__device__ __forceinline__ int crow(int r,int hi){return (r&3)+8*(r>>2)+4*hi;}
#define SBAR() __builtin_amdgcn_sched_barrier(0)
__device__ __forceinline__ void cmask(f32x16&p0,f32x16&p1,int jb,int qrel,int hi){
  const float NEG=-INFINITY; int kb=64*jb+4*hi;
  #pragma unroll
  for(int r=0;r<16;++r){int kv=kb+(r&3)+8*(r>>2); if(kv>qrel)p0[r]=NEG; if(kv+32>qrel)p1[r]=NEG;}
}

constexpr int NSLOT=3, SLOTB=8192;
constexpr int LDS_K=0, LDS_V=NSLOT*SLOTB, LDS_WS=2*NSLOT*SLOTB, LDS_OST=LDS_WS+NW*64*4, LDS_KE=LDS_OST+NW*4096, LDS_BYTES=LDS_KE+4*1024;
constexpr float C2=0.125f*1.4426950408889634f;
__device__ __forceinline__ void glds16(const void*gsrc,unsigned lds_dst){unsigned keep;
  asm volatile("s_mov_b32 %0, m0\n\ts_mov_b32 m0, %2\n\ts_nop 0\n\tglobal_load_lds_dwordx4 %1, off\n\ts_mov_b32 m0, %0":"=&s"(keep):"v"(gsrc),"s"(lds_dst):"memory");}
__device__ __forceinline__ float max3f(float a,float b,float c){float r;asm("v_max3_f32 %0, %1, %2, %3":"=v"(r):"v"(a),"v"(b),"v"(c));return r;}
__device__ __forceinline__ float max2f(float a,float b){float r;asm("v_max_f32_e32 %0, %1, %2":"=v"(r):"v"(a),"v"(b));return r;}
__device__ __forceinline__ float fadd_s(float a,float b){float r;asm("v_add_f32_e32 %0, %1, %2":"=v"(r):"v"(a),"v"(b));return r;}
__device__ __forceinline__ float fsub_s(float a,float b){float r;asm("v_sub_f32_e32 %0, %1, %2":"=v"(r):"v"(a),"v"(b));return r;}
typedef float f32x2_t __attribute__((ext_vector_type(2))); typedef __bf16 bf16x2_t __attribute__((ext_vector_type(2)));
__device__ __forceinline__ unsigned cvtpk_s(float lo,float hi){f32x2_t v={lo,hi};bf16x2_t b=__builtin_convertvector(v,bf16x2_t);return __builtin_bit_cast(unsigned,b);}
#define WAIT_BAR(N) asm volatile("s_waitcnt vmcnt(" #N ") lgkmcnt(0)\n\ts_barrier":::"memory")

__device__ __forceinline__ void qkt(f32x16&p0,f32x16&p1,const char*Kslot,const bf16x8*qr,const f32x16&negm,int r32,int hi){
  const char*kb=Kslot+hi*1024+r32*16;
  #pragma unroll
  for(int d0=0;d0<4;++d0){
    const bf16x8 b0=*reinterpret_cast<const bf16x8*>(kb+d0*2048);
    const bf16x8 b1=*reinterpret_cast<const bf16x8*>(kb+d0*2048+512);
    if(d0==0){p0=__builtin_amdgcn_mfma_f32_32x32x16_bf16(b0,qr[0],negm,0,0,0);p1=__builtin_amdgcn_mfma_f32_32x32x16_bf16(b1,qr[0],negm,0,0,0);}
    else{p0=__builtin_amdgcn_mfma_f32_32x32x16_bf16(b0,qr[d0],p0,0,0,0);p1=__builtin_amdgcn_mfma_f32_32x32x16_bf16(b1,qr[d0],p1,0,0,0);}}
}
typedef __attribute__((address_space(3))) const char* lds_cptr;
typedef short v4i16_t __attribute__((ext_vector_type(4)));
__device__ __forceinline__ void kload8(bf16x8*kf,lds_cptr kp){
  kf[0]=*(const __attribute__((address_space(3))) bf16x8*)(kp);      kf[1]=*(const __attribute__((address_space(3))) bf16x8*)(kp+512);
  kf[2]=*(const __attribute__((address_space(3))) bf16x8*)(kp+2048); kf[3]=*(const __attribute__((address_space(3))) bf16x8*)(kp+2560);
  kf[4]=*(const __attribute__((address_space(3))) bf16x8*)(kp+4096); kf[5]=*(const __attribute__((address_space(3))) bf16x8*)(kp+4608);
  kf[6]=*(const __attribute__((address_space(3))) bf16x8*)(kp+6144); kf[7]=*(const __attribute__((address_space(3))) bf16x8*)(kp+6656);
}
__device__ __forceinline__ void kload2(bf16x8*kf,lds_cptr kp,int j){ kf[2*j]=*(const __attribute__((address_space(3))) bf16x8*)(kp+j*2048); kf[2*j+1]=*(const __attribute__((address_space(3))) bf16x8*)(kp+j*2048+512); }
__device__ __forceinline__ s16x4 vtr(lds_cptr p){ return __builtin_bit_cast(s16x4,__builtin_amdgcn_ds_read_tr16_b64_v4i16((__attribute__((address_space(3))) v4i16_t*)p)); }
__device__ __forceinline__ float rowmax(const f32x16&p0,const f32x16&p1){
  float a=max3f(p0[0],p0[1],p1[0]),b=max3f(p0[2],p0[3],p1[1]);a=max3f(a,p1[2],p1[3]);
  #pragma unroll
  for(int r=4;r<16;r+=4){a=max3f(a,p0[r],p0[r+1]);b=max3f(b,p0[r+2],p0[r+3]);a=max3f(a,p1[r],p1[r+1]);b=max3f(b,p1[r+2],p1[r+3]);}
  const float m=max2f(a,b);
  auto rr=__builtin_amdgcn_permlane32_swap(__float_as_uint(m),__float_as_uint(m),false,false);
  return max2f(__uint_as_float(rr[0]),__uint_as_float(rr[1]));
}
__device__ __forceinline__ void pv(f32x16*o,int vb,bf16x8 pa0,bf16x8 pa1,bf16x8 pa2,bf16x8 pa3){
  #pragma unroll
  for(int d0=0;d0<2;++d0){s16x4 lo[4],hi[4];
    #pragma unroll
    for(int ks=0;ks<4;++ks){
      asm volatile("ds_read_b64_tr_b16 %0,%1 offset:%c2":"=&v"(lo[ks]):"v"(vb),"i"(d0*4096+ks*1024):"memory");
      asm volatile("ds_read_b64_tr_b16 %0,%1 offset:%c2":"=&v"(hi[ks]):"v"(vb),"i"(d0*4096+ks*1024+512):"memory");}
    asm volatile("s_waitcnt lgkmcnt(0)":::"memory");SBAR();
    #define PK(k) (bf16x8){lo[k][0],lo[k][1],lo[k][2],lo[k][3],hi[k][0],hi[k][1],hi[k][2],hi[k][3]}
    o[d0]=__builtin_amdgcn_mfma_f32_32x32x16_bf16(pa0,PK(0),o[d0],0,0,0);
    o[d0]=__builtin_amdgcn_mfma_f32_32x32x16_bf16(pa1,PK(1),o[d0],0,0,0);
    o[d0]=__builtin_amdgcn_mfma_f32_32x32x16_bf16(pa2,PK(2),o[d0],0,0,0);
    o[d0]=__builtin_amdgcn_mfma_f32_32x32x16_bf16(pa3,PK(3),o[d0],0,0,0);
    #undef PK
  }
}

__device__ __forceinline__ unsigned bf_rne(float f){ unsigned u=__float_as_uint(f); return (u+0x7fffu+((u>>16)&1u))>>16; }
__device__ __forceinline__ bf16x8 make_qre(float a,int hi){
  const unsigned h0=bf_rne(a); const float r1=a-__uint_as_float(h0<<16); const unsigned h1=bf_rne(r1); const float r2=r1-__uint_as_float(h1<<16); const unsigned h2=bf_rne(r2);
  u32x4 w; w.x=hi?0u:(h0|(h1<<16)); w.y=hi?0u:(h2|(0x3F80u<<16)); w.z=hi?0u:(0x3F80u|(0x3F80u<<16)); w.w=0u; return __builtin_bit_cast(bf16x8,w); }
constexpr int ATTN_LDS_BYTES=LDS_BYTES;
#undef SBAR
#undef WAIT_BAR
}
namespace attn256 {
using attn_body::bf16; using attn_body::bf16x8; using attn_body::s16x4; using attn_body::f32x16; using attn_body::u32x4; using attn_body::lds_cptr;
using attn_body::glds16; using attn_body::fadd_s; using attn_body::fsub_s; using attn_body::cvtpk_s; using attn_body::vtr; using attn_body::crow; using attn_body::max3f; using attn_body::max2f;
constexpr int SEQ=16384,DM=4096,OPITCH=512,QBU=256,KVBLK=64;
constexpr int KSLOT=8192,VSLOT=16384;
constexpr int LDS_K=0,LDS_V=4*KSLOT,LDS_WS=LDS_V+4*VSLOT,LDS_KE=LDS_WS+2048,LDS_BYTES=LDS_KE+4096;
#define SBAR() __builtin_amdgcn_sched_barrier(0)
#define WAIT_BAR(N) asm volatile("s_waitcnt vmcnt(" #N ") lgkmcnt(0)\n\ts_barrier":::"memory")
#define LAS3 __attribute__((address_space(3)))
__device__ __forceinline__ void wait_bar_n(int n){ if(n<=0){WAIT_BAR(0);} else if(n==1){WAIT_BAR(1);} else if(n==2){WAIT_BAR(2);} else if(n==3){WAIT_BAR(3);} else {WAIT_BAR(4);} }
template<int THRL,int DVB,bool FOX,bool NOMAX> __device__ __forceinline__ void unit(int MODE,int qb,int t0,const bf16*Qb,const bf16*__restrict__ Kb,const bf16*__restrict__ Vb,bf16*Ob,const bf16*__restrict__ Zb,bf16*Yb,const float*__restrict__ subg,float lam,const float*__restrict__ F2b,const bf16*__restrict__ KEb,char*shm){
  constexpr int NV=DVB/2;
  const int tid=threadIdx.x,lane=tid&63,r32=lane&31,hi=lane>>5; const int wid=__builtin_amdgcn_readfirstlane(tid>>6);
  const int q0=qb*QBU;
  const bf16*Qw=Qb+(long)(q0+wid*32)*DM;
  const unsigned lds0=(unsigned)(uintptr_t)shm;
  float*wsf=(float*)(shm+LDS_WS)+wid*64;
  constexpr bool TILED=(DVB==4)&&!FOX; constexpr long KSTR=TILED?4096:(long)KVBLK*DM, VSTR=TILED?8192:(long)KVBLK*DM, V2=TILED?4096:64;
  const bf16*ksrc=TILED?Kb+(long)t0*KSTR+wid*512+lane*8:Kb+((long)t0*KVBLK+lane)*DM+wid*8;
  const bf16*vsrc=TILED?Vb+(long)t0*VSTR+(wid>>2)*2048+(wid&3)*512+lane*8:Vb+((long)t0*KVBLK+16*(wid&3)+(lane>>2))*DM+(wid>>2)*32+(lane&3)*8;
  const bf16*kesrc=KEb+((long)t0*KVBLK+lane)*8; const unsigned kedst=lds0+LDS_KE; const int xw=(FOX&&wid==0)?1:0;
  const unsigned kdst=lds0+LDS_K+wid*1024, vdst=lds0+LDS_V+(wid>>2)*4096+(wid&3)*1024;
  #define KOFF(t) ((((unsigned)(t))&3u)<<13)
  #define VOFF(t) ((((unsigned)(t))&3u)<<(DVB==4?14:13))
  #define DMA_K(t) glds16(ksrc+(long)(t)*KSTR,(unsigned)__builtin_amdgcn_readfirstlane(kdst+KOFF(t)))
  #define DMA_V(t) do{ glds16(vsrc+(long)(t)*VSTR,(unsigned)__builtin_amdgcn_readfirstlane(vdst+VOFF(t))); if(DVB==4){glds16(vsrc+(long)(t)*VSTR+V2,(unsigned)__builtin_amdgcn_readfirstlane(vdst+VOFF(t)+8192));} }while(0)
  #define DMA_KE(t) do{ if(FOX&&wid==0) glds16(kesrc+(long)(t)*KVBLK*8,(unsigned)__builtin_amdgcn_readfirstlane(kedst+((((unsigned)(t))&3u)<<10))); }while(0)
  const lds_cptr shm3=(lds_cptr)shm;
  const lds_cptr kp0=shm3+LDS_K+hi*1024+r32*16;
  const lds_cptr vp0=shm3+LDS_V+((lane>>4)&1)*32+(lane&3)*8+(4*hi+((lane&15)>>2))*64;
  const lds_cptr kep0=shm3+LDS_KE+r32*16;
  const int NT=(q0+QBU)/KVBLK-t0;
  DMA_KE(0);DMA_KE(1);DMA_KE(2);
  DMA_K(0);DMA_V(0);DMA_K(1);DMA_K(2);DMA_V(1);
  bf16x8 qr[4];
  #pragma unroll
  for(int d0=0;d0<4;++d0)qr[d0]=*reinterpret_cast<const bf16x8*>(&Qw[(long)r32*DM+d0*16+hi*8]);
  float mhat=0.f,l_reg=0.f;f32x16 o[DVB];
  #pragma unroll
  for(int d_=0;d_<DVB;++d_)o[d_]=f32x16{};
  f32x16 negm=f32x16{}; if(!FOX&&!NOMAX){asm volatile("":"+v"(negm));}
  bf16x8 qre=bf16x8{},kef=bf16x8{}; float fq2=0.f;
  if(FOX){ fq2=F2b[q0+wid*32+r32]; qre=attn_body::make_qre(fq2,hi); }
  #define SETREF() do{ if(FOX){ qre=attn_body::make_qre(fq2-mhat,hi); } else { _Pragma("unroll") for(int r=0;r<16;++r)negm[r]=-mhat; asm volatile("":"+v"(negm)); } }while(0)
  const int qrel=wid*32+r32;
  #define CMASK(Px,t,h) do{int jb_=(t)-(NT-4); if(jb_>=0){ const int kb_=64*jb_+32*(h)+4*hi; _Pragma("unroll") for(int r=0;r<16;++r){ if(kb_+(r&3)+8*(r>>2)>qrel)Px[r]=-INFINITY; } } }while(0)
  bool resc=false;
  #define RESC() do{ if(resc){ asm volatile("s_waitcnt lgkmcnt(0)":::"memory"); \
      _Pragma("unroll") for(int d_=0;d_<DVB;++d_) _Pragma("unroll") for(int r=0;r<16;++r)o[d_][r]*=wsf[crow(r,hi)]; } }while(0)
  f32x16 pA,pB; bf16x8 kf[4];
  constexpr bool RESP=false;
  constexpr bool LMFMA=false; f32x16 ol=f32x16{}; const bf16x8 ones=(bf16x8){0x3F80,0x3F80,0x3F80,0x3F80,0x3F80,0x3F80,0x3F80,0x3F80};
  WAIT_BAR(0);
  if(3<NT){DMA_K(3);DMA_KE(3);}
  DMA_V(2);
  { const char*kb=shm+LDS_K+hi*1024+r32*16;
    if(FOX){ kef=*(const LAS3 bf16x8*)(kep0); pA=__builtin_amdgcn_mfma_f32_32x32x16_bf16(kef,qre,f32x16{},0,0,0); pA=__builtin_amdgcn_mfma_f32_32x32x16_bf16(*reinterpret_cast<const bf16x8*>(kb),qr[0],pA,0,0,0); }
    else pA=__builtin_amdgcn_mfma_f32_32x32x16_bf16(*reinterpret_cast<const bf16x8*>(kb),qr[0],(NOMAX?f32x16{}:negm),0,0,0);
    #pragma unroll
    for(int d0=1;d0<4;++d0)pA=__builtin_amdgcn_mfma_f32_32x32x16_bf16(*reinterpret_cast<const bf16x8*>(kb+d0*2048),qr[d0],pA,0,0,0); }
  #pragma unroll
  for(int d0=0;d0<4;++d0)kf[d0]=*(const LAS3 bf16x8*)(kp0+d0*2048+512);
  if(FOX)kef=*(const LAS3 bf16x8*)(kep0+512);
  asm volatile("s_nop 15\n\ts_nop 7":"+v"(pA));CMASK(pA,0,0);
  { if constexpr(!NOMAX){ float a=max3f(pA[0],pA[1],pA[2]),b=max3f(pA[3],pA[4],pA[5]);a=max3f(a,pA[6],pA[7]);b=max3f(b,pA[8],pA[9]);a=max3f(a,pA[10],pA[11]);b=max3f(b,pA[12],pA[13]);a=max3f(a,pA[14],pA[15]);
    float rm=max2f(a,b); auto rr=__builtin_amdgcn_permlane32_swap(__float_as_uint(rm),__float_as_uint(rm),false,false); rm=max2f(__uint_as_float(rr[0]),__uint_as_float(rr[1]));
    mhat=fadd_s(mhat,rm);
    #pragma unroll
    for(int r=0;r<16;++r)pA[r]=fsub_s(pA[r],rm);
    SETREF(); }
    #pragma unroll
    for(int r=0;r<16;++r)pA[r]=__builtin_amdgcn_exp2f(pA[r]); }
  s16x4 vlo[2*DVB],vhi[2*DVB]; u32x4 pw0,pw1;
  #define PKW(P,B) cvtpk_s(P[B],P[B+1])
  #define PAF(k) __builtin_bit_cast(bf16x8,pw##k)
  #define VFR(i) (bf16x8){vlo[i][0],vlo[i][1],vlo[i][2],vlo[i][3],vhi[i][0],vhi[i][1],vhi[i][2],vhi[i][3]}
  #define PIN(x) asm volatile("":"+v"(x))
  #define MX3(a,b,c) __builtin_fmaxf(__builtin_fmaxf((a),(b)),(c))
  #define GAPA(MF,A0,A1,A2,A3,W0,W1,PW) do{ MF; if constexpr(!LMFMA){ sacc+=A0; sacc+=A1; sacc+=A2; sacc+=A3; PIN(sacc); } W0; W1; PIN(PW); SBAR(); }while(0)
  #define EX(v) __builtin_amdgcn_exp2f(v)
  #define GAPB(MF,X,B) do{ MF; X[B]=EX(X[B]); X[B+1]=EX(X[B+1]); PIN(X); SBAR(); }while(0)
  #define GAPB3(MF,X,B) do{ MF; X[B]=EX(X[B]); X[B+1]=EX(X[B+1]); X[B+2]=EX(X[B+2]); PIN(X); SBAR(); }while(0)
  #define GAPA0(MF) do{ MF; SBAR(); }while(0)
  #define GAPB4(MF,X,B) do{ MF; X[B]=EX(X[B]); X[B+1]=EX(X[B+1]); X[B+2]=EX(X[B+2]); X[B+3]=EX(X[B+3]); PIN(X); SBAR(); }while(0)
  #define VRD(i) do{ vlo[i]=vtr(vp_+(((i)%DVB)*4096+((i)/DVB)*1024)); vhi[i]=vtr(vp_+(((i)%DVB)*4096+((i)/DVB)*1024+512)); SBAR(); }while(0)
  #define KERD(G) do{ if(FOX&&(G)){ kef=*(const LAS3 bf16x8*)(ken_); SBAR(); } }while(0)
  #define CIN0(Cx) (FOX?(Cx):(NOMAX?f32x16{}:negm))
  #define KRD(G,j) do{ if(G){ kf[j]=*(const LAS3 bf16x8*)(kn_+(j)*2048); SBAR(); } }while(0)
  #define SUB(Cx,Px,t,h,VP,KN,KEN,GL,ISSUE) do{ SBAR(); \
    const lds_cptr vp_=(VP); const lds_cptr kn_=(KN); const lds_cptr ken_=(KEN); \
    if(FOX){ Cx=__builtin_amdgcn_mfma_f32_32x32x16_bf16(kef,qre,f32x16{},0,0,0); SBAR(); } \
    VRD(0); float sacc=0.f; \
    GAPA(Cx=__builtin_amdgcn_mfma_f32_32x32x16_bf16(kf[0],qr[0],CIN0(Cx),0,0,0), Px[0],Px[1],Px[2],Px[3],     pw0[0]=PKW(Px,0), pw0[1]=PKW(Px,2), pw0); \
    VRD(1); GAPA(Cx=__builtin_amdgcn_mfma_f32_32x32x16_bf16(kf[1],qr[1],Cx,0,0,0), Px[4],Px[5],Px[6],Px[7],     pw0[2]=PKW(Px,4), pw0[3]=PKW(Px,6), pw0); \
    if constexpr(RESP){ VRD(2); GAPA0(Cx=__builtin_amdgcn_mfma_f32_32x32x16_bf16(kf[2],qr[2],Cx,0,0,0)); VRD(3); GAPA0(Cx=__builtin_amdgcn_mfma_f32_32x32x16_bf16(kf[3],qr[3],Cx,0,0,0)); } else { \
    if(DVB==4){VRD(2);} GAPA(Cx=__builtin_amdgcn_mfma_f32_32x32x16_bf16(kf[2],qr[2],Cx,0,0,0), Px[8],Px[9],Px[10],Px[11],   pw1[0]=PKW(Px,8), pw1[1]=PKW(Px,10), pw1); \
    if(DVB==4){VRD(3);} GAPA(Cx=__builtin_amdgcn_mfma_f32_32x32x16_bf16(kf[3],qr[3],Cx,0,0,0), Px[12],Px[13],Px[14],Px[15], pw1[2]=PKW(Px,12), pw1[3]=PKW(Px,14), pw1); \
    l_reg+=sacc; } \
    ISSUE; \
    CMASK(Cx,t,h); \
    if constexpr(!NOMAX) \
    { float a=MX3(Cx[0],Cx[1],Cx[2]),b=MX3(Cx[3],Cx[4],Cx[5]); a=MX3(a,Cx[6],Cx[7]); b=MX3(b,Cx[8],Cx[9]); a=MX3(a,Cx[10],Cx[11]); b=MX3(b,Cx[12],Cx[13]); a=MX3(a,Cx[14],Cx[15]); \
      float rm=__builtin_fmaxf(a,b); { auto rr=__builtin_amdgcn_permlane32_swap(__float_as_uint(rm),__float_as_uint(rm),false,false); rm=__builtin_fmaxf(__uint_as_float(rr[0]),__uint_as_float(rr[1])); } \
      resc=false; \
      if(__builtin_expect(__any(rm>(float)THRL),0)){ const float dl=__builtin_fmaxf(rm,0.f); mhat+=dl; \
        _Pragma("unroll") for(int r=0;r<16;++r){Cx[r]-=dl;} \
        SETREF(); \
        const float f=__builtin_amdgcn_exp2f(-dl); l_reg*=f; if(hi==0)wsf[r32]=f; resc=true; } } \
    SBAR(); \
    if constexpr(RESP){ \
    VRD(4); GAPA(o[0]=__builtin_amdgcn_mfma_f32_32x32x16_bf16(PAF(0),VFR(0),o[0],0,0,0), Px[8],Px[9],Px[10],Px[11],   pw1[0]=PKW(Px,8), pw1[1]=PKW(Px,10), pw1); \
    VRD(5); GAPA(o[1]=__builtin_amdgcn_mfma_f32_32x32x16_bf16(PAF(0),VFR(1),o[1],0,0,0), Px[12],Px[13],Px[14],Px[15], pw1[2]=PKW(Px,12), pw1[3]=PKW(Px,14), pw1); \
    l_reg+=sacc; \
    VRD(6); GAPB3(o[2]=__builtin_amdgcn_mfma_f32_32x32x16_bf16(PAF(0),VFR(2),o[2],0,0,0), Cx,0); \
    VRD(7); GAPB3(o[3]=__builtin_amdgcn_mfma_f32_32x32x16_bf16(PAF(0),VFR(3),o[3],0,0,0), Cx,3); \
    KRD(GL,0); GAPB3(o[0]=__builtin_amdgcn_mfma_f32_32x32x16_bf16(PAF(1),VFR(4),o[0],0,0,0), Cx,6); \
    KRD(GL,1); GAPB3(o[1]=__builtin_amdgcn_mfma_f32_32x32x16_bf16(PAF(1),VFR(5),o[1],0,0,0), Cx,9); \
    KRD(GL,2); GAPB(o[2]=__builtin_amdgcn_mfma_f32_32x32x16_bf16(PAF(1),VFR(6),o[2],0,0,0), Cx,12); \
    KRD(GL,3); KERD(GL); GAPB(o[3]=__builtin_amdgcn_mfma_f32_32x32x16_bf16(PAF(1),VFR(7),o[3],0,0,0), Cx,14); \
    } else if constexpr(DVB==4){ \
    VRD(4); GAPB(o[0]=__builtin_amdgcn_mfma_f32_32x32x16_bf16(PAF(0),VFR(0),o[0],0,0,0), Cx,0); \
    VRD(5); GAPB(o[1]=__builtin_amdgcn_mfma_f32_32x32x16_bf16(PAF(0),VFR(1),o[1],0,0,0), Cx,2); \
    VRD(6); GAPB(o[2]=__builtin_amdgcn_mfma_f32_32x32x16_bf16(PAF(0),VFR(2),o[2],0,0,0), Cx,4); \
    VRD(7); GAPB(o[3]=__builtin_amdgcn_mfma_f32_32x32x16_bf16(PAF(0),VFR(3),o[3],0,0,0), Cx,6); \
    KRD(GL,0); GAPB(o[0]=__builtin_amdgcn_mfma_f32_32x32x16_bf16(PAF(1),VFR(4),o[0],0,0,0), Cx,8); \
    KRD(GL,1); GAPB(o[1]=__builtin_amdgcn_mfma_f32_32x32x16_bf16(PAF(1),VFR(5),o[1],0,0,0), Cx,10); \
    KRD(GL,2); GAPB(o[2]=__builtin_amdgcn_mfma_f32_32x32x16_bf16(PAF(1),VFR(6),o[2],0,0,0), Cx,12); \
    KRD(GL,3); KERD(GL); GAPB(o[3]=__builtin_amdgcn_mfma_f32_32x32x16_bf16(PAF(1),VFR(7),o[3],0,0,0), Cx,14); \
    if constexpr(LMFMA){ ol=__builtin_amdgcn_mfma_f32_32x32x16_bf16(PAF(0),ones,ol,0,0,0); ol=__builtin_amdgcn_mfma_f32_32x32x16_bf16(PAF(1),ones,ol,0,0,0); SBAR(); } \
    } else { \
    VRD(2); GAPB4(o[0]=__builtin_amdgcn_mfma_f32_32x32x16_bf16(PAF(0),VFR(0),o[0],0,0,0), Cx,0); \
    VRD(3); GAPB4(o[1]=__builtin_amdgcn_mfma_f32_32x32x16_bf16(PAF(0),VFR(1),o[1],0,0,0), Cx,4); \
    KRD(GL,0); KRD(GL,1); GAPB4(o[0]=__builtin_amdgcn_mfma_f32_32x32x16_bf16(PAF(1),VFR(2),o[0],0,0,0), Cx,8); \
    KRD(GL,2); KRD(GL,3); KERD(GL); GAPB4(o[1]=__builtin_amdgcn_mfma_f32_32x32x16_bf16(PAF(1),VFR(3),o[1],0,0,0), Cx,12); \
    } \
    RESC(); \
    }while(0)
  SUB(pB,pA,0,1,vp0+VOFF(0),kp0+KOFF(1),kep0+1024,true,(void)0);
  wait_bar_n(NV+1+xw);
  int t=1;
  #undef CMASK
  #define CMASK(Px,t,h) do{}while(0)
  for(;t+4<NT;++t){
    SUB(pA,pB,t,0,vp0+VOFF(t-1)+2048,kp0+KOFF(t)+512,kep0+((((unsigned)(t))&3u)<<10)+512,true,do{DMA_K(t+3);DMA_KE(t+3);DMA_V(t+2);}while(0));
    SUB(pB,pA,t,1,vp0+VOFF(t),kp0+KOFF(t+1),kep0+((((unsigned)(t+1))&3u)<<10),true,(void)0);
    wait_bar_n(NV+1+xw);
  }
  #undef CMASK
  #define CMASK(Px,t,h) do{int jb_=(t)-(NT-4); if(jb_>=0){ const int kb_=64*jb_+32*(h)+4*hi; _Pragma("unroll") for(int r=0;r<16;++r){ if(kb_+(r&3)+8*(r>>2)>qrel)Px[r]=-INFINITY; } } }while(0)
  for(;t<NT;++t){
    SUB(pA,pB,t,0,vp0+VOFF(t-1)+2048,kp0+KOFF(t)+512,kep0+((((unsigned)(t))&3u)<<10)+512,true,do{ if(t+3<NT){DMA_K(t+3);DMA_KE(t+3);} if(t+2<NT)DMA_V(t+2); }while(0));
    SUB(pB,pA,t,1,vp0+VOFF(t),kp0+KOFF(t+1),kep0+((((unsigned)(t+1))&3u)<<10),(t+1<NT),(void)0);
    if(t+3<NT){wait_bar_n(NV+1+xw);} else if(t+2<NT){wait_bar_n(NV);} else {WAIT_BAR(0);}
  }
  { if constexpr(!LMFMA){ float sacc=0.f; _Pragma("unroll") for(int r=0;r<16;++r)sacc+=pB[r]; l_reg+=sacc; }
    pw0=(u32x4){PKW(pB,0),PKW(pB,2),PKW(pB,4),PKW(pB,6)};pw1=(u32x4){PKW(pB,8),PKW(pB,10),PKW(pB,12),PKW(pB,14)};
    const lds_cptr vp_=vp0+VOFF(NT-1)+2048;
    #pragma unroll
    for(int i=0;i<2*DVB;++i){ vlo[i]=vtr(vp_+((i%DVB)*4096+(i/DVB)*1024)); vhi[i]=vtr(vp_+((i%DVB)*4096+(i/DVB)*1024+512)); }
    #pragma unroll
    for(int d_=0;d_<DVB;++d_)o[d_]=__builtin_amdgcn_mfma_f32_32x32x16_bf16(PAF(0),VFR(d_),o[d_],0,0,0);
    #pragma unroll
    for(int d_=0;d_<DVB;++d_)o[d_]=__builtin_amdgcn_mfma_f32_32x32x16_bf16(PAF(1),VFR(DVB+d_),o[d_],0,0,0);
    if constexpr(LMFMA){ ol=__builtin_amdgcn_mfma_f32_32x32x16_bf16(PAF(0),ones,ol,0,0,0); ol=__builtin_amdgcn_mfma_f32_32x32x16_bf16(PAF(1),ones,ol,0,0,0); } }
  #undef PKW
  #undef PAF
  #undef VFR
  #undef PIN
  #undef MX3
  #undef GAPA
  #undef GAPB
  #undef GAPB4
  #undef GAPB3
  #undef GAPA0
  #undef KERD
  #undef CIN0
  #undef EX
  #undef VRD
  #undef KRD
  #undef SUB
  {auto rr=__builtin_amdgcn_permlane32_swap(__float_as_uint(l_reg),__float_as_uint(l_reg),false,false);l_reg=__uint_as_float(rr[0])+__uint_as_float(rr[1]);}
  if(hi==0)wsf[32+r32]=l_reg;
  asm volatile("s_waitcnt lgkmcnt(0)\n\ts_barrier":::"memory");
  { float rli[16];
    #pragma unroll
    for(int r=0;r<16;++r)rli[r]=__builtin_amdgcn_rcpf(LMFMA?ol[r]:wsf[32+crow(r,hi)]);
    constexpr int OC=32*DVB, CPR=OC/8, RPI=64/CPR;
    bf16*stg=(bf16*)(shm)+wid*4096;
    #pragma unroll
    for(int r=0;r<16;++r){const int orow=crow(r,hi);
      #pragma unroll
      for(int d_=0;d_<DVB;++d_)stg[orow*OC+d_*32+r32]=__float2bfloat16(o[d_][r]*rli[r]);}
    asm volatile("s_waitcnt lgkmcnt(0)":::"memory");
    bf16*Ow=Ob+(long)(q0+wid*32)*OPITCH;
    if constexpr(DVB==2){
    #pragma unroll
    for(int i=0;i<32/RPI;++i){const int row=i*RPI+lane/CPR,ch=lane%CPR; const long grow=q0+wid*32+row; u32x4 v=*(const u32x4*)(stg+row*OC+ch*8); const u32x4 zz=*(const u32x4*)(Zb+grow*DM+ch*8);
      #pragma unroll
      for(int k=0;k<4;++k){ const float z0=__uint_as_float(zz[k]<<16),z1=__uint_as_float(zz[k]&0xffff0000u); v[k]=cvtpk_s(__uint_as_float(v[k]<<16)*(z0*__builtin_amdgcn_rcpf(1.f+__expf(-z0))),__uint_as_float(v[k]&0xffff0000u)*(z1*__builtin_amdgcn_rcpf(1.f+__expf(-z1)))); }
      *(u32x4*)(Yb+grow*1024+ch*8)=v; }
    } else
    if(MODE==0){
    #pragma unroll
    for(int i=0;i<8;++i){const int row=i*4+(lane>>4),ch=lane&15; const u32x4 v=*(const u32x4*)(stg+row*128+ch*8); *(u32x4*)(Ow+(long)row*OPITCH+ch*8)=v;}
    } else {
    const int ch=lane&15; float gg[8];
    #pragma unroll
    for(int k=0;k<8;++k)gg[k]=subg[ch*8+k];
    #pragma unroll
    for(int i=0;i<8;++i){const int row=i*4+(lane>>4); const long grow=q0+wid*32+row;
      const u32x4 v1=*(const u32x4*)(stg+row*128+ch*8), v0=*(const u32x4*)(Ow+(long)row*OPITCH+ch*8), zz=*(const u32x4*)(Zb+grow*DM+ch*8);
      float d[8];
      #pragma unroll
      for(int k=0;k<4;++k){ d[2*k]=__uint_as_float(v0[k]<<16)-lam*__uint_as_float(v1[k]<<16); d[2*k+1]=__uint_as_float(v0[k]&0xffff0000u)-lam*__uint_as_float(v1[k]&0xffff0000u); }
      float ss=0.f;
      #pragma unroll
      for(int k=0;k<8;++k)ss+=d[k]*d[k];
      #pragma unroll
      for(int o_=1;o_<16;o_<<=1)ss+=__shfl_xor(ss,o_);
      const float rs=__builtin_amdgcn_rsqf(ss*(1.f/128.f)+1e-6f); u32x4 w;
      #pragma unroll
      for(int k=0;k<4;++k){ const float z0=__uint_as_float(zz[k]<<16),z1=__uint_as_float(zz[k]&0xffff0000u);
        const float y0=d[2*k]*rs*gg[2*k]*(z0*__builtin_amdgcn_rcpf(1.f+__expf(-z0))), y1=d[2*k+1]*rs*gg[2*k+1]*(z1*__builtin_amdgcn_rcpf(1.f+__expf(-z1))); w[k]=cvtpk_s(y0,y1); }
      *(u32x4*)(Yb+grow*1024+ch*8)=w; }
    } }
  asm volatile("s_waitcnt lgkmcnt(0)\n\ts_barrier":::"memory");
  #undef DMA_K
  #undef DMA_V
  #undef DMA_KE
  #undef SETREF
  #undef KOFF
  #undef VOFF
  #undef CMASK
  #undef RESC
}
#undef SBAR
#undef WAIT_BAR
#undef LAS3
}
constexpr int NWAVES = 8;
#ifndef MK_ONE_LAUNCH
#define MK_ONE_LAUNCH 1
#endif
constexpr int BATCH = 2, SEQ = 16384, D = 1024, M = BATCH * SEQ, NPJ = 4096;
constexpr int ATTN_IN = 4104, ML_IN = 4112;
constexpr float RMS_EPS = 1e-6f, LOG2E = 1.4426950408889634f, C2 = 0.125f * 1.4426950408889634f;
constexpr int NPHASE = 12;
constexpr size_t MiB = 1u << 20;
constexpr size_t WS_CTL = 0, CTL_ZERO_BYTES = 1 * MiB;
constexpr size_t WS_LOGF = 1 * MiB, WS_F2 = 2 * MiB, WS_QE = 3 * MiB, WS_KE = 7 * MiB, WS_LI = 11 * MiB, WS_LF = 12 * MiB;
constexpr size_t WS_GB = 13 * MiB, WS_GE = 14 * MiB, WS_GU = 15 * MiB, WS_CHA = 16 * MiB, WS_CHE = 16 * MiB + 65536, WS_CHM = 16 * MiB + 131072;
constexpr size_t WS_DN = 17 * MiB, WS_NS = 17 * MiB + 524288, WS_SUBG = 16 * MiB + 262144, WS_RSTD = 16 * MiB + 524288;
constexpr size_t WS_ROPE = 18 * MiB, WS_WIN0 = 26 * MiB, WS_WOUT0 = 34 * MiB, WS_WIN1 = 36 * MiB, WS_WOUT1 = 44 * MiB;
constexpr size_t WS_XN = 48 * MiB;
constexpr size_t WS_PROJ = 112 * MiB;
constexpr size_t WS_OB = 368 * MiB;
constexpr size_t WS_END = 464 * MiB;
constexpr int CW_TMO = 0, CW_CODE = 1, CW_BAR = 4096, CW_NRM = 8192, CW_FOXQ = 8192 + 256;
constexpr int RING_OFF = 0, RING_BYTES = 131072;
constexpr int LDSCTL_OFF = RING_BYTES, MISC_OFF = LDSCTL_OFF + 320;
constexpr int LDS_BYTES = 147456;
static_assert(MISC_OFF + 128 <= LDS_BYTES, "LDS map");
#define GAS __attribute__((address_space(1)))
#define LAS __attribute__((address_space(3)))
typedef unsigned short bf16;
typedef unsigned v4u __attribute__((ext_vector_type(4)));
typedef float f32x4 __attribute__((ext_vector_type(4)));
typedef short bf16x8 __attribute__((ext_vector_type(8)));
typedef GAS unsigned gu32;
typedef GAS unsigned long long gu64;
#define RLX_AGENT __ATOMIC_RELAXED, __HIP_MEMORY_SCOPE_AGENT
#define LDS_WAIT() asm volatile("s_waitcnt lgkmcnt(0)" ::: "memory")
#define VM_WAIT() asm volatile("s_waitcnt vmcnt(0)" ::: "memory")
__device__ __forceinline__ unsigned long long rt() { return __builtin_amdgcn_s_memrealtime(); }
__device__ __forceinline__ unsigned f2bf(float f) { unsigned u = __builtin_bit_cast(unsigned, f); return (u + 0x7fffu + ((u >> 16) & 1u)) >> 16; }
__device__ __forceinline__ unsigned pk2(float lo, float hi) { return f2bf(lo) | (f2bf(hi) << 16); }
#define XB_TMO      128
#define XB_XCNT(j)  (256  + 64 * (j))
#define XB_XSUB(j)  (1280 + 64 * (j))
#define XB_XGEN(j)  (2304 + 64 * (j))
#define XB_TOP      3328
#define XB_TOPGEN   3392
#define XCD_BAR_WORDS 3456
#define XB_SPIN_CAP (1u << 18)

__device__ __forceinline__ unsigned xb_ld(unsigned* p)              { return __hip_atomic_load(p, __ATOMIC_RELAXED, __HIP_MEMORY_SCOPE_AGENT); }
__device__ __forceinline__ unsigned xb_add(unsigned* p, unsigned v) { return __hip_atomic_fetch_add(p, v, __ATOMIC_RELAXED, __HIP_MEMORY_SCOPE_AGENT); }
__device__ __forceinline__ unsigned xb_xcc_id() { return (unsigned)__builtin_amdgcn_s_getreg((3 << 11) | 20) & 0xFu; }
#define XB_SPIN(cond, bar) do { unsigned _sp = 0; while (cond) { __builtin_amdgcn_s_sleep(1); \
    if ((++_sp & 255u) == 0u) { if (xb_ld(&(bar)[XB_TMO])) break; if (_sp > XB_SPIN_CAP) { atomicAdd(&(bar)[XB_TMO], 1u); break; } } } } while (0)

struct XcdBarrier {
    unsigned* bar; unsigned x;
    volatile LAS unsigned* st;
};

__device__ __forceinline__ XcdBarrier xcd_barrier_post(unsigned* bar, volatile LAS unsigned* st) {
    XcdBarrier b; b.bar = bar; b.x = xb_xcc_id(); b.st = st;
    if (threadIdx.x == 0) (void)xb_add(&bar[XB_XCNT(b.x)], 1u);
    return b;
}
__device__ __forceinline__ void xcd_barrier_complete(unsigned* bar, unsigned x, unsigned& nloc, unsigned& nx) {
    const unsigned G = gridDim.x * gridDim.y * gridDim.z;
    unsigned sum, cnt, mine, sp = 0u;
    for (;;) {
        sum = 0u; cnt = 0u; mine = 0u;
#pragma unroll
        for (unsigned j = 0; j < 16; ++j) { const unsigned c = xb_ld(&bar[XB_XCNT(j)]); sum += c; cnt += (c > 0u) ? 1u : 0u; mine = (j == x) ? c : mine; }
        if (sum == G) break;
        __builtin_amdgcn_s_sleep(1);
        if ((++sp & 255u) == 0u) { if (xb_ld(&bar[XB_TMO])) break; if (sp > XB_SPIN_CAP) { atomicAdd(&bar[XB_TMO], 1u); break; } }
    }
    nloc = mine > 0u ? mine : 1u; nx = cnt > 0u ? cnt : 1u;
}

__device__ __forceinline__ void xcd_barrier(const XcdBarrier& b) {
    asm volatile("s_waitcnt vmcnt(0)" ::: "memory");
    __syncthreads();
    if (threadIdx.x == 0) {
        unsigned* bar = b.bar;
        __builtin_amdgcn_s_waitcnt(0);
        unsigned nloc = b.st[0], nx = b.st[1];
        if (nloc == 0u) { xcd_barrier_complete(bar, b.x, nloc, nx); b.st[0] = nloc; b.st[1] = nx; }
        const unsigned old = xb_add(&bar[XB_XSUB(b.x)], 1u);
        const unsigned gen = old / nloc;
        if (old + 1u == (gen + 1u) * nloc) {
            __builtin_amdgcn_fence(__ATOMIC_RELEASE, "agent");
            asm volatile("s_waitcnt vmcnt(0)" ::: "memory");
            const unsigned og = xb_add(&bar[XB_TOP], 1u);
            const unsigned tg = og / nx;
            if (og + 1u == (tg + 1u) * nx) xb_add(&bar[XB_TOPGEN], 1u);
            else XB_SPIN(xb_ld(&bar[XB_TOPGEN]) == tg, bar);
            __builtin_amdgcn_fence(__ATOMIC_ACQUIRE, "agent");
            xb_add(&bar[XB_XGEN(b.x)], 1u);
            asm volatile("s_waitcnt vmcnt(0)" ::: "memory");
        } else {
            XB_SPIN(xb_ld(&bar[XB_XGEN(b.x)]) == gen, bar);
            __builtin_amdgcn_fence(__ATOMIC_ACQUIRE, "agent");
            asm volatile("s_waitcnt vmcnt(0)" ::: "memory");
        }
    }
    __syncthreads();
}
__device__ __forceinline__ float wave_sum(float v) {
#pragma unroll
    for (int o = 1; o < 64; o <<= 1) v += __shfl_xor(v, o);
    return v;
}
__device__ __forceinline__ float bf2f(unsigned short b) { return __builtin_bit_cast(float, (unsigned)b << 16); }
__device__ __forceinline__ float bflo(unsigned w) { return __builtin_bit_cast(float, w << 16); }
__device__ __forceinline__ float bfhi(unsigned w) { return __builtin_bit_cast(float, w & 0xffff0000u); }
typedef _Float16 h2p __attribute__((ext_vector_type(2))); typedef float f2p __attribute__((ext_vector_type(2)));
__device__ __forceinline__ unsigned pkh(float lo, float hi) { const f2p v = {lo, hi}; return __builtin_bit_cast(unsigned, __builtin_convertvector(v, h2p)); }
__device__ __forceinline__ float h_lo(unsigned w) { return (float)__builtin_bit_cast(h2p, w)[0]; }
__device__ __forceinline__ float h_hi(unsigned w) { return (float)__builtin_bit_cast(h2p, w)[1]; }
__device__ __forceinline__ float log_sigmoid_f(float x) { return fminf(x, 0.f) - log1pf(__expf(-fabsf(x))); }
__device__ __forceinline__ float sigmoid_f(float x) { return 1.f / (1.f + __expf(-x)); }
__device__ __forceinline__ float silu_f(float x) { return x / (1.f + __expf(-x)); }

typedef unsigned u32x4m __attribute__((ext_vector_type(4)));
struct Ctx {
    LAS unsigned char* lds; char* ldsg; int G, bid;
    float* out; unsigned char* ws;
};
__device__ __forceinline__ const float* kin(int i) { unsigned long long r; const unsigned long long kp = (unsigned long long)__builtin_amdgcn_kernarg_segment_ptr();
    asm volatile("s_load_dwordx2 %0, %1, %2\n\ts_waitcnt lgkmcnt(0)" : "=s"(r) : "s"(kp), "n"(i * 8)); return (const float*)r; }
__device__ __forceinline__ int src_col0(int P) {
    if (P < 1536) return P;
    if (P < 2560) { const int q = P - 1536, grp = q >> 6, p = q & 63; return 1544 + grp * 64 + 16 * (p >> 5) + 4 * ((p >> 3) & 3) + (p & 3) + 32 * ((p >> 2) & 1); }
    return P + 8;
}
__device__ __forceinline__ int src_col1(int P) { if (P < 2048) return P; const int j = (P - 2048) >> 1; return (P & 1) ? 3088 + j : 2064 + j; }
template <bool F16>
__device__ __forceinline__ void transpose_item(const float* W, int ldw, const float* gain, bf16* WT, LAS float* scr, int kb, int nb, int lane, int srcc) {
    const int k0 = 64 * kb, n0 = 32 * nb;
    float wv[32], gv[32];
#pragma unroll
    for (int i = 0; i < 32; ++i) { const int kk = 2 * i + (lane >> 5); gv[i] = gain ? gain[k0 + kk] : 1.f; wv[i] = W[(size_t)(k0 + kk) * ldw + srcc]; }
#pragma unroll
    for (int i = 0; i < 32; ++i) { const int kk = 2 * i + (lane >> 5); scr[kk * 33 + (lane & 31)] = wv[i] * gv[i]; }
    LDS_WAIT(); asm volatile("" ::: "memory");
    const int c = lane & 7;
#pragma unroll
    for (int j = 0; j < 4; ++j) { const int n = (lane >> 3) + 8 * j; const LAS float* s = scr + (8 * c) * 33 + n;
        v4u o; if (F16) { o.x = pkh(s[0 * 33], s[1 * 33]); o.y = pkh(s[2 * 33], s[3 * 33]); o.z = pkh(s[4 * 33], s[5 * 33]); o.w = pkh(s[6 * 33], s[7 * 33]); }
        else { o.x = pk2(s[0 * 33], s[1 * 33]); o.y = pk2(s[2 * 33], s[3 * 33]); o.z = pk2(s[4 * 33], s[5 * 33]); o.w = pk2(s[6 * 33], s[7 * 33]); }
        *(GAS v4u*)(WT + (size_t)(n0 + n) * 1024 + k0 + 8 * c) = o; }
    LDS_WAIT(); asm volatile("" ::: "memory");
}
__device__ __constant__ const double kInvFreq[32] = {1.0, 0.7498942093324559, 0.5623413251903491, 0.4216965034285822, 0.31622776601683794, 0.23713737056616552, 0.1778279410038923, 0.1333521432163324, 0.1, 0.07498942093324558,
    0.05623413251903491, 0.042169650342858224, 0.03162277660168379, 0.023713737056616554, 0.01778279410038923, 0.01333521432163324, 0.01, 0.007498942093324558, 0.005623413251903491, 0.004216965034285823, 0.0031622776601683794,
    0.0023713737056616554, 0.0017782794100389228, 0.001333521432163324, 0.001, 0.0007498942093324559, 0.0005623413251903491, 0.00042169650342858224, 0.00031622776601683794, 0.00023713737056616554, 0.00017782794100389227, 0.0001333521432163324};

__device__ __forceinline__ void prologue_weights(const Ctx& C) {
    LAS float* scr = (LAS float*)(C.lds + RING_OFF + __builtin_amdgcn_readfirstlane((int)threadIdx.x >> 6) * 16384);
    const int gw = C.bid * NWAVES + __builtin_amdgcn_readfirstlane((int)threadIdx.x >> 6), NGW = C.G * NWAVES;
    bf16* Win0 = (bf16*)(C.ws + WS_WIN0); bf16* Wout0 = (bf16*)(C.ws + WS_WOUT0); bf16* Win1 = (bf16*)(C.ws + WS_WIN1); bf16* Wout1 = (bf16*)(C.ws + WS_WOUT1);
    constexpr int I_IN = 16 * 128, I_OUT = 16 * 32, NITEMS = 2 * I_IN + 2 * I_OUT;
    for (int it = gw; it < NITEMS; it += NGW) {
        int r = it;
        if (r < I_IN) { const int kb = r / 128, nb = r % 128; transpose_item<false>(kin(3), ATTN_IN, kin(2), Win0, scr, kb, nb, ((int)threadIdx.x & 63), src_col0(32 * nb + (((int)threadIdx.x & 63) & 31))); continue; } r -= I_IN;
        if (r < I_IN) { const int kb = r / 128, nb = r % 128; transpose_item<true>(kin(12), ML_IN, kin(11), Win1, scr, kb, nb, ((int)threadIdx.x & 63), src_col1(32 * nb + (((int)threadIdx.x & 63) & 31))); continue; } r -= I_IN;
        if (r < I_OUT) { const int kb = r / 32, nb = r % 32; transpose_item<false>(kin(10), 1024, nullptr, Wout0, scr, kb, nb, ((int)threadIdx.x & 63), 32 * nb + (((int)threadIdx.x & 63) & 31)); continue; } r -= I_OUT;
        { const int kb = r / 32, nb = r % 32; transpose_item<false>(kin(15), 1024, nullptr, Wout1, scr, kb, nb, ((int)threadIdx.x & 63), 32 * nb + (((int)threadIdx.x & 63) & 31)); }
    }
    const int* pos = (const int*)kin(1); float* rope = (float*)(C.ws + WS_ROPE);
    for (int idx = C.bid * (NWAVES * 64) + (int)threadIdx.x; idx < M * 32; idx += C.G * NWAVES * 64) { const int m = idx >> 5, i = idx & 31;
        double rev = (double)pos[m] * kInvFreq[i] * 0.15915494309189535; rev -= floor(rev); const float rf = (float)rev;
        *(float2*)(rope + (size_t)idx * 2) = make_float2(__builtin_amdgcn_cosf(rf), __builtin_amdgcn_sinf(rf)); }
}
typedef _Float16 h8n __attribute__((ext_vector_type(8)));
template <int NG, bool B16IN>
__device__ __forceinline__ void norm_gate_phase(const Ctx& C, const void* Xv, const float* W, int ldw, int gcol0, const float* gain, const float* bias_a, const float* bias_b, bf16* XN, float* outA, float* outB, float* rstdo) {
    constexpr int TP = 1032;
    LAS unsigned short* thi = (LAS unsigned short*)(C.lds + RING_OFF); LAS unsigned short* tlo = thi + 16 * TP;
#pragma unroll 8
    for (int i = (int)threadIdx.x; i < 16 * 1024; i += NWAVES * 64) { const int c = i & 15, k = i >> 4; float w = 0.f; if (c < NG) w = W[(size_t)k * ldw + gcol0 + c] * gain[k];
        const _Float16 h = (_Float16)w; const _Float16 l = (_Float16)(w - (float)h); thi[c * TP + k] = __builtin_bit_cast(unsigned short, h); tlo[c * TP + k] = __builtin_bit_cast(unsigned short, l); }
    __syncthreads();
    const int ln = (int)threadIdx.x & 63, r16 = ln & 15, kg = ln >> 4;
    const int gw = C.bid * NWAVES + __builtin_amdgcn_readfirstlane((int)threadIdx.x >> 6), NGW = C.G * NWAVES;
    for (int grp = gw; grp < M / 16; grp += NGW) { const size_t row = (size_t)grp * 16 + r16;
        f32x4 acc = {0.f, 0.f, 0.f, 0.f}; float ss = 0.f;
#pragma unroll 4
        for (int s = 0; s < 32; ++s) { const int k0 = 32 * s + 8 * kg;
            const bf16x8 bh = *(const LAS bf16x8*)(thi + r16 * TP + k0), bl = *(const LAS bf16x8*)(tlo + r16 * TP + k0);
            if (B16IN) { const v4u a = *(const v4u*)((const bf16*)Xv + row * D + k0);
                ss += (h_lo(a.x) * h_lo(a.x) + h_hi(a.x) * h_hi(a.x)) + (h_lo(a.y) * h_lo(a.y) + h_hi(a.y) * h_hi(a.y)) + (h_lo(a.z) * h_lo(a.z) + h_hi(a.z) * h_hi(a.z)) + (h_lo(a.w) * h_lo(a.w) + h_hi(a.w) * h_hi(a.w));
                const h8n af = __builtin_bit_cast(h8n, a);
                acc = __builtin_amdgcn_mfma_f32_16x16x32_f16(af, __builtin_bit_cast(h8n, bh), acc, 0, 0, 0); acc = __builtin_amdgcn_mfma_f32_16x16x32_f16(af, __builtin_bit_cast(h8n, bl), acc, 0, 0, 0);
            } else { const f32x4 x0 = *(const f32x4*)((const float*)Xv + row * D + k0), x1 = *(const f32x4*)((const float*)Xv + row * D + k0 + 4);
                ss += (x0[0] * x0[0] + x0[1] * x0[1]) + (x0[2] * x0[2] + x0[3] * x0[3]) + (x1[0] * x1[0] + x1[1] * x1[1]) + (x1[2] * x1[2] + x1[3] * x1[3]);
                v4u o; o.x = pk2(x0[0], x0[1]); o.y = pk2(x0[2], x0[3]); o.z = pk2(x1[0], x1[1]); o.w = pk2(x1[2], x1[3]); *(v4u*)(XN + row * D + k0) = o;
                v4u ah, al;
                ah.x = pkh(x0[0], x0[1]); ah.y = pkh(x0[2], x0[3]); ah.z = pkh(x1[0], x1[1]); ah.w = pkh(x1[2], x1[3]);
                al.x = pkh(x0[0] - h_lo(ah.x), x0[1] - h_hi(ah.x)); al.y = pkh(x0[2] - h_lo(ah.y), x0[3] - h_hi(ah.y)); al.z = pkh(x1[0] - h_lo(ah.z), x1[1] - h_hi(ah.z)); al.w = pkh(x1[2] - h_lo(ah.w), x1[3] - h_hi(ah.w));
                const h8n afh = __builtin_bit_cast(h8n, ah), afl = __builtin_bit_cast(h8n, al);
                acc = __builtin_amdgcn_mfma_f32_16x16x32_f16(afh, __builtin_bit_cast(h8n, bh), acc, 0, 0, 0); acc = __builtin_amdgcn_mfma_f32_16x16x32_f16(afh, __builtin_bit_cast(h8n, bl), acc, 0, 0, 0);
                acc = __builtin_amdgcn_mfma_f32_16x16x32_f16(afl, __builtin_bit_cast(h8n, bh), acc, 0, 0, 0); } }
        ss += __shfl_xor(ss, 16); ss += __shfl_xor(ss, 32);
        const float rstd = 1.f / sqrtf(ss * (1.f / D) + RMS_EPS);
        if (kg == 0) rstdo[row] = rstd;
#pragma unroll
        for (int i = 0; i < 4; ++i) { const float rs = __shfl(rstd, 4 * kg + i); const float g = acc[i] * rs; const size_t m = (size_t)grp * 16 + 4 * kg + i;
            if (NG == 8) { if (r16 < 8) outA[m * 8 + r16] = log_sigmoid_f(g + bias_a[r16 & 7]); }
            else { if (r16 < 8) outA[m * 8 + r16] = g + bias_a[r16 & 7]; else outB[m * 8 + r16 - 8] = log_sigmoid_f(g + bias_b[r16 & 7]); } }
    }
}
__device__ __forceinline__ void cumsum_phase(const Ctx& C) {
    if (C.bid >= 16) return;
    const int bh = C.bid, b = bh >> 3, h = bh & 7, t = (int)threadIdx.x;
    const float* lp = (const float*)(C.ws + WS_LOGF) + ((size_t)b * SEQ + 32 * t) * 8 + h;
    float v[32]; float run = 0.f;
#pragma unroll
    for (int i = 0; i < 32; ++i) { run += lp[i * 8]; v[i] = run; }
    float x = run;
#pragma unroll
    for (int o = 1; o < 64; o <<= 1) { const float y = __shfl_up(x, o); if (((int)threadIdx.x & 63) >= o) x += y; }
    volatile LAS float* wt = (volatile LAS float*)(C.lds + LDSCTL_OFF);
    if (((int)threadIdx.x & 63) == 63) wt[__builtin_amdgcn_readfirstlane((int)threadIdx.x >> 6)] = x;
    __syncthreads();
    float off = x - run;
    for (int w = 0; w < __builtin_amdgcn_readfirstlane((int)threadIdx.x >> 6); ++w) off += wt[w];
    float* F2 = (float*)(C.ws + WS_F2) + (size_t)bh * SEQ + 32 * t;
    v4u* QE = (v4u*)(C.ws + WS_QE) + (size_t)bh * SEQ + 32 * t; v4u* KE = (v4u*)(C.ws + WS_KE) + (size_t)bh * SEQ + 32 * t;
#pragma unroll
    for (int i = 0; i < 32; ++i) { const float f = (off + v[i]) * LOG2E; F2[i] = f;
        const unsigned h0 = f2bf(f); const float r1 = f - __builtin_bit_cast(float, h0 << 16); const unsigned h1 = f2bf(r1); const float r2 = r1 - __builtin_bit_cast(float, h1 << 16); const unsigned h2 = f2bf(r2);
        v4u q; q.x = h0 | (h1 << 16); q.y = h2 | (0x3F80u << 16); q.z = 0x3F80u | (0x3F80u << 16); q.w = 0u; QE[i] = q;
        v4u k; k.x = 0x3F80u | (0x3F80u << 16); k.y = 0x3F80u | ((h0 ^ 0x8000u) << 16); k.z = (h1 ^ 0x8000u) | ((h2 ^ 0x8000u) << 16); k.w = 0u; KE[i] = k; }
    __syncthreads();
}
__device__ __forceinline__ void he_cols(int he, int& qc, int& kc, int& vc, int& oc) {
    if (he < 8) { qc = he * 64; kc = 512 + he * 64; vc = 1024 + he * 64; oc = he * 64; }
    else { const int j = he - 8, hd = j >> 2, c = (j >> 1) & 1, e = j & 1; qc = 1536 + (hd * 2 + c) * 64; kc = 2048 + (hd * 2 + c) * 64; vc = 2560 + hd * 128 + e * 64; oc = 512 + j * 64; }
}
__device__ __forceinline__ int fox_t0(const float* F2b, int qb, float qk2, int lane) {
    const int NTf = 4 * (qb + 1); const float fq = F2b[qb * 256]; int cnt = 0;
#pragma unroll
    for (int k = 0; k < 4; ++k) { const int t = lane + 64 * k; const bool skip = (t < NTf) && (qk2 + fq - F2b[64 * t + 63] < -150.f); cnt += __builtin_popcountll(__ballot(skip)); }
    int t0 = cnt; if (t0 > NTf - 4) t0 = NTf - 4; return __builtin_amdgcn_readfirstlane(t0);
}
__device__ __forceinline__ void attn_tuned_phase(const Ctx& C) {
    typedef attn_body::bf16 abf;
    const abf* P = (const abf*)(C.ws + WS_PROJ); abf* OB = (abf*)(C.ws + WS_OB); const float* F2 = (const float*)(C.ws + WS_F2); const abf* KE = (const abf*)(C.ws + WS_KE);
    const int vcu = (C.G % 8 == 0) ? (C.bid % 8) * (C.G / 8) + C.bid / 8 : C.bid;
    char* shm = C.ldsg + RING_OFF; gu32* ctl = (gu32*)(C.ws + WS_CTL);
    const int tid = threadIdx.x;
    volatile LAS unsigned* qslot = (volatile LAS unsigned*)(C.lds + LDSCTL_OFF + 64);
    bool fox_nomax, diff_nomax;
    { const int l = tid & 63; float bound = 0.f;
      if (l < 32) { const int dif = l >> 4, i = l & 15; const gu32* nq = ctl + CW_NRM + dif * 64 + i * 2; const gu32* nk = nq + 32;
          const float qn2 = __builtin_bit_cast(float, __hip_atomic_load(nq, RLX_AGENT)) + __builtin_bit_cast(float, __hip_atomic_load(nq + 1, RLX_AGENT));
          const float kn2 = __builtin_bit_cast(float, __hip_atomic_load(nk, RLX_AGENT)) + __builtin_bit_cast(float, __hip_atomic_load(nk + 1, RLX_AGENT));
          bound = 1.02f * sqrtf(qn2 * kn2); }
      const unsigned long long ok = __ballot(bound <= 100.f);
      fox_nomax = (ok & 0xffffull) == 0xffffull; diff_nomax = ((ok >> 16) & 0xffffull) == 0xffffull; }
#ifndef ATT_NO_DIFF
    float lam;
    { const int l = tid & 63; const float d1 = kin(5)[l] * kin(6)[l], d2 = kin(7)[l] * kin(8)[l]; lam = __expf(wave_sum(d1)) - __expf(wave_sum(d2)) + 0.2f; }
    float* subg = (float*)(C.ws + WS_SUBG);
    if (tid < 128) subg[tid] = kin(9)[tid] * 0.8f;
    abf* Yd = (abf*)(C.ws + WS_XN);
#define DIFF_LOOP(NM) _Pragma("nounroll") \
    for (int it = 0; it < 8 * 8 * 64; ++it) { const int p = vcu + (it >> 2) * C.G; if (p >= 8 * 32) break; \
        const int bh = p >> 5, s = p & 31, b = bh >> 2, hd = bh & 3, c = it & 1, qb = (it & 2) ? s : 63 - s;     \
        const abf* Pb = P + (size_t)b * SEQ * NPJ; abf* Osc = OB + (size_t)b * SEQ * 512 + hd * 128; \
        const abf* KTb = (const abf*)(C.ws + WS_OB + 32 * MiB) + (size_t)((b * 8 + hd * 2 + c) * 256) * 4096; const abf* VTb = (const abf*)(C.ws + WS_OB + 64 * MiB) + (size_t)((b * 4 + hd) * 256) * 8192; \
        attn256::unit<8, 4, false, NM>(c, qb, 0, Pb + 1536 + (hd * 2 + c) * 64, KTb, VTb, Osc, Pb + 3072 + 512 + hd * 128, Yd + (size_t)b * SEQ * 1024 + 512 + hd * 128, subg, lam, nullptr, nullptr, shm); }
    if (diff_nomax) { DIFF_LOOP(true) } else { DIFF_LOOP(false) }
#undef DIFF_LOOP
#endif
#ifndef ATT_NO_FOX
    if (tid == 0) *qslot = __hip_atomic_fetch_add(ctl + CW_FOXQ, 1u, RLX_AGENT);
    __syncthreads();
    unsigned u = __builtin_amdgcn_readfirstlane(*qslot);
#define FOX_LOOP(NM) _Pragma("nounroll") \
    while (u < 1024u) { \
        __syncthreads(); \
        if (tid == 0) *qslot = __hip_atomic_fetch_add(ctl + CW_FOXQ, 1u, RLX_AGENT); \
        const int qb = 63 - (int)(u >> 4), bh = (int)(u & 15u), b = bh >> 3, he = bh & 7; int qc, kc, vc, oc; he_cols(he, qc, kc, vc, oc); \
        const gu32* nq = ctl + CW_NRM + ((0 * 2 + b) * 8 + he) * 2; const gu32* nk = ctl + CW_NRM + ((1 * 2 + b) * 8 + he) * 2; \
        const float qn2 = __builtin_bit_cast(float, __hip_atomic_load(nq, RLX_AGENT)) + __builtin_bit_cast(float, __hip_atomic_load(nq + 1, RLX_AGENT)); \
        const float kn2 = __builtin_bit_cast(float, __hip_atomic_load(nk, RLX_AGENT)) + __builtin_bit_cast(float, __hip_atomic_load(nk + 1, RLX_AGENT)); \
        const float qk2 = 2.04f * sqrtf(qn2 * kn2); \
        const float* F2b = F2 + (size_t)bh * SEQ; \
        const int t0 = fox_t0(F2b, qb, qk2, tid & 63); \
        const abf* Pb = P + (size_t)b * SEQ * NPJ; \
        attn256::unit<8, 2, true, NM>(2, qb, t0, Pb + qc, Pb + kc, Pb + vc, nullptr, Pb + 3072 + oc, (abf*)(C.ws + WS_XN) + (size_t)b * SEQ * 1024 + oc, nullptr, 0.f, F2b, KE + (size_t)bh * SEQ * 8, shm); \
        u = __builtin_amdgcn_readfirstlane(*qslot); }
    if (fox_nomax) { FOX_LOOP(true) } else { FOX_LOOP(false) }
#undef FOX_LOOP
#endif
}
__device__ __forceinline__ void final_norm_phase(const Ctx& C, const bf16* X2) {
    const int lane = (int)threadIdx.x & 63, gw = C.bid * NWAVES + __builtin_amdgcn_readfirstlane((int)threadIdx.x >> 6), NGW = C.G * NWAVES; const float* g = kin(16);
    f32x4 gv[4];
#pragma unroll
    for (int j = 0; j < 4; ++j) gv[j] = ((const f32x4*)g)[lane + 64 * j];
    unsigned long long nh[4];
#define FN_LOAD(mm) do { const GAS unsigned long long* xb = (const GAS unsigned long long*)(X2 + (size_t)(mm) * D) + lane; _Pragma("unroll") for (int j = 0; j < 4; ++j) nh[j] = xb[64 * j]; } while (0)
    if (gw < M) FN_LOAD(gw);
    for (int m = gw; m < M; m += NGW) {
        f32x4 v[4]; float ss = 0.f;
#pragma unroll
        for (int j = 0; j < 4; ++j) { const unsigned long long w = nh[j]; const unsigned lo = (unsigned)w, hi = (unsigned)(w >> 32); v[j] = (f32x4){h_lo(lo), h_hi(lo), h_lo(hi), h_hi(hi)};
            ss += (v[j].x * v[j].x + v[j].y * v[j].y) + (v[j].z * v[j].z + v[j].w * v[j].w); }
        if (m + NGW < M) FN_LOAD(m + NGW);
        const float rstd = 1.f / sqrtf(wave_sum(ss) * (1.f / D) + RMS_EPS);
        GAS f32x4* xr = (GAS f32x4*)(C.out + (size_t)m * D) + lane;
#pragma unroll
        for (int j = 0; j < 4; ++j) xr[64 * j] = v[j] * rstd * gv[j];
    }
}
#undef FN_LOAD
typedef float f32x16m __attribute__((ext_vector_type(16)));
typedef _Float16 h8m __attribute__((ext_vector_type(8))); typedef _Float16 h2m __attribute__((ext_vector_type(2))); typedef float f2m __attribute__((ext_vector_type(2)));
__device__ __forceinline__ unsigned pkh2(float lo, float hi) { const f2m v = {lo, hi}; return __builtin_bit_cast(unsigned, __builtin_convertvector(v, h2m)); }
__device__ __forceinline__ float hlo(unsigned w) { return (float)__builtin_bit_cast(h2m, w)[0]; }
__device__ __forceinline__ float hhi(unsigned w) { return (float)__builtin_bit_cast(h2m, w)[1]; }
#define MFMA_H(a, b, c) __builtin_amdgcn_mfma_f32_32x32x16_f16(__builtin_bit_cast(h8m, (a)), __builtin_bit_cast(h8m, (b)), (c), 0, 0, 0)
typedef short s16x4m __attribute__((ext_vector_type(4)));
__device__ __forceinline__ int crow_m(int reg, int hh) { return (reg & 3) + 8 * (reg >> 2) + 4 * hh; }
__device__ __forceinline__ s16x4m tr4(const LAS unsigned char* p) { return __builtin_bit_cast(s16x4m, __builtin_amdgcn_ds_read_tr16_b64_v4i16((LAS s16x4m*)p)); }
__device__ __forceinline__ bf16x8 tr_frag(const LAS unsigned char* base, int stride, int row0, int col0, int lane, int hmul, int rstep) {
    const int hh = lane >> 5, blk = (lane >> 4) & 1, q = (lane & 15) >> 2, p = lane & 3;
    const LAS unsigned char* a = base + (row0 + hmul * hh + q) * stride + (col0 + 16 * blk + 4 * p) * 2;
    const s16x4m lo = tr4(a), hi = tr4(a + rstep * stride);
    return (bf16x8){lo[0], lo[1], lo[2], lo[3], hi[0], hi[1], hi[2], hi[3]};
}
__device__ __forceinline__ void mlstm_scan_phase(const Ctx& C) {
    const int lane = threadIdx.x & 63, gw = C.bid * NWAVES + __builtin_amdgcn_readfirstlane((int)threadIdx.x >> 6), NGW = C.G * NWAVES;
    const float* LI = (const float*)(C.ws + WS_LI); const float* LF = (const float*)(C.ws + WS_LF);
    float* GB = (float*)(C.ws + WS_GB); float* GE = (float*)(C.ws + WS_GE); float* GU = (float*)(C.ws + WS_GU); float* CHA = (float*)(C.ws + WS_CHA); float* CHE = (float*)(C.ws + WS_CHE);
    for (int id = gw; id < 2048; id += NGW) { const int bh = id >> 7, c = id & 127, b = bh >> 3, h = bh & 7; const size_t r0 = (size_t)b * SEQ + c * 128 + 2 * lane;
        const float lf0 = LF[r0 * 8 + h], lf1 = LF[(r0 + 1) * 8 + h], li0 = LI[r0 * 8 + h], li1 = LI[(r0 + 1) * 8 + h];
        const float ps = lf0 + lf1; float x = ps;
#pragma unroll
        for (int o = 1; o < 64; o <<= 1) { const float y = __shfl_up(x, o); if (lane >= o) x += y; }
        const float b0 = (x - ps) + lf0, b1 = x, e0 = li0 - b0, e1 = li1 - b1;
        float y = fmaxf(e0, e1);
#pragma unroll
        for (int o = 1; o < 64; o <<= 1) { const float z = __shfl_up(y, o); if (lane >= o) y = fmaxf(y, z); }
        float prev = __shfl_up(y, 1); if (lane == 0) prev = -INFINITY;
        const float u0 = fmaxf(prev, e0), u1 = fmaxf(u0, e1);
        const size_t o2 = (size_t)id * 128 + 2 * lane;
        *(float2*)(GB + o2) = make_float2(b0, b1); *(float2*)(GE + o2) = make_float2(e0, e1); *(float2*)(GU + o2) = make_float2(u0, u1);
        if (lane == 63) { CHA[id] = b1; CHE[id] = u1; }
    }
}
__device__ __forceinline__ void mlstm_dc_phase(const Ctx& C) {
    const int tid = threadIdx.x, lane = tid & 63, wave = __builtin_amdgcn_readfirstlane(tid >> 6);
    const bf16* P = (const bf16*)(C.ws + WS_PROJ); bf16* DC = (bf16*)(C.ws + WS_OB); float* DN = (float*)(C.ws + WS_DN);
    const float* GE = (const float*)(C.ws + WS_GE); const float* CHE = (const float*)(C.ws + WS_CHE);
    LAS unsigned char* Ks = C.lds; LAS unsigned char* Vs = C.lds + 18432; LAS float* wsm = (LAS float*)(C.lds + 53248);
    v4u pk[2], pv[4]; float pge = 0.f, pche = 0.f;
#define M3_LOAD(u_) do { const int bh_ = (u_) >> 7, c_ = (u_) & 127, b_ = bh_ >> 3, h_ = bh_ & 7; const size_t r0_ = (size_t)b_ * SEQ + c_ * 128; \
        _Pragma("unroll") for (int i = 0; i < 2; ++i) { const int idx = tid + 512 * i, r = idx >> 3, ch = idx & 7; pk[i] = *(const v4u*)(P + (size_t)16777216 + (size_t)(u_) * 8192 + r * 64 + ch * 8); } \
        _Pragma("unroll") for (int i = 0; i < 4; ++i) { const int idx = tid + 512 * i, r = idx >> 4, ch = idx & 15; pv[i] = *(const v4u*)(P + (size_t)33554432 + (size_t)(u_) * 16384 + r * 128 + ch * 8); } \
        pche = CHE[(u_)]; if (tid < 128) pge = GE[(size_t)(u_) * 128 + tid]; } while (0)
    int unit = C.bid; if (unit < 2048) M3_LOAD(unit);
    while (unit < 2048) {
        if (tid < 128) wsm[tid] = __expf(pge - pche);
#pragma unroll
        for (int i = 0; i < 2; ++i) { const int idx = tid + 512 * i, r = idx >> 3, ch = idx & 7; *(LAS v4u*)(Ks + r * 144 + ch * 16) = pk[i]; }
        __syncthreads();
#pragma unroll
        for (int i = 0; i < 4; ++i) { const int idx = tid + 512 * i, r = idx >> 4, ch = idx & 15; const v4u v = pv[i]; const float w = wsm[r]; v4u o;
            o.x = pkh2(hlo(v.x) * w, hhi(v.x) * w); o.y = pkh2(hlo(v.y) * w, hhi(v.y) * w); o.z = pkh2(hlo(v.z) * w, hhi(v.z) * w); o.w = pkh2(hlo(v.w) * w, hhi(v.w) * w);
            *(LAS v4u*)(Vs + r * 272 + ch * 16) = o; }
        __syncthreads();
        const int cur = unit; unit += C.G; if (unit < 2048) M3_LOAD(unit);
        { const int db = wave >> 2, eb = wave & 3, r = lane & 31, hh = lane >> 5; f32x16m acc = {};
#pragma unroll
          for (int ks = 0; ks < 8; ++ks) { const bf16x8 a = tr_frag(Ks, 144, 16 * ks, 32 * db, lane, 8, 4), bb = tr_frag(Vs, 272, 16 * ks, 32 * eb, lane, 8, 4);
              acc = MFMA_H(a, bb, acc); }
          bf16* o = DC + (size_t)cur * 8192 + (size_t)(32 * eb + r) * 64 + 32 * db + 4 * hh;
#pragma unroll
          for (int g = 0; g < 4; ++g) { unsigned long long w = (unsigned long long)pkh2(acc[4 * g], acc[4 * g + 1]) | ((unsigned long long)pkh2(acc[4 * g + 2], acc[4 * g + 3]) << 32); *(unsigned long long*)(o + 8 * g) = w; } }
        if (tid < 64) { float acc = 0.f; for (int s = 0; s < 128; ++s) acc += wsm[s] * (float)*(const LAS _Float16*)(Ks + s * 144 + tid * 2); DN[(size_t)cur * 64 + tid] = acc; }
        __syncthreads();
    }
#undef M3_LOAD
}
__device__ __forceinline__ void mlstm_state_phase(const Ctx& C) {
    const int tid = threadIdx.x;
    const bf16* DC = (const bf16*)(C.ws + WS_OB); bf16* CST = (bf16*)(C.ws + WS_OB + 64 * MiB); const float* DN = (const float*)(C.ws + WS_DN); float* NS = (float*)(C.ws + WS_NS);
    const float* CHA = (const float*)(C.ws + WS_CHA); const float* CHE = (const float*)(C.ws + WS_CHE); float* CHM = (float*)(C.ws + WS_CHM);
    LAS float* wold = (LAS float*)(C.lds); LAS float* scl = wold + 128; LAS float* aa = scl + 128; LAS float* ee = aa + 128;
    for (int vb = C.bid; vb < 256; vb += C.G) { const int bh = vb >> 4, part = vb & 15;
        if (tid < 128) { aa[tid] = CHA[bh * 128 + tid]; ee[tid] = CHE[bh * 128 + tid]; }
        __syncthreads();
        if (tid < 64) { const float a0 = aa[2 * tid], e0 = ee[2 * tid], a1 = aa[2 * tid + 1], e1 = ee[2 * tid + 1];
            float A = a0 + a1, B = fmaxf(e0 + a0 + a1, e1 + a1);
#pragma unroll
            for (int o = 1; o < 64; o <<= 1) { const float Ap = __shfl_up(A, o), Bp = __shfl_up(B, o); if (tid >= o) { B = fmaxf(Bp + A, B); A = Ap + A; } }
            float Ae = __shfl_up(A, 1), Be = __shfl_up(B, 1); if (tid == 0) { Ae = 0.f; Be = -INFINITY; }
            const float m0 = fmaxf(0.f + Ae, Be), mx0 = fmaxf(m0, e0), m1 = a0 + mx0, mx1 = fmaxf(m1, e1);
            wold[2 * tid] = __expf(m0 - mx0); scl[2 * tid] = __expf(e0 - mx0); wold[2 * tid + 1] = __expf(m1 - mx1); scl[2 * tid + 1] = __expf(e1 - mx1);
            if (part == 0) { CHM[bh * 128 + 2 * tid] = m0; CHM[bh * 128 + 2 * tid + 1] = m1; } }
        __syncthreads();
        { const size_t idx = (size_t)part * 512 + tid; const bf16* dc = DC + (size_t)bh * 128 * 8192 + idx; bf16* cs = CST + (size_t)bh * 128 * 8192 + idx; float cv = 0.f;
#pragma unroll 16
          for (int c = 0; c < 128; ++c) { const float d = (float)__builtin_bit_cast(_Float16, dc[(size_t)c * 8192]); cs[(size_t)c * 8192] = __builtin_bit_cast(unsigned short, (_Float16)fminf(fmaxf(cv, -60000.f), 60000.f)); cv = wold[c] * cv + scl[c] * d; } }
        if (part == 0 && tid < 64) { const float* dn = DN + (size_t)bh * 128 * 64 + tid; float* ns = NS + (size_t)bh * 128 * 64 + tid; float nv = 0.f;
#pragma unroll 8
          for (int c = 0; c < 128; ++c) { const float d = dn[c * 64]; ns[c * 64] = nv; nv = wold[c] * nv + scl[c] * d; } }
        __syncthreads();
    }
#undef M5_LOAD
}
__device__ __forceinline__ void mlstm_out_phase(const Ctx& C) {
    const int tid = threadIdx.x, lane = tid & 63, wave = __builtin_amdgcn_readfirstlane(tid >> 6);
    const bf16* P = (const bf16*)(C.ws + WS_PROJ); bf16* Y = (bf16*)(C.ws + WS_XN); const bf16* CST = (const bf16*)(C.ws + WS_OB + 64 * MiB); const float* NS = (const float*)(C.ws + WS_NS);
    const float* GB = (const float*)(C.ws + WS_GB); const float* GE = (const float*)(C.ws + WS_GE); const float* GU = (const float*)(C.ws + WS_GU); const float* CHM = (const float*)(C.ws + WS_CHM);
    LAS unsigned char* Qs = C.lds; LAS unsigned char* Ks = C.lds + 18432; LAS unsigned char* Vs = C.lds + 36864; LAS unsigned char* Cts = C.lds + 71680;
    LAS float* e2 = (LAS float*)(C.lds + 90112); LAS float* M2 = e2 + 128; LAS float* wint = M2 + 128; LAS float* flr = wint + 128; LAS float* nsl = flr + 128; LAS float* invw = nsl + 64 + wave * 32;
    LAS float* Hs = (LAS float*)(C.lds);
    v4u pq[2], pkk[2], pc[2], pv[4], pog[4]; float pe = 0.f, pu = 0.f, pb = 0.f, pns = 0.f, pmc = 0.f;
#define M5_LOAD(u_) do { const int bh_ = (u_) >> 7, c_ = (u_) & 127, b_ = bh_ >> 3, h_ = bh_ & 7; const size_t r0_ = (size_t)b_ * SEQ + c_ * 128; \
        _Pragma("unroll") for (int i = 0; i < 2; ++i) { const int idx = tid + 512 * i, r = idx >> 3, ch = idx & 7; const bf16* src = P + (size_t)(u_) * 8192 + r * 64 + ch * 8; \
            pq[i] = *(const v4u*)(src); pkk[i] = *(const v4u*)(src + 16777216); pc[i] = *(const v4u*)(CST + (size_t)(u_) * 8192 + r * 64 + ch * 8); } \
        _Pragma("unroll") for (int i = 0; i < 4; ++i) { const int idx = tid + 512 * i, r = idx >> 4, ch = idx & 15; pv[i] = *(const v4u*)(P + (size_t)33554432 + (size_t)(u_) * 16384 + r * 128 + ch * 8); } \
        pmc = CHM[(u_)]; if (tid < 128) { const size_t gi = (size_t)(u_) * 128 + tid; pe = GE[gi]; pu = GU[gi]; pb = GB[gi]; } else if (tid < 192) pns = NS[(size_t)(u_) * 64 + tid - 128]; } while (0)
    int unit = C.bid; if (unit < 2048) M5_LOAD(unit);
    while (unit < 2048) { const int bh = unit >> 7, c = unit & 127, b = bh >> 3, h = bh & 7; const size_t row0 = (size_t)b * SEQ + c * 128;
        { const float mc = pmc;
          if (tid < 128) { const float Mt = fmaxf(mc, pu); e2[tid] = pe * LOG2E; M2[tid] = Mt * LOG2E; wint[tid] = __expf(mc - Mt); flr[tid] = __expf(-(pb + Mt)); }
          else if (tid < 192) nsl[tid - 128] = pns; }
#pragma unroll
        for (int i = 0; i < 2; ++i) { const int idx = tid + 512 * i, r = idx >> 3, ch = idx & 7; *(LAS v4u*)(Qs + r * 144 + ch * 16) = pq[i]; *(LAS v4u*)(Ks + r * 144 + ch * 16) = pkk[i]; *(LAS v4u*)(Cts + r * 144 + ch * 16) = pc[i]; }
#pragma unroll
        for (int i = 0; i < 4; ++i) { const int idx = tid + 512 * i, r = idx >> 4, ch = idx & 15; *(LAS v4u*)(Vs + r * 272 + ch * 16) = pv[i]; }
        __syncthreads();
        { const int nxt = unit + C.G; if (nxt < 2048) M5_LOAD(nxt); }
#pragma unroll
        for (int i = 0; i < 4; ++i) { const int idx = tid + 512 * i, t = idx >> 4, ch = idx & 15; pog[i] = *(const v4u*)(P + (size_t)67108864 + (size_t)unit * 16384 + t * 128 + ch * 8); }
        const int tb = wave & 3, eh = wave >> 2, r = lane & 31, hh = lane >> 5;
        f32x16m acc[2]; acc[0] = f32x16m{}; acc[1] = f32x16m{};
        bf16x8 qf[4];
#pragma unroll
        for (int kd = 0; kd < 4; ++kd) qf[kd] = *(const LAS bf16x8*)(Qs + (32 * tb + r) * 144 + (16 * kd + 8 * hh) * 2);
#pragma unroll
        for (int kd = 0; kd < 4; ++kd)
#pragma unroll
            for (int j = 0; j < 2; ++j) { const bf16x8 cf = *(const LAS bf16x8*)(Cts + (64 * eh + 32 * j + r) * 144 + (16 * kd + 8 * hh) * 2); acc[j] = MFMA_H(qf[kd], cf, acc[j]); }
#pragma unroll
        for (int g = 0; g < 4; ++g) { const f32x4 w4 = *(const LAS f32x4*)(wint + 32 * tb + 8 * g + 4 * hh);
#pragma unroll
            for (int i = 0; i < 4; ++i) { acc[0][4 * g + i] *= w4[i]; acc[1][4 * g + i] *= w4[i]; } }
        float qn = 0.f;
#pragma unroll
        for (int c4 = 0; c4 < 4; ++c4) { const v4u qv = *(const LAS v4u*)(Qs + (32 * tb + r) * 144 + (32 * hh + 8 * c4) * 2); const f32x4 n0 = *(const LAS f32x4*)(nsl + 32 * hh + 8 * c4), n1 = *(const LAS f32x4*)(nsl + 32 * hh + 8 * c4 + 4);
            qn += hlo(qv.x) * n0[0] + hhi(qv.x) * n0[1] + hlo(qv.y) * n0[2] + hhi(qv.y) * n0[3] + hlo(qv.z) * n1[0] + hhi(qv.z) * n1[1] + hlo(qv.w) * n1[2] + hhi(qv.w) * n1[3]; }
        float den = 0.f; const float M2t = M2[32 * tb + r];
        for (int sb = 0; sb <= tb; ++sb) {
            f32x16m X = {};
#pragma unroll
            for (int kd = 0; kd < 4; ++kd) { const bf16x8 kf = *(const LAS bf16x8*)(Ks + (32 * sb + r) * 144 + (16 * kd + 8 * hh) * 2); X = MFMA_H(kf, qf[kd], X); }
#pragma unroll
            for (int g = 0; g < 4; ++g) { const f32x4 e4 = *(const LAS f32x4*)(e2 + 32 * sb + 8 * g + 4 * hh);
#pragma unroll
                for (int i = 0; i < 4; ++i) { const bool valid = (sb < tb) || (8 * g + 4 * hh + i <= r); const float p = valid ? X[4 * g + i] * __builtin_amdgcn_exp2f(e4[i] - M2t) : 0.f; den += p; X[4 * g + i] = p; } }
#pragma unroll
            for (int ks2 = 0; ks2 < 2; ++ks2) { u32x4m pw; pw.x = pkh2(X[8 * ks2], X[8 * ks2 + 1]); pw.y = pkh2(X[8 * ks2 + 2], X[8 * ks2 + 3]); pw.z = pkh2(X[8 * ks2 + 4], X[8 * ks2 + 5]); pw.w = pkh2(X[8 * ks2 + 6], X[8 * ks2 + 7]);
                const bf16x8 pf = __builtin_bit_cast(bf16x8, pw);
#pragma unroll
                for (int j = 0; j < 2; ++j) { const bf16x8 vf = tr_frag(Vs, 272, 32 * sb + 16 * ks2, 64 * eh + 32 * j, lane, 4, 8); acc[j] = MFMA_H(pf, vf, acc[j]); } }
        }
        { const auto rr = __builtin_amdgcn_permlane32_swap(__float_as_uint(den), __float_as_uint(den), false, false); den = __uint_as_float(rr[0]) + __uint_as_float(rr[1]);
          const auto r2 = __builtin_amdgcn_permlane32_swap(__float_as_uint(qn), __float_as_uint(qn), false, false); qn = __uint_as_float(r2[0]) + __uint_as_float(r2[1]); }
        const float denT = wint[32 * tb + r] * qn + den, invv = 1.f / fmaxf(fabsf(denT), flr[32 * tb + r]);
        if (hh == 0) invw[r] = invv;
        LDS_WAIT();
#pragma unroll
        for (int g = 0; g < 4; ++g) { const f32x4 i4 = *(const LAS f32x4*)(invw + 8 * g + 4 * hh);
#pragma unroll
            for (int i = 0; i < 4; ++i) { acc[0][4 * g + i] *= i4[i]; acc[1][4 * g + i] *= i4[i]; } }
        __syncthreads();
#pragma unroll
        for (int j = 0; j < 2; ++j)
#pragma unroll
            for (int reg = 0; reg < 16; ++reg) Hs[(32 * tb + crow_m(reg, hh)) * 132 + 64 * eh + 32 * j + r] = acc[j][reg];
        __syncthreads();
#pragma unroll
        for (int i = 0; i < 4; ++i) { const int idx = tid + 512 * i, t = idx >> 4, ch = idx & 15; const f32x4 h0 = *(const LAS f32x4*)(Hs + t * 132 + ch * 8), h1 = *(const LAS f32x4*)(Hs + t * 132 + ch * 8 + 4);
            const v4u gg = pog[i]; v4u o;
            o.x = pk2(bflo(gg.x) * h0[0], bfhi(gg.x) * h0[1]); o.y = pk2(bflo(gg.y) * h0[2], bfhi(gg.y) * h0[3]); o.z = pk2(bflo(gg.z) * h1[0], bfhi(gg.z) * h1[1]); o.w = pk2(bflo(gg.w) * h1[2], bfhi(gg.w) * h1[3]);
            *(v4u*)(Y + (row0 + t) * 1024 + h * 128 + ch * 8) = o; }
        unit += C.G;
        __syncthreads();
    }
#undef M5_LOAD
}
#ifndef WGM_PROJ
#define WGM_PROJ 2
#endif
#ifndef WGM_OUT
#define WGM_OUT 2
#endif
struct Args { const float* in[17]; float* out; unsigned char* ws; int ph_lo, ph_hi; };
__global__ void __launch_bounds__(NWAVES * 64, 2) fwd_kernel(Args args) {
    extern __shared__ __attribute__((aligned(16))) unsigned char lds[];
    Ctx C;
    C.lds = (LAS unsigned char*)lds; C.ldsg = (char*)lds; C.G = gridDim.x; C.bid = blockIdx.x;
    C.out = args.out; C.ws = args.ws;
    volatile LAS unsigned* MISC = (volatile LAS unsigned*)(C.lds + MISC_OFF);
    gu32* ctl = (gu32*)(C.ws + WS_CTL);
    for (int u = (int)threadIdx.x; u < (LDS_BYTES - LDSCTL_OFF) / 4; u += NWAVES * 64) ((LAS unsigned*)(C.lds + LDSCTL_OFF))[u] = 0u;
    __syncthreads();
    XcdBarrier bar; bar.bar = (unsigned*)(ctl + CW_BAR); bar.x = 0; bar.st = nullptr;
    if (MK_ONE_LAUNCH) bar = xcd_barrier_post((unsigned*)(ctl + CW_BAR), MISC + 8);
#define GRID_BAR() do { if (MK_ONE_LAUNCH) xcd_barrier(bar); } while (0)
    const int lo = args.ph_lo, hi = args.ph_hi;
#ifndef PH_MASK
#define PH_MASK 0xffff
#endif
#define IN(k) (((PH_MASK >> (k)) & 1) && lo <= (k) && (k) < hi)
#define BOTH(k) (IN(k) && IN((k) + 1))
    bf16* XN = (bf16*)(C.ws + WS_XN); bf16* PROJ = (bf16*)(C.ws + WS_PROJ);
    bf16* X1B = (bf16*)C.out;
    bf16* X2B = (bf16*)(C.ws + WS_OB);

    if (IN(0)) { prologue_weights(C); __syncthreads();
        norm_gate_phase<8, false>(C, kin(0), kin(3), ATTN_IN, 1536, kin(2), kin(4), nullptr, XN, (float*)(C.ws + WS_LOGF), nullptr, (float*)(C.ws + WS_RSTD));
        if (BOTH(0)) GRID_BAR(); }
    if (IN(1)) { cumsum_phase(C);
      {
        pg8::Gemm g{XN, (const bf16*)(C.ws + WS_WIN0), M, NPJ, D}; pg8::StaticOrder S; S.init(M, NPJ, C.G, C.bid, WGM_PROJ);
        pg8::EpiProj0 E{PROJ, (const float*)(C.ws + WS_ROPE), C2, (unsigned*)(ctl + CW_NRM), (bf16*)(C.ws + WS_OB + 32 * MiB), (bf16*)(C.ws + WS_OB + 64 * MiB), (const float*)(C.ws + WS_RSTD)};
        pg8::gemm_phase<pg8::EpiProj0, pg8::StaticOrder, true, true>(C.lds + RING_OFF, g, S, E);
        if (BOTH(1)) GRID_BAR(); } }
    if (IN(2)) { attn_tuned_phase(C);
        if (BOTH(2)) GRID_BAR(); }
    if (IN(4)) { pg8::Gemm g{XN, (const bf16*)(C.ws + WS_WOUT0), M, D, D}; pg8::StaticOrder S; S.init(M, D, C.G, C.bid, WGM_OUT);
        pg8::EpiResidF2B E{kin(0), X1B};
        pg8::gemm_phase<pg8::EpiResidF2B, pg8::StaticOrder, true, true>(C.lds + RING_OFF, g, S, E);
        if (BOTH(4)) GRID_BAR(); }
    if (IN(5)) { norm_gate_phase<16, true>(C, X1B, kin(12), ML_IN, 2048, kin(11), kin(13), kin(14), nullptr, (float*)(C.ws + WS_LI), (float*)(C.ws + WS_LF), (float*)(C.ws + WS_RSTD));
        if (BOTH(5)) GRID_BAR(); }
    if (IN(6)) { mlstm_scan_phase(C);
        pg8::Gemm g{X1B, (const bf16*)(C.ws + WS_WIN1), M, NPJ, D}; pg8::StaticOrder S; S.init(M, NPJ, C.G, C.bid, WGM_PROJ);
        pg8::EpiProj1 E{PROJ, (const float*)(C.ws + WS_RSTD)};
        pg8::gemm_phase<pg8::EpiProj1, pg8::StaticOrder, true, true, true>(C.lds + RING_OFF, g, S, E);
        if (BOTH(6)) GRID_BAR(); }
    {
    if (IN(7)) { mlstm_dc_phase(C); if (BOTH(7)) GRID_BAR(); }
    if (IN(8)) {
        mlstm_state_phase(C);
        if (BOTH(8)) GRID_BAR(); }
    if (IN(9)) {
        mlstm_out_phase(C);
        if (BOTH(9)) GRID_BAR(); }
    }
    if (IN(10)) { pg8::Gemm g{XN, (const bf16*)(C.ws + WS_WOUT1), M, D, D}; pg8::StaticOrder S; S.init(M, D, C.G, C.bid, WGM_OUT);
        pg8::EpiResidB2B E{X1B, X2B};
        pg8::gemm_phase<pg8::EpiResidB2B, pg8::StaticOrder, true, true>(C.lds + RING_OFF, g, S, E);
        if (BOTH(10)) GRID_BAR(); }
    if (IN(11)) { final_norm_phase(C, X2B); }
#undef IN
#undef BOTH
}

extern "C" void kernel_launch(void* const* d_in, const int* in_sizes, int n_in, void* d_out, int out_size, void* d_ws, size_t ws_size, hipStream_t stream) {
    static int grid = 0;
    if (grid == 0) {
        if (n_in != 17 || in_sizes[0] != M * D || out_size != M * D || ws_size < WS_END) { fprintf(stderr, "kernel_launch: unexpected shapes (n_in %d, in0 %d, out %d, ws %zu < %zu); nothing launched\n", n_in, n_in > 0 ? in_sizes[0] : -1, out_size, ws_size, (size_t)WS_END); grid = -1; return; }
        int dev = 0, cus = 0, per_cu = 0;
        if (hipGetDevice(&dev) != hipSuccess || hipDeviceGetAttribute(&cus, hipDeviceAttributeMultiprocessorCount, dev) != hipSuccess) { grid = -1; return; }
        if (hipFuncSetAttribute((const void*)fwd_kernel, hipFuncAttributeMaxDynamicSharedMemorySize, LDS_BYTES) != hipSuccess) { fprintf(stderr, "kernel_launch: hipFuncSetAttribute failed\n"); grid = -1; return; }
        if (hipOccupancyMaxActiveBlocksPerMultiprocessor(&per_cu, (const void*)fwd_kernel, NWAVES * 64, LDS_BYTES) != hipSuccess || per_cu < 1) fprintf(stderr, "kernel_launch: occupancy query reports %d\n", per_cu);
        (void)hipGetLastError();
        grid = cus;
    }
    if (grid < 0) return;
    if (hipMemsetAsync((char*)d_ws + WS_CTL, 0, CTL_ZERO_BYTES, stream) != hipSuccess) return;
    Args a{};
    for (int i = 0; i < 17; ++i) a.in[i] = (const float*)d_in[i];
    a.out = (float*)d_out; a.ws = (unsigned char*)d_ws;
    if (MK_ONE_LAUNCH) { a.ph_lo = 0; a.ph_hi = NPHASE; hipLaunchKernelGGL(fwd_kernel, dim3(grid), dim3(NWAVES * 64), LDS_BYTES, stream, a); }
    else for (int p = 0; p < NPHASE; ++p) { a.ph_lo = p; a.ph_hi = p + 1; hipLaunchKernelGGL(fwd_kernel, dim3(grid), dim3(NWAVES * 64), LDS_BYTES, stream, a); }
}
```
